# Optimizing an MI355X kernel written in HIP

```python
import math
import jax, jax.numpy as jnp
from jax import lax
import numpy as np

D_MODEL = 1024
BATCH = 2
SEQ = 16384
DEPTH = 4

CHUNK = 64
Q_BLOCK = 128
LRU_WIDTH = 256
LRU_HEADS = 4
LRU_HEAD_DIM = LRU_WIDTH // LRU_HEADS
CONV_WIDTH = 4
LRU_C = 8.0
SG_WIDTH = 256
SG_GROUPS = 4
SG_GROUP_DIM = SG_WIDTH // SG_GROUPS
SG_LEN = 128
ATTN_HEADS = 4
ATTN_QK_DIM = 64
ATTN_V_DIM = 2 * ATTN_QK_DIM
ATTN_QK_TOTAL = ATTN_HEADS * 2 * ATTN_QK_DIM
ATTN_WIDTH = ATTN_HEADS * ATTN_V_DIM
N_BUCKETS = 32
MAX_DISTANCE = 2048
N_BRANCH = 3
FFN_HIDDEN = -(-8 * D_MODEL // (3 * 256)) * 256
EPS = 1e-6

_IN_SIZES = (LRU_WIDTH, LRU_WIDTH, SG_WIDTH, SG_WIDTH, ATTN_QK_TOTAL, ATTN_QK_TOTAL, ATTN_WIDTH, N_BRANCH * D_MODEL)
IN_COLS = sum(_IN_SIZES)
IN_SPLITS = tuple(int(s) for s in np.cumsum(_IN_SIZES)[:-1])

kernel_name = "hybrid_rglru_sgu_diffattn_trunk"


def rms_norm(x, g):
    x32 = x.astype(jnp.float32)
    y = x32 * lax.rsqrt(jnp.mean(x32 * x32, axis=-1, keepdims=True) + EPS)
    return (y * g.astype(jnp.float32)).astype(x.dtype)


def layer_norm(x, g, b):
    x32 = x.astype(jnp.float32)
    mu = jnp.mean(x32, axis=-1, keepdims=True)
    var = jnp.mean(jnp.square(x32 - mu), axis=-1, keepdims=True)
    y = (x32 - mu) * lax.rsqrt(var + EPS)
    return (y * g.astype(jnp.float32) + b.astype(jnp.float32)).astype(x.dtype)


def rglru_branch(xa, ga, conv_w, conv_b, wa, ba, wi, bi, lam):
    B, S, _ = xa.shape
    xp = jnp.pad(xa, ((0, 0), (CONV_WIDTH - 1, 0), (0, 0)))
    xc = conv_b
    for tap in range(CONV_WIDTH):
        xc = xc + xp[:, tap:tap + S] * conv_w[tap]
    xh = xc.reshape(B, S, LRU_HEADS, LRU_HEAD_DIM)
    r = jax.nn.sigmoid(jnp.einsum('bshi,hij->bshj', xh, wa).reshape(B, S, LRU_WIDTH) + ba)
    i = jax.nn.sigmoid(jnp.einsum('bshi,hij->bshj', xh, wi).reshape(B, S, LRU_WIDTH) + bi)
    log_a = (-LRU_C * jax.nn.softplus(-lam.astype(jnp.float32))) * r.astype(jnp.float32)
    a = jnp.exp(log_a)
    mult = jnp.sqrt(-jnp.expm1(2.0 * log_a))
    bterm = mult * (i * xc).astype(jnp.float32)

    def combine(left, right):
        a1, b1 = left
        a2, b2 = right
        return a1 * a2, a2 * b1 + b2

    _, h = lax.associative_scan(combine, (a, bterm), axis=1)
    return h.astype(xa.dtype) * jax.nn.gelu(ga)


def spatial_gating_branch(u, v, ln_g, ln_b, w_s, b_s):
    B, S, _ = v.shape
    vn = layer_norm(v, ln_g, ln_b)
    vb = vn.reshape(B, S // SG_LEN, SG_LEN, SG_GROUPS, SG_GROUP_DIM)
    causal = jnp.tril(jnp.ones((SG_LEN, SG_LEN), dtype=bool))
    ws = jnp.where(causal, w_s, jnp.zeros_like(w_s))
    mixed = jnp.einsum('gts,bnsgc->bntgc', ws, vb) + b_s.T[None, None, :, :, None]
    return u * mixed.reshape(B, S, SG_WIDTH)


def t5_bucket(rel):
    half = N_BUCKETS // 2
    max_exact = half // 2
    ret = jnp.where(rel > 0, half, 0)
    n = jnp.abs(rel)
    nf = jnp.maximum(n, 1).astype(jnp.float32)
    large = max_exact + (jnp.log(nf / max_exact) / math.log(MAX_DISTANCE / max_exact)
                         * (half - max_exact)).astype(jnp.int32)
    large = jnp.minimum(large, half - 1)
    return ret + jnp.where(n < max_exact, n, large)


def diff_attention_branch(q, k, v, q_g, k_g, lq1, lk1, lq2, lk2, sub_g, rel_bias, lam_init):
    B, S, _ = q.shape
    H, dk = ATTN_HEADS, ATTN_QK_DIM
    q = rms_norm(q.reshape(B, S, H, 2, dk), q_g) * (dk ** -0.5)
    k = rms_norm(k.reshape(B, S, H, 2, dk), k_g)
    v = v.reshape(B, S, H, ATTN_V_DIM)
    f32 = jnp.float32
    lam = (jnp.exp(jnp.sum(lq1.astype(f32) * lk1.astype(f32)))
           - jnp.exp(jnp.sum(lq2.astype(f32) * lk2.astype(f32))) + lam_init)
    nb = S // Q_BLOCK
    qb = q.reshape(B, nb, Q_BLOCK, H, 2, dk).transpose(1, 0, 2, 3, 4, 5)
    k_pos = jnp.arange(S, dtype=jnp.int32)
    k_chunk = k_pos // CHUNK

    def block(args):
        qi, blk = args
        q_pos = blk * Q_BLOCK + jnp.arange(Q_BLOCK, dtype=jnp.int32)
        bias = rel_bias[t5_bucket(k_pos[None, :] - q_pos[:, None])]
        allowed = k_chunk[None, :] <= (q_pos // CHUNK)[:, None]
        s = (jnp.einsum('bqhcd,bkhcd->bhcqk', qi, k).astype(f32)
             + bias.transpose(2, 0, 1)[None, :, None].astype(f32))
        s = jnp.where(allowed, s, -jnp.inf)
        p = jax.nn.softmax(s, axis=-1)
        attn = p[:, :, 0] - lam * p[:, :, 1]
        return jnp.einsum('bhqk,bkhe->bqhe', attn.astype(v.dtype), v)

    o = lax.map(block, (qb, jnp.arange(nb, dtype=jnp.int32)))
    o = o.transpose(1, 0, 2, 3, 4).reshape(B, S, H, ATTN_V_DIM)
    o = rms_norm(o, sub_g) * (1.0 - lam_init)
    return o.reshape(B, S, ATTN_WIDTH)


def setup_inputs(seed: int = 0) -> dict:
    key = jax.random.key(seed)
    ks = iter(jax.random.split(key, 40))
    f32 = jnp.float32

    def nrm(shape, scale):
        return jax.random.normal(next(ks), shape, f32) * scale

    def gain(shape):
        return 1.0 + nrm(shape, 0.02)

    L, D = DEPTH, D_MODEL
    u = jax.random.uniform(next(ks), (L, LRU_WIDTH), f32, 0.9, 0.999)
    s = u ** (1.0 / LRU_C)
    lru_lambda = jnp.log(s) - jnp.log1p(-s)
    return {
        "x": nrm((BATCH, SEQ, D), 1.0),
        "ln1_g": gain((L, D)),
        "w_in": nrm((L, D, IN_COLS), D ** -0.5),
        "b_gate": nrm((L, N_BRANCH * D), 0.01),
        "conv_w": nrm((L, CONV_WIDTH, LRU_WIDTH), CONV_WIDTH ** -0.5),
        "conv_b": nrm((L, LRU_WIDTH), 0.01),
        "lru_wa": nrm((L, LRU_HEADS, LRU_HEAD_DIM, LRU_HEAD_DIM), LRU_HEAD_DIM ** -0.5),
        "lru_ba": nrm((L, LRU_WIDTH), 0.01),
        "lru_wi": nrm((L, LRU_HEADS, LRU_HEAD_DIM, LRU_HEAD_DIM), LRU_HEAD_DIM ** -0.5),
        "lru_bi": nrm((L, LRU_WIDTH), 0.01),
        "lru_lambda": lru_lambda,
        "sg_ln_g": gain((L, SG_WIDTH)),
        "sg_ln_b": nrm((L, SG_WIDTH), 0.01),
        "sg_w": nrm((L, SG_GROUPS, SG_LEN, SG_LEN), SG_LEN ** -0.5),
        "sg_b": 1.0 + nrm((L, SG_GROUPS, SG_LEN), 0.01),
        "q_norm_g": gain((L, ATTN_QK_DIM)),
        "k_norm_g": gain((L, ATTN_QK_DIM)),
        "lambda_q1": nrm((L, ATTN_QK_DIM), 0.1),
        "lambda_k1": nrm((L, ATTN_QK_DIM), 0.1),
        "lambda_q2": nrm((L, ATTN_QK_DIM), 0.1),
        "lambda_k2": nrm((L, ATTN_QK_DIM), 0.1),
        "subln_g": gain((L, ATTN_V_DIM)),
        "rel_bias": nrm((N_BUCKETS, ATTN_HEADS), 0.5),
        "w_pa": nrm((L, LRU_WIDTH, D), LRU_WIDTH ** -0.5),
        "w_pb": nrm((L, SG_WIDTH, D), SG_WIDTH ** -0.5),
        "w_pc": nrm((L, ATTN_WIDTH, D), ATTN_WIDTH ** -0.5),
        "w_o": nrm((L, D, D), D ** -0.5),
        "ln2_g": gain((L, D)),
        "w_ff_gate": nrm((L, D, FFN_HIDDEN), D ** -0.5),
        "w_ff_up": nrm((L, D, FFN_HIDDEN), D ** -0.5),
        "w_ff_down": nrm((L, FFN_HIDDEN, D), FFN_HIDDEN ** -0.5),
    }


def reference(x, ln1_g, w_in, b_gate, conv_w, conv_b, lru_wa, lru_ba, lru_wi, lru_bi, lru_lambda,
              sg_ln_g, sg_ln_b, sg_w, sg_b, q_norm_g, k_norm_g, lambda_q1, lambda_k1, lambda_q2,
              lambda_k2, subln_g, rel_bias, w_pa, w_pb, w_pc, w_o, ln2_g, w_ff_gate, w_ff_up,
              w_ff_down):
    B, S, D = x.shape
    for l in range(DEPTH):
        lam_init = 0.8 - 0.6 * math.exp(-0.3 * l)
        h = rms_norm(x, ln1_g[l])
        proj = h @ w_in[l]
        xa, ga, u, v, q, k, vv, gates = jnp.split(proj, IN_SPLITS, axis=-1)
        ya = rglru_branch(xa, ga, conv_w[l], conv_b[l], lru_wa[l], lru_ba[l], lru_wi[l], lru_bi[l],
                          lru_lambda[l])
        yb = spatial_gating_branch(u, v, sg_ln_g[l], sg_ln_b[l], sg_w[l], sg_b[l])
        yc = diff_attention_branch(q, k, vv, q_norm_g[l], k_norm_g[l], lambda_q1[l], lambda_k1[l],
                                   lambda_q2[l], lambda_k2[l], subln_g[l], rel_bias, lam_init)
        g = jax.nn.sigmoid(gates + b_gate[l]).reshape(B, S, N_BRANCH, D)
        merged = (g[:, :, 0] * (ya @ w_pa[l]) + g[:, :, 1] * (yb @ w_pb[l])
                  + g[:, :, 2] * (yc @ w_pc[l]))
        x = x + merged @ w_o[l]
        h2 = rms_norm(x, ln2_g[l])
        x = x + (jax.nn.silu(h2 @ w_ff_gate[l]) * (h2 @ w_ff_up[l])) @ w_ff_down[l]
    return x
```

```cpp
#include <hip/hip_runtime.h>
#include <hip/hip_cooperative_groups.h>
#include <hip/hip_bf16.h>
#include <cstdio>
#include <cstdint>
#include <cmath>
namespace cg = cooperative_groups;
namespace pg8 {
#define PG8_LAS __attribute__((address_space(3)))
typedef unsigned short bf16_t;
typedef short bf16x8 __attribute__((ext_vector_type(8)));
typedef float f32x4 __attribute__((ext_vector_type(4)));
typedef unsigned u32x4 __attribute__((ext_vector_type(4)));
constexpr int BM = 256, BK = 64, HALF = 128, HTB = HALF * BK * 2  , STAGE_BYTES = 8 * HTB, NXCD = 8, WGM = 8;

__host__ __device__ __forceinline__ int lds_byte(int r, int c) { const int st = (r >> 4) * 2 + (c >> 5), rr = r & 15, cc = c & 31, ob = rr * 64 + cc * 2; return st * 1024 + (ob ^ (((ob >> 9) & 1) << 5)); }
__host__ __device__ __forceinline__ void stage_rc(int b, int& R, int& C) { const int st = b / 1024, sb = b % 1024, swz = sb ^ (((sb >> 9) & 1) << 5); R = (st >> 1) * 16 + swz / 64; C = (st & 1) * 32 + (swz % 64) / 2; }
__host__ __device__ __forceinline__ int perm32(int rho) { const int n = rho >> 4, i = rho & 15; return 8 * (i >> 2) + 4 * n + (i & 3); }

struct Unit { int pm, pn; };
struct Gemm { const bf16_t* A; const bf16_t* Bt; int M, N, K, lda; };

struct StaticOrder {
    int nM, nN, nwg, G, c;
    __host__ __device__ void init(int M, int N, int G_, int c_) { nM = M / BM; nN = N / BM; nwg = nM * nN; G = G_; c = c_; }
    __host__ __device__ bool next(int i, Unit& u) const {
        const long L = (long)i * G + c; if (L >= nwg) return false;
        int wgid = (int)L; { const int q = nwg / NXCD, r = nwg % NXCD, xcd = wgid % NXCD, off = wgid / NXCD; wgid = (xcd < r ? xcd * (q + 1) : r * (q + 1) + (xcd - r) * q) + off; }
        const int nig = WGM * nN, gid = wgid / nig, fm = gid * WGM, gsz = (nM - fm) < WGM ? (nM - fm) : WGM;
        u.pm = fm + ((wgid % nig) % gsz); u.pn = (wgid % nig) / gsz; return true;
    }
    __device__ __forceinline__ void a_ready(const Unit&) const {}
    __device__ __forceinline__ void done(const Unit&) const {}
};

template <class Epi, class Sched, bool ALIGN_EPI = false, bool SP2 = false>
__device__ __forceinline__ void gemm_phase(PG8_LAS unsigned char* lds, const Gemm g, const Sched& S, const Epi& E, const int tid) {
    const int wid = __builtin_amdgcn_readfirstlane(tid >> 6), lane = tid & 63, wr = wid >> 2, wc = wid & 3, fr = lane & 15, fq = lane >> 4;
    const int K = g.K, nt = K / BK;
    unsigned voffA[2], voffB[2];
#pragma unroll
    for (int i = 0; i < 2; ++i) { int R, C; stage_rc(tid * 16 + i * 8192, R, C); const int Rb = Epi::PERM ? ((R & ~31) + perm32(R & 31)) : R;
        voffA[i] = (unsigned)(R * g.lda + C) * 2u; voffB[i] = (unsigned)(Rb * K + C) * 2u; }
    const size_t kstep = (size_t)(BK * 2);
    const size_t hstepA = (size_t)HALF * g.lda * 2, hstepB = (size_t)HALF * K * 2;
    const size_t tstepA = 2 * hstepA, tstepB = 2 * hstepB;
    const unsigned ldsw = (unsigned)wid * 1024u;
    const int aoff = lds_byte(wr * 64 + fr, fq * 8), boff = lds_byte(wc * 32 + fr, fq * 8);
#define PG8_SA(b, h) (((b) * 2 + (h)) * HTB)
#define PG8_SB(b, h) ((4 + (b) * 2 + (h)) * HTB)
#define PG8_STAGE(bufoff, gbase, voff) do { _Pragma("unroll") for (int _i = 0; _i < 2; ++_i) \
        __builtin_amdgcn_global_load_lds((const unsigned*)((const char*)(gbase) + (voff)[_i]), (PG8_LAS unsigned*)(lds + (bufoff) + ldsw + _i * 8192), 16, 0, 0); } while (0)
#define PG8_LDA(dst, b, h) do { _Pragma("unroll") for (int m = 0; m < 4; ++m) _Pragma("unroll") for (int k = 0; k < 2; ++k) dst[m][k] = *(const PG8_LAS bf16x8*)(lds + PG8_SA(b, h) + aoff + m * 2048 + k * 1024); } while (0)
#define PG8_LDB(dst, b, h) do { _Pragma("unroll") for (int n = 0; n < 2; ++n) _Pragma("unroll") for (int k = 0; k < 2; ++k) dst[n][k] = *(const PG8_LAS bf16x8*)(lds + PG8_SB(b, h) + boff + n * 2048 + k * 1024); } while (0)
#define PG8_MMA(ai, bj, At, Bt) do { __builtin_amdgcn_s_setprio(1); _Pragma("unroll") for (int m = 0; m < 4; ++m) _Pragma("unroll") for (int n = 0; n < 2; ++n) _Pragma("unroll") for (int k = 0; k < 2; ++k) \
        acc[ai][bj][m][n] = __builtin_amdgcn_mfma_f32_16x16x32_bf16(Bt[n][k], At[m][k], acc[ai][bj][m][n], 0, 0, 0); __builtin_amdgcn_s_setprio(0); } while (0)
#define PG8_WAIT_V(n) asm volatile("s_waitcnt vmcnt(" #n ")" ::: "memory")
#define PG8_WAIT_L(n) asm volatile("s_waitcnt lgkmcnt(" #n ")" ::: "memory")
#define PG8_BAR __builtin_amdgcn_s_barrier()
#define PG8_SCHED __builtin_amdgcn_sched_barrier(0)
    Unit cur, nxt; int ui = 0;
    if (!S.next(0, cur)) return;
    f32x4 acc[2][2][4][2];
#pragma unroll
    for (int a = 0; a < 2; ++a)
#pragma unroll
        for (int b = 0; b < 2; ++b)
#pragma unroll
            for (int m = 0; m < 4; ++m)
#pragma unroll
                for (int n = 0; n < 2; ++n) acc[a][b][m][n] = (f32x4){0.f, 0.f, 0.f, 0.f};
    bf16x8 At[4][2], B0[2][2], B1[2][2];
    const char* cA = (const char*)g.A + (size_t)cur.pm * tstepA; const char* cB = (const char*)g.Bt + (size_t)cur.pn * tstepB;
    S.a_ready(cur);
    if constexpr (SP2) {
        PG8_STAGE(PG8_SB(0, 0), cB, voffB); PG8_STAGE(PG8_SB(0, 1), cB + hstepB, voffB); PG8_STAGE(PG8_SA(0, 0), cA, voffA); PG8_STAGE(PG8_SA(0, 1), cA + hstepA, voffA);
        if (wr == 1) PG8_BAR;
        PG8_WAIT_V(2); PG8_BAR;
        PG8_STAGE(PG8_SB(1, 0), cB + kstep, voffB); PG8_STAGE(PG8_SA(1, 0), cA + kstep, voffA); PG8_STAGE(PG8_SB(1, 1), cB + hstepB + kstep, voffB);
        PG8_WAIT_V(6); PG8_BAR;
    } else {
        PG8_STAGE(PG8_SB(0, 0), cB, voffB); PG8_STAGE(PG8_SA(0, 0), cA, voffA); PG8_STAGE(PG8_SB(0, 1), cB + hstepB, voffB); PG8_STAGE(PG8_SA(0, 1), cA + hstepA, voffA);
        if (wr == 1) PG8_BAR;
        PG8_WAIT_V(4); PG8_BAR;
        PG8_STAGE(PG8_SB(1, 0), cB + kstep, voffB); PG8_STAGE(PG8_SA(1, 0), cA + kstep, voffA); PG8_STAGE(PG8_SB(1, 1), cB + hstepB + kstep, voffB);
        PG8_WAIT_V(6); PG8_BAR;
    }
    for (;;) {
        const bool has_next = S.next(ui + 1, nxt);
        const char* nA = has_next ? (const char*)g.A + (size_t)nxt.pm * tstepA : cA; const char* nB = has_next ? (const char*)g.Bt + (size_t)nxt.pn * tstepB : cB;
        for (int t = 0; t < nt; t += 2) {
            const bool last = (t == nt - 2);
            const char* a1 = cA + (size_t)(t + 1) * kstep;
            const char* a2 = last ? nA : cA + (size_t)(t + 2) * kstep; const char* b2 = last ? nB : cB + (size_t)(t + 2) * kstep;
            const char* a3 = a2 + kstep; const char* b3 = b2 + kstep;
            if (last && has_next) S.a_ready(nxt);
            if constexpr (SP2) {
            PG8_LDB(B0, 0, 0); PG8_LDB(B1, 0, 1); PG8_SCHED; PG8_LDA(At, 0, 0); PG8_STAGE(PG8_SA(1, 1), a1 + hstepA, voffA);
            PG8_WAIT_V(8); PG8_WAIT_L(0); PG8_BAR; PG8_MMA(0, 0, At, B0); PG8_MMA(0, 1, At, B1); PG8_BAR; PG8_SCHED;
            PG8_LDA(At, 0, 1); PG8_STAGE(PG8_SB(0, 0), b2, voffB); PG8_STAGE(PG8_SB(0, 1), b2 + hstepB, voffB); PG8_STAGE(PG8_SA(0, 0), a2, voffA);
            PG8_WAIT_V(8); PG8_WAIT_L(0); PG8_BAR; PG8_MMA(1, 0, At, B0); PG8_MMA(1, 1, At, B1); PG8_BAR; PG8_SCHED;
            PG8_LDB(B0, 1, 0); PG8_LDB(B1, 1, 1); PG8_SCHED; PG8_LDA(At, 1, 0); PG8_STAGE(PG8_SA(0, 1), a2 + hstepA, voffA);
            PG8_WAIT_V(8); PG8_WAIT_L(0); PG8_BAR; PG8_MMA(0, 0, At, B0); PG8_MMA(0, 1, At, B1); PG8_BAR; PG8_SCHED;
            PG8_LDA(At, 1, 1); PG8_STAGE(PG8_SB(1, 0), b3, voffB); PG8_STAGE(PG8_SB(1, 1), b3 + hstepB, voffB); PG8_STAGE(PG8_SA(1, 0), a3, voffA);
            PG8_WAIT_V(8); PG8_WAIT_L(0); PG8_BAR; PG8_MMA(1, 0, At, B0); PG8_MMA(1, 1, At, B1); PG8_BAR; PG8_SCHED;
            } else {
            PG8_LDB(B0, 0, 0); PG8_SCHED; PG8_LDA(At, 0, 0); PG8_STAGE(PG8_SA(1, 1), a1 + hstepA, voffA);
            PG8_WAIT_L(8); PG8_BAR; PG8_WAIT_L(0); PG8_MMA(0, 0, At, B0); PG8_BAR; PG8_SCHED;
            PG8_LDB(B1, 0, 1); PG8_STAGE(PG8_SB(0, 0), b2, voffB);
            PG8_BAR; PG8_WAIT_L(0); PG8_MMA(0, 1, At, B1); PG8_BAR;
            PG8_LDA(At, 0, 1); PG8_STAGE(PG8_SA(0, 0), a2, voffA);
            PG8_BAR; PG8_WAIT_L(0); PG8_MMA(1, 0, At, B0); PG8_BAR; PG8_SCHED;
            PG8_STAGE(PG8_SB(0, 1), b2 + hstepB, voffB);
            PG8_WAIT_V(6); PG8_BAR; PG8_MMA(1, 1, At, B1); PG8_BAR;
            PG8_LDB(B0, 1, 0); PG8_SCHED; PG8_LDA(At, 1, 0); PG8_STAGE(PG8_SA(0, 1), a2 + hstepA, voffA);
            PG8_WAIT_L(8); PG8_BAR; PG8_WAIT_L(0); PG8_MMA(0, 0, At, B0); PG8_BAR; PG8_SCHED;
            PG8_LDB(B1, 1, 1); PG8_STAGE(PG8_SB(1, 0), b3, voffB);
            PG8_BAR; PG8_WAIT_L(0); PG8_MMA(0, 1, At, B1); PG8_BAR;
            PG8_LDA(At, 1, 1); PG8_STAGE(PG8_SA(1, 0), a3, voffA);
            PG8_BAR; PG8_WAIT_L(0); PG8_MMA(1, 0, At, B0); PG8_BAR; PG8_SCHED;
            PG8_STAGE(PG8_SB(1, 1), b3 + hstepB, voffB);
            PG8_WAIT_V(6); PG8_BAR; PG8_MMA(1, 1, At, B1); PG8_BAR;
            }
        }
        if constexpr (ALIGN_EPI) { if (wr == 0) PG8_BAR; }
        if constexpr (!Epi::AFTER_DRAIN) { int l2_; asm volatile("v_mbcnt_lo_u32_b32 %0, -1, 0\n\tv_mbcnt_hi_u32_b32 %0, -1, %0" : "=v"(l2_)); E(acc, cur, wr, wc, l2_ & 15, l2_ >> 4); S.done(cur); }
        if (!has_next) break;
#pragma unroll
        for (int a = 0; a < 2; ++a)
#pragma unroll
            for (int b = 0; b < 2; ++b)
#pragma unroll
                for (int m = 0; m < 4; ++m)
#pragma unroll
                    for (int n = 0; n < 2; ++n) acc[a][b][m][n] = (f32x4){0.f, 0.f, 0.f, 0.f};
        cur = nxt; cA = nA; cB = nB; ++ui;
        if constexpr (ALIGN_EPI) { if (wr == 1) PG8_BAR; }
    }
    PG8_WAIT_V(0);
    if constexpr (!ALIGN_EPI) { if (wr == 0) PG8_BAR; }
    PG8_BAR;
    if constexpr (Epi::AFTER_DRAIN) { E.fused(acc, cur, wr, wc, fr, fq, lds, wid, lane); S.done(cur); }
#undef PG8_SA
#undef PG8_SB
#undef PG8_STAGE
#undef PG8_LDA
#undef PG8_LDB
#undef PG8_MMA
#undef PG8_WAIT_V
#undef PG8_WAIT_L
#undef PG8_BAR
#undef PG8_SCHED
}
}

#define LAS __attribute__((address_space(3)))
typedef unsigned short bf16_t;
typedef short bf16x8 __attribute__((ext_vector_type(8)));
typedef float f32x4 __attribute__((ext_vector_type(4)));
typedef float f32x2 __attribute__((ext_vector_type(2)));
typedef float f32x16 __attribute__((ext_vector_type(16)));
typedef unsigned u32x4 __attribute__((ext_vector_type(4)));
typedef unsigned u32x2 __attribute__((ext_vector_type(2)));
typedef __bf16 bf16x2_t __attribute__((ext_vector_type(2)));

constexpr int NB = 2, SEQ = 16384, DM = 1024, NL = 4, MT = NB * SEQ;
constexpr int INC = 5632, PJ = 2048, GP = 3072, FF = 2816;
constexpr float EPS = 1e-6f, LOG2E = 1.4426950408889634f;
constexpr size_t MiB = 1u << 20;
constexpr size_t WS_SSQA = 1 * MiB, WS_SSQB = 3 * MiB, WS_AGG = 5 * MiB, WS_SMALL = 6 * MiB;
constexpr size_t WS_W0 = 8 * MiB, WS_WSZ = 32 * MiB;
constexpr size_t WS_XB = 72 * MiB, WS_PROJ = 136 * MiB, WS_VT = 264 * MiB, WS_GATES = 296 * MiB, WS_END = 488 * MiB;
constexpr size_t W_IN = 0, W_PA = 11 * MiB, W_PB = W_PA + MiB / 2, W_PC = 12 * MiB, W_O = 13 * MiB, W_FF = 15 * MiB, W_DN = 26 * MiB;
constexpr int SMALL_PER_LAYER = 16384 + 16384 + 65536;
constexpr int LDS_BYTES = 147456, MISC_OFF = 131072 + 320;
constexpr int CW_BAR = 4096; constexpr size_t CTL_ZERO_BYTES = 65536;

__device__ __forceinline__ unsigned pk2(float lo, float hi) { f32x2 v = {lo, hi}; bf16x2_t b = __builtin_convertvector(v, bf16x2_t); return __builtin_bit_cast(unsigned, b); }
__device__ __forceinline__ bf16_t f2bf(float f) { unsigned u = __builtin_bit_cast(unsigned, f); return (bf16_t)((u + 0x7fffu + ((u >> 16) & 1u)) >> 16); }
__device__ __forceinline__ float bf2f(bf16_t b) { return __builtin_bit_cast(float, (unsigned)b << 16); }
__device__ __forceinline__ float bflo(unsigned w) { return __builtin_bit_cast(float, w << 16); }
__device__ __forceinline__ float bfhi(unsigned w) { return __builtin_bit_cast(float, w & 0xffff0000u); }
__device__ __forceinline__ float fsigmoid(float x) { return __builtin_amdgcn_rcpf(1.f + __builtin_amdgcn_exp2f(-x * LOG2E)); }
__device__ __forceinline__ float shx(float v, int mask, int lane) { return __builtin_bit_cast(float, __builtin_amdgcn_ds_bpermute((lane ^ mask) << 2, __builtin_bit_cast(int, v))); }
__device__ __forceinline__ float wave_sum(float v, int lane) {
#pragma unroll
    for (int o = 1; o < 64; o <<= 1) v += shx(v, o, lane);
    return v;
}
__device__ __forceinline__ int crow(int r, int hi) { return (r & 3) + 8 * (r >> 2) + 4 * hi; }
#define MFMA32(a, b, c) __builtin_amdgcn_mfma_f32_32x32x16_bf16((a), (b), (c), 0, 0, 0)
__device__ __forceinline__ bf16x8 pack8(float a0, float a1, float a2, float a3, float a4, float a5, float a6, float a7) {
    u32x4 p; p.x = pk2(a0, a1); p.y = pk2(a2, a3); p.z = pk2(a4, a5); p.w = pk2(a6, a7); return __builtin_bit_cast(bf16x8, p);
}

namespace pg8 {
__device__ __forceinline__ float row_rstd(const float* ssq, int r) {
    const f32x4* p = (const f32x4*)(ssq + (size_t)r * 16);
    const f32x4 a = p[0], b = p[1], c = p[2], d = p[3];
    const float s = ((a[0] + a[1]) + (a[2] + a[3])) + ((b[0] + b[1]) + (b[2] + b[3])) + ((c[0] + c[1]) + (c[2] + c[3])) + ((d[0] + d[1]) + (d[2] + d[3]));
    return __builtin_amdgcn_rsqf(s * (1.f / 1024.f) + EPS);
}
__device__ __forceinline__ u32x4 pack_f8(const f32x4 v0, const f32x4 v1) { u32x4 w; w.x = pk2(v0[0], v0[1]); w.y = pk2(v0[2], v0[3]); w.z = pk2(v1[0], v1[1]); w.w = pk2(v1[2], v1[3]); return w; }

struct EpiInProj {
    static constexpr bool PERM = true, AFTER_DRAIN = false;
    bf16_t* proj; bf16_t* vt; bf16_t* gates; const float* ssq; const float* bgate;
    __device__ __forceinline__ void operator()(const f32x4 (&acc)[2][2][4][2], const Unit& u, int wr, int wc, int fr, int fq) const {
        const int row0 = u.pm * BM + wr * 64 + fr, cin = wc * 32 + 8 * fq;
        if (u.pn < 8) {
#pragma unroll
            for (int ai = 0; ai < 2; ++ai)
#pragma unroll
                for (int m = 0; m < 4; ++m) { const int r = row0 + ai * HALF + m * 16; const float rs = row_rstd(ssq, r); bf16_t* rowp = proj + (size_t)r * PJ + u.pn * BM + cin;
#pragma unroll
                    for (int bj = 0; bj < 2; ++bj) *(u32x4*)(rowp + bj * HALF) = pack_f8(acc[ai][bj][m][0] * rs, acc[ai][bj][m][1] * rs); }
        } else if (u.pn < 10) {
#pragma unroll
            for (int ai = 0; ai < 2; ++ai)
#pragma unroll
                for (int m = 0; m < 4; ++m) { const int r = row0 + ai * HALF + m * 16; const float rs = row_rstd(ssq, r);
                    const int b = r >> 14, s = r & (SEQ - 1), ko = s & 15, gq = ko >> 2, sg = (gq == 1) ? 2 : ((gq == 2) ? 1 : gq), slot = (s & ~15) | (sg * 4 + (ko & 3));
#pragma unroll
                    for (int bj = 0; bj < 2; ++bj) { const int head = (u.pn - 8) * 2 + bj; bf16_t* base = vt + ((size_t)((b * 4 + head) * 128 + cin)) * SEQ + slot;
                        const f32x4 v0 = acc[ai][bj][m][0] * rs, v1 = acc[ai][bj][m][1] * rs;
                        base[0] = f2bf(v0[0]); base[(size_t)SEQ] = f2bf(v0[1]); base[(size_t)2 * SEQ] = f2bf(v0[2]); base[(size_t)3 * SEQ] = f2bf(v0[3]);
                        base[(size_t)4 * SEQ] = f2bf(v1[0]); base[(size_t)5 * SEQ] = f2bf(v1[1]); base[(size_t)6 * SEQ] = f2bf(v1[2]); base[(size_t)7 * SEQ] = f2bf(v1[3]); } }
        } else {
            const int colg = (u.pn - 10) * BM + cin;
            f32x4 bv[2][2];
#pragma unroll
            for (int bj = 0; bj < 2; ++bj) { bv[bj][0] = *(const f32x4*)(bgate + colg + bj * HALF); bv[bj][1] = *(const f32x4*)(bgate + colg + bj * HALF + 4); }
#pragma unroll
            for (int ai = 0; ai < 2; ++ai)
#pragma unroll
                for (int m = 0; m < 4; ++m) { const int r = row0 + ai * HALF + m * 16; const float rs = row_rstd(ssq, r); bf16_t* rowp = gates + (size_t)r * GP + colg;
#pragma unroll
                    for (int bj = 0; bj < 2; ++bj) { f32x4 v0 = acc[ai][bj][m][0] * rs + bv[bj][0], v1 = acc[ai][bj][m][1] * rs + bv[bj][1];
#pragma unroll
                        for (int e = 0; e < 4; ++e) { v0[e] = fsigmoid(v0[e]); v1[e] = fsigmoid(v1[e]); }
                        *(u32x4*)(rowp + bj * HALF) = pack_f8(v0, v1); } }
        }
    }
};
template <int BR> struct EpiMerge {
    static constexpr bool PERM = true, AFTER_DRAIN = false;
    const bf16_t* gates; bf16_t* merged;
    __device__ __forceinline__ void operator()(const f32x4 (&acc)[2][2][4][2], const Unit& u, int wr, int wc, int fr, int fq) const {
        const int row0 = u.pm * BM + wr * 64 + fr, cin = wc * 32 + 8 * fq;
#pragma unroll
        for (int ai = 0; ai < 2; ++ai)
#pragma unroll
            for (int m = 0; m < 4; ++m) { const int r = row0 + ai * HALF + m * 16;
#pragma unroll
                for (int bj = 0; bj < 2; ++bj) { const int col = u.pn * BM + bj * HALF + cin;
                    const u32x4 g = *(const u32x4*)(gates + (size_t)r * GP + BR * 1024 + col);
                    bf16_t* mp = merged + (size_t)r * DM + col;
                    f32x4 o0 = {0.f, 0.f, 0.f, 0.f}, o1 = {0.f, 0.f, 0.f, 0.f};
                    if (BR > 0) { const u32x4 p = *(const u32x4*)mp; o0 = (f32x4){bflo(p.x), bfhi(p.x), bflo(p.y), bfhi(p.y)}; o1 = (f32x4){bflo(p.z), bfhi(p.z), bflo(p.w), bfhi(p.w)}; }
                    const f32x4 g0 = {bflo(g.x), bfhi(g.x), bflo(g.y), bfhi(g.y)}, g1 = {bflo(g.z), bfhi(g.z), bflo(g.w), bfhi(g.w)};
                    o0 += g0 * acc[ai][bj][m][0]; o1 += g1 * acc[ai][bj][m][1];
                    *(u32x4*)mp = pack_f8(o0, o1); }
                asm volatile("" ::: "memory"); }
    }
};
struct EpiResid {
    static constexpr bool PERM = true, AFTER_DRAIN = false;
    const float* xin; float* xout; bf16_t* xb; float* ssq;
    __device__ __forceinline__ void operator()(const f32x4 (&acc)[2][2][4][2], const Unit& u, int wr, int wc, int fr, int fq) const {
        const int row0 = u.pm * BM + wr * 64 + fr, cin = wc * 32 + 8 * fq;
#pragma unroll
        for (int ai = 0; ai < 2; ++ai)
#pragma unroll
            for (int m = 0; m < 4; ++m) { const int r = row0 + ai * HALF + m * 16; float ss = 0.f;
#pragma unroll
                for (int bj = 0; bj < 2; ++bj) { const size_t off = (size_t)r * DM + u.pn * BM + bj * HALF + cin;
                    f32x4 x0 = *(const f32x4*)(xin + off), x1 = *(const f32x4*)(xin + off + 4);
                    x0 += acc[ai][bj][m][0]; x1 += acc[ai][bj][m][1];
                    *(f32x4*)(xout + off) = x0; *(f32x4*)(xout + off + 4) = x1;
                    *(u32x4*)(xb + off) = pack_f8(x0, x1);
                    ss += (x0[0] * x0[0] + x0[1] * x0[1]) + (x0[2] * x0[2] + x0[3] * x0[3]) + (x1[0] * x1[0] + x1[1] * x1[1]) + (x1[2] * x1[2] + x1[3] * x1[3]); }
                { const int ln_ = fr | (fq << 4); ss += shx(ss, 16, ln_); ss += shx(ss, 32, ln_); }
                if (fq == 0) ssq[(size_t)r * 16 + u.pn * 4 + wc] = ss;
                asm volatile("" ::: "memory"); }
    }
};
struct EpiFfn1 {
    static constexpr bool PERM = true, AFTER_DRAIN = false;
    bf16_t* hid; const float* ssq;
    __device__ __forceinline__ void operator()(const f32x4 (&acc)[2][2][4][2], const Unit& u, int wr, int wc, int fr, int fq) const {
        const int row0 = u.pm * BM + wr * 64 + fr, cin = wc * 32 + 8 * fq;
#pragma unroll
        for (int ai = 0; ai < 2; ++ai)
#pragma unroll
            for (int m = 0; m < 4; ++m) { const int r = row0 + ai * HALF + m * 16; const float rs = row_rstd(ssq, r);
                f32x4 o[2];
#pragma unroll
                for (int n = 0; n < 2; ++n) { const f32x4 g = acc[ai][0][m][n] * rs, up = acc[ai][1][m][n] * rs;
#pragma unroll
                    for (int e = 0; e < 4; ++e) o[n][e] = g[e] * fsigmoid(g[e]) * up[e]; }
                *(u32x4*)(hid + (size_t)r * FF + u.pn * HALF + cin) = pack_f8(o[0], o[1]);
                asm volatile("" ::: "memory"); }
    }
};
}

#define XB_TMO      128
#define XB_XCNT(j)  (256  + 64 * (j))
#define XB_XSUB(j)  (1280 + 64 * (j))
#define XB_XGEN(j)  (2304 + 64 * (j))
#define XB_TOP      3328
#define XB_TOPGEN   3392
#define XCD_BAR_WORDS 3456
#define XB_SPIN_CAP (1u << 18)

__device__ __forceinline__ unsigned xb_ld(unsigned* p)              { return __hip_atomic_load(p, __ATOMIC_RELAXED, __HIP_MEMORY_SCOPE_AGENT); }
__device__ __forceinline__ unsigned xb_add(unsigned* p, unsigned v) { return __hip_atomic_fetch_add(p, v, __ATOMIC_RELAXED, __HIP_MEMORY_SCOPE_AGENT); }
__device__ __forceinline__ unsigned xb_xcc_id() { return (unsigned)__builtin_amdgcn_s_getreg((3 << 11) | 20) & 0xFu; }
#define XB_SPIN(cond, bar) do { unsigned _sp = 0; while (cond) { __builtin_amdgcn_s_sleep(1); \
    if ((++_sp & 255u) == 0u) { if (xb_ld(&(bar)[XB_TMO])) break; if (_sp > XB_SPIN_CAP) { atomicAdd(&(bar)[XB_TMO], 1u); break; } } } } while (0)

struct XcdBarrier {
    unsigned* bar; unsigned x;
    volatile LAS unsigned* st;
};

__device__ __forceinline__ XcdBarrier xcd_barrier_post(unsigned* bar, volatile LAS unsigned* st, bool is0) {
    XcdBarrier b; b.bar = bar; b.x = xb_xcc_id(); b.st = st;
    if (is0) (void)xb_add(&bar[XB_XCNT(b.x)], 1u);
    return b;
}
__device__ __forceinline__ void xcd_barrier_complete(unsigned* bar, unsigned x, unsigned& nloc, unsigned& nx) {
    const unsigned G = gridDim.x * gridDim.y * gridDim.z;
    unsigned sum, cnt, mine, sp = 0u;
    for (;;) {
        sum = 0u; cnt = 0u; mine = 0u;
#pragma unroll
        for (unsigned j = 0; j < 16; ++j) { const unsigned c = xb_ld(&bar[XB_XCNT(j)]); sum += c; cnt += (c > 0u) ? 1u : 0u; mine = (j == x) ? c : mine; }
        if (sum == G) break;
        __builtin_amdgcn_s_sleep(1);
        if ((++sp & 255u) == 0u) { if (xb_ld(&bar[XB_TMO])) break; if (sp > XB_SPIN_CAP) { atomicAdd(&bar[XB_TMO], 1u); break; } }
    }
    nloc = mine > 0u ? mine : 1u; nx = cnt > 0u ? cnt : 1u;
}

__device__ __forceinline__ void xcd_barrier(const XcdBarrier& b, bool is0) {
    asm volatile("s_waitcnt vmcnt(0)" ::: "memory");
    __syncthreads();
    if (is0) {
        unsigned* bar = b.bar;
        __builtin_amdgcn_s_waitcnt(0);
        unsigned nloc = b.st[0], nx = b.st[1];
        if (nloc == 0u) { xcd_barrier_complete(bar, b.x, nloc, nx); b.st[0] = nloc; b.st[1] = nx; }
        const unsigned old = xb_add(&bar[XB_XSUB(b.x)], 1u);
        const unsigned gen = old / nloc;
        if (old + 1u == (gen + 1u) * nloc) {
            __builtin_amdgcn_fence(__ATOMIC_RELEASE, "agent");
            asm volatile("s_waitcnt vmcnt(0)" ::: "memory");
            const unsigned og = xb_add(&bar[XB_TOP], 1u);
            const unsigned tg = og / nx;
            if (og + 1u == (tg + 1u) * nx) xb_add(&bar[XB_TOPGEN], 1u);
            else XB_SPIN(xb_ld(&bar[XB_TOPGEN]) == tg, bar);
            __builtin_amdgcn_fence(__ATOMIC_ACQUIRE, "agent");
            xb_add(&bar[XB_XGEN(b.x)], 1u);
            asm volatile("s_waitcnt vmcnt(0)" ::: "memory");
        } else {
            XB_SPIN(xb_ld(&bar[XB_XGEN(b.x)]) == gen, bar);
            __builtin_amdgcn_fence(__ATOMIC_ACQUIRE, "agent");
            asm volatile("s_waitcnt vmcnt(0)" ::: "memory");
        }
    }
    __syncthreads();
}


struct Args { const float* in[31]; float* out; unsigned char* ws; };
typedef const float* cfptr_t;
__device__ __forceinline__ cfptr_t kin(int i) { const volatile __attribute__((address_space(4))) cfptr_t* p = (const volatile __attribute__((address_space(4))) cfptr_t*)__builtin_amdgcn_kernarg_segment_ptr(); return p[i]; }

__device__ __forceinline__ void conv_item(const float* W, int N, int k0, int n0, bf16_t* dst, int ldk, const float* gain, LAS float* scr, int tid) {
    const int n = tid & 63, kq = tid >> 6;
#pragma unroll
    for (int i = 0; i < 8; ++i) { const int k = kq + 8 * i; float v = W[(size_t)(k0 + k) * N + n0 + n]; if (gain) v *= gain[k0 + k]; scr[k * 65 + n] = v; }
    __syncthreads();
    const int nn = tid >> 3, c = tid & 7;
    const LAS float* s = scr + (8 * c) * 65 + nn;
    u32x4 o; o.x = pk2(s[0], s[65]); o.y = pk2(s[130], s[195]); o.z = pk2(s[260], s[325]); o.w = pk2(s[390], s[455]);
    *(u32x4*)(dst + (size_t)nn * ldk + k0 + 8 * c) = o;
    __syncthreads();
}
__device__ __forceinline__ void convert_layer(int l, unsigned char* Wb, LAS float* scr, int tid, int bid, int G) {
    for (int it = bid; it < 4032; it += G) {
        int r = it;
        if (r < 1408) { const int kb = r / 88, nb = r % 88; conv_item(kin(2) + (size_t)l * DM * INC, INC, kb * 64, nb * 64, (bf16_t*)(Wb + W_IN) + (size_t)nb * 64 * DM, DM, kin(1) + l * DM, scr, tid); continue; } r -= 1408;
        if (r < 64) { const int kb = r / 16, nb = r % 16; conv_item(kin(23) + (size_t)l * 256 * DM, DM, kb * 64, nb * 64, (bf16_t*)(Wb + W_PA) + (size_t)nb * 64 * 256, 256, nullptr, scr, tid); continue; } r -= 64;
        if (r < 64) { const int kb = r / 16, nb = r % 16; conv_item(kin(24) + (size_t)l * 256 * DM, DM, kb * 64, nb * 64, (bf16_t*)(Wb + W_PB) + (size_t)nb * 64 * 256, 256, nullptr, scr, tid); continue; } r -= 64;
        if (r < 128) { const int kb = r / 16, nb = r % 16; conv_item(kin(25) + (size_t)l * 512 * DM, DM, kb * 64, nb * 64, (bf16_t*)(Wb + W_PC) + (size_t)nb * 64 * 512, 512, nullptr, scr, tid); continue; } r -= 128;
        if (r < 256) { const int kb = r / 16, nb = r % 16; conv_item(kin(26) + (size_t)l * DM * DM, DM, kb * 64, nb * 64, (bf16_t*)(Wb + W_O) + (size_t)nb * 64 * DM, DM, nullptr, scr, tid); continue; } r -= 256;
        if (r < 704) { const int kb = r / 44, nb = r % 44; conv_item(kin(28) + (size_t)l * DM * FF, FF, kb * 64, nb * 64, (bf16_t*)(Wb + W_FF) + (size_t)(256 * (nb >> 1) + 64 * (nb & 1)) * DM, DM, kin(27) + l * DM, scr, tid); continue; } r -= 704;
        if (r < 704) { const int kb = r / 44, nb = r % 44; conv_item(kin(29) + (size_t)l * DM * FF, FF, kb * 64, nb * 64, (bf16_t*)(Wb + W_FF) + (size_t)(256 * (nb >> 1) + 128 + 64 * (nb & 1)) * DM, DM, kin(27) + l * DM, scr, tid); continue; } r -= 704;
        { const int kb = r / 16, nb = r % 16; conv_item(kin(30) + (size_t)l * FF * DM, DM, kb * 64, nb * 64, (bf16_t*)(Wb + W_DN) + (size_t)nb * 64 * FF, FF, nullptr, scr, tid); }
    }
}
__device__ __forceinline__ void convert_small(bf16_t* sm, int tid, int bid, int G) {
    for (int idx = bid * 512 + tid; idx < NL * SMALL_PER_LAYER; idx += G * 512) {
        const int l = idx / SMALL_PER_LAYER, e = idx % SMALL_PER_LAYER; float v;
        if (e < 32768) { const int e2 = e & 16383, hd = e2 >> 12, o = (e2 >> 6) & 63, i = e2 & 63; const float* src = (e < 16384) ? kin(6) : kin(8); v = src[(size_t)((l * 4 + hd) * 64 + i) * 64 + o]; }
        else { const int e2 = e - 32768, t = (e2 >> 7) & 127, s = e2 & 127; v = (s <= t) ? kin(13)[(size_t)l * 65536 + e2] : 0.f; }
        sm[idx] = f2bf(v);
    }
}
__device__ __forceinline__ void x_pass(const float* x, bf16_t* xb, float* ssq, int lane, int gw, int NGW) {
    for (int m = gw; m < MT; m += NGW) {
        const f32x4* xr = (const f32x4*)(x + (size_t)m * DM) + lane; u32x2* o = (u32x2*)(xb + (size_t)m * DM) + lane; float ss = 0.f;
#pragma unroll
        for (int j = 0; j < 4; ++j) { const f32x4 v = xr[64 * j]; ss += (v[0] * v[0] + v[1] * v[1]) + (v[2] * v[2] + v[3] * v[3]); u32x2 w; w.x = pk2(v[0], v[1]); w.y = pk2(v[2], v[3]); o[64 * j] = w; }
        ss = wave_sum(ss, lane);
        if (lane < 16) ssq[(size_t)m * 16 + lane] = (lane == 0) ? ss : 0.f;
    }
}
__device__ __forceinline__ void qk_norm(bf16_t* proj, bf16_t* outp, int opitch, const float* qg, const float* kg, int lane, int gw, int NGW) {
    const int d0 = (lane * 8) & 63; float gq[8], gk[8];
#pragma unroll
    for (int e = 0; e < 8; ++e) { gq[e] = qg[d0 + e] * (0.125f * LOG2E); gk[e] = kg[d0 + e]; }
    for (int m = gw; m < MT; m += NGW) {
        bf16_t* base = proj + (size_t)m * PJ + 1024;
#pragma unroll
        for (int i = 0; i < 2; ++i) { const u32x4* p = (const u32x4*)(base + (lane + 64 * i) * 8); const u32x4 v = *p; u32x4* po = (u32x4*)(outp + (size_t)m * opitch + (lane + 64 * i) * 8);
            float f[8] = {bflo(v.x), bfhi(v.x), bflo(v.y), bfhi(v.y), bflo(v.z), bfhi(v.z), bflo(v.w), bfhi(v.w)};
            float ss = 0.f;
#pragma unroll
            for (int e = 0; e < 8; ++e) ss += f[e] * f[e];
            ss += shx(ss, 1, lane); ss += shx(ss, 2, lane); ss += shx(ss, 4, lane);
            const float rs = __builtin_amdgcn_rsqf(ss * (1.f / 64.f) + EPS);
#pragma unroll
            for (int e = 0; e < 8; ++e) f[e] *= rs * (i == 0 ? gq[e] : gk[e]);
            u32x4 w; w.x = pk2(f[0], f[1]); w.y = pk2(f[2], f[3]); w.z = pk2(f[4], f[5]); w.w = pk2(f[6], f[7]); *po = w; }
    }
}

constexpr int LRU_XA = 0, LRU_XP = 528, LRU_CW = 35392;
struct LruP { const float *cw, *cb, *ba, *bi, *lam; const bf16_t *waT, *wiT; };
template <bool FINAL> __device__ __forceinline__ void lru_unit(LAS unsigned char* lds, bf16_t* proj, bf16_t* outp, int opitch, float* agg, const LruP& P, int b, int chunk, int tid) {
    const int lane = tid & 63, r = lane & 31, h = lane >> 5, w = __builtin_amdgcn_readfirstlane(tid >> 6), hd = w >> 1, cbk = w & 1;
    const size_t Rb = (size_t)b * SEQ; const int t0 = chunk * 64;
    for (int c = tid; c < 67 * 32; c += 512) { const int j = c >> 5, cc = c & 31, tok = t0 - 3 + j; u32x4 v = {0u, 0u, 0u, 0u};
        if (tok >= 0) v = *(const u32x4*)(proj + (Rb + tok) * PJ + cc * 8);
        *(LAS u32x4*)(lds + LRU_XA + j * LRU_XP + cc * 16) = v; }
    LAS float* CWl = (LAS float*)(lds + LRU_CW);
    for (int i = tid; i < 1280; i += 512) CWl[i] = (i < 1024) ? P.cw[i] : P.cb[i - 1024];
    __syncthreads();
    const int oc = hd * 64 + cbk * 32 + r;
    float Hc = 0.f;
    if (FINAL) {
        const int mid = chunk >> 1, lo = h ? mid : 0, hi2 = h ? chunk : mid; float PA = 1.f, PH = 0.f;
        const f32x2* ap = (const f32x2*)agg + ((size_t)b * 256) * 256 + oc;
#pragma unroll 4
        for (int j = lo; j < hi2; ++j) { const f32x2 q = ap[(size_t)j * 256]; PH = q.x * PH + q.y; PA *= q.x; }
        const float oPA = shx(PA, 32, lane), oPH = shx(PH, 32, lane);
        Hc = h ? (PA * oPH + PH) : (oPA * PH + oPH);
        asm volatile("" : "+v"(Hc));
    }
    const float cw0 = CWl[oc], cw1 = CWl[256 + oc], cw2 = CWl[512 + oc], cw3 = CWl[768 + oc], cbv = CWl[1024 + oc];
    const float bav = P.ba[oc], biv = P.bi[oc], elam = __builtin_amdgcn_exp2f(-P.lam[oc] * LOG2E), cl = -8.f * ((elam < 0.03f) ? elam * (1.f - elam * (0.5f - elam * (0.33333334f - elam * 0.25f))) : __builtin_amdgcn_logf(1.f + elam) * 0.6931471805599453f);
    float av[2][16], bv[2][16];
#pragma unroll
    for (int rb = 0; rb < 2; ++rb) { f32x16 acca = (f32x16){}, acci = (f32x16){};
#pragma unroll
        for (int ks = 0; ks < 4; ++ks) { const int ci0 = hd * 64 + 16 * ks + 8 * h;
            const bf16x8 waf = *(const bf16x8*)(P.waT + (size_t)oc * 64 + 16 * ks + 8 * h), wif = *(const bf16x8*)(P.wiT + (size_t)oc * 64 + 16 * ks + 8 * h);
            const f32x4 c0 = *(const LAS f32x4*)(CWl + 1024 + ci0), c1 = *(const LAS f32x4*)(CWl + 1024 + ci0 + 4);
            float xc[8] = {c0[0], c0[1], c0[2], c0[3], c1[0], c1[1], c1[2], c1[3]};
#pragma unroll
            for (int tap = 0; tap < 4; ++tap) { const u32x4 xv = *(const LAS u32x4*)(lds + LRU_XA + (32 * rb + r + tap) * LRU_XP + ci0 * 2);
                const f32x4 w0 = *(const LAS f32x4*)(CWl + tap * 256 + ci0), w1 = *(const LAS f32x4*)(CWl + tap * 256 + ci0 + 4);
                xc[0] += w0[0] * bflo(xv.x); xc[1] += w0[1] * bfhi(xv.x); xc[2] += w0[2] * bflo(xv.y); xc[3] += w0[3] * bfhi(xv.y);
                xc[4] += w1[0] * bflo(xv.z); xc[5] += w1[1] * bfhi(xv.z); xc[6] += w1[2] * bflo(xv.w); xc[7] += w1[3] * bfhi(xv.w); }
            const bf16x8 af = pack8(xc[0], xc[1], xc[2], xc[3], xc[4], xc[5], xc[6], xc[7]);
            acca = MFMA32(af, waf, acca); acci = MFMA32(af, wif, acci); }
#pragma unroll
        for (int i = 0; i < 16; ++i) { const int tok = 32 * rb + crow(i, h);
            const LAS bf16_t* xp = (const LAS bf16_t*)(lds + LRU_XA + tok * LRU_XP + oc * 2);
            const float xc = cbv + cw0 * bf2f(xp[0]) + cw1 * bf2f(xp[LRU_XP / 2]) + cw2 * bf2f(xp[LRU_XP]) + cw3 * bf2f(xp[3 * LRU_XP / 2]);
            const float rg = fsigmoid(acca[i] + bav), ig = fsigmoid(acci[i] + biv), la = cl * rg;
            const float x2 = 2.f * la;
            const float em1 = (x2 > -0.03f) ? x2 * (1.f + x2 * (0.5f + x2 * (0.16666667f + x2 * 0.041666668f))) : (__builtin_amdgcn_exp2f(x2 * LOG2E) - 1.f);
            av[rb][i] = __builtin_amdgcn_exp2f(la * LOG2E); bv[rb][i] = __builtin_amdgcn_sqrtf(-em1) * ig * xc; }
#pragma unroll
        for (int i = 0; i < 16; ++i) asm volatile("" : "+v"(av[rb][i]), "+v"(bv[rb][i]));
    }
    float Ag[8], Bg[8];
#pragma unroll
    for (int k = 0; k < 8; ++k) { const int rb = k >> 2, i0 = 4 * (k & 3);
        Ag[k] = (av[rb][i0] * av[rb][i0 + 1]) * (av[rb][i0 + 2] * av[rb][i0 + 3]);
        Bg[k] = ((bv[rb][i0] * av[rb][i0 + 1] + bv[rb][i0 + 1]) * av[rb][i0 + 2] + bv[rb][i0 + 2]) * av[rb][i0 + 3] + bv[rb][i0 + 3]; }
    float myin[8]; float Pp = 1.f;
#pragma unroll
    for (int k = 0; k < 8; ++k) { const float pA = shx(Ag[k], 32, lane), pB = shx(Bg[k], 32, lane);
        const float A0 = h ? pA : Ag[k], B0 = h ? pB : Bg[k], A1 = h ? Ag[k] : pA, B1 = h ? Bg[k] : pB;
        const float in0 = Hc; Hc = A0 * Hc + B0; const float in1 = Hc; Hc = A1 * Hc + B1; myin[k] = h ? in1 : in0; Pp *= A0 * A1; }
    if (!FINAL) { if (h == 0) { f32x2 q; q.x = Pp; q.y = Hc; ((f32x2*)agg)[((size_t)b * 256 + chunk) * 256 + oc] = q; } }
    else {
#pragma unroll
        for (int k = 0; k < 8; ++k) { const int rb = k >> 2, i0 = 4 * (k & 3); float hh = myin[k];
#pragma unroll
            for (int j = 0; j < 4; ++j) { hh = av[rb][i0 + j] * hh + bv[rb][i0 + j]; const int tok = 32 * rb + 8 * (k & 3) + 4 * h + j;
                const bf16_t* gp = proj + (Rb + t0 + tok) * PJ + 256 + oc; const float ga = bf2f(*gp); bf16_t* go = outp + (Rb + t0 + tok) * opitch + oc;
                const float z = 1.5957691216057308f * (ga + 0.044715f * ga * ga * ga);
                *go = f2bf(hh * ga * fsigmoid(z)); }
            asm volatile("" ::: "memory"); }
    }
    __syncthreads();
}

constexpr int SG_VP = 272;
struct SgP { const float *lng, *lnb, *sgb; const bf16_t* sgw; };
__device__ __forceinline__ void sg_unit(LAS unsigned char* lds, bf16_t* proj, bf16_t* outp, int opitch, const SgP& P, int n, int tid) {
    const int lane = tid & 63, r = lane & 31, h = lane >> 5, w = __builtin_amdgcn_readfirstlane(tid >> 6);
    const size_t R0 = (size_t)n * 128;
    { const f32x4 g4 = *(const f32x4*)(P.lng + lane * 4), b4 = *(const f32x4*)(P.lnb + lane * 4);
      for (int rr = 0; rr < 16; ++rr) { const int t = w * 16 + rr; const u32x2 raw = *(const u32x2*)(proj + (R0 + t) * PJ + 768 + lane * 4);
        float v[4] = {bflo(raw.x), bfhi(raw.x), bflo(raw.y), bfhi(raw.y)};
        const float mean = wave_sum((v[0] + v[1]) + (v[2] + v[3]), lane) * (1.f / 256.f);
#pragma unroll
        for (int e = 0; e < 4; ++e) v[e] -= mean;
        const float var = wave_sum((v[0] * v[0] + v[1] * v[1]) + (v[2] * v[2] + v[3] * v[3]), lane) * (1.f / 256.f);
        const float rs = __builtin_amdgcn_rsqf(var + EPS);
#pragma unroll
        for (int e = 0; e < 4; ++e) *(LAS bf16_t*)(lds + (lane * 4 + e) * SG_VP + t * 2) = f2bf(v[e] * rs * g4[e] + b4[e]); } }
    __syncthreads();
    const int g = w >> 1, cbk = w & 1, c = g * 64 + cbk * 32 + r;
#pragma unroll
    for (int tb = 0; tb < 4; ++tb) { f32x16 acc = (f32x16){};
        const bf16_t* wp = P.sgw + (size_t)(g * 128 + 32 * tb + r) * 128 + 8 * h;
#pragma unroll
        for (int ks = 0; ks < 2 * tb + 2; ++ks) { const bf16x8 af = *(const bf16x8*)(wp + 16 * ks); const bf16x8 bfr = *(const LAS bf16x8*)(lds + c * SG_VP + (16 * ks + 8 * h) * 2); acc = MFMA32(af, bfr, acc); }
#pragma unroll
        for (int i = 0; i < 16; ++i) { const int t = 32 * tb + crow(i, h); const bf16_t* up = proj + (R0 + t) * PJ + 512 + c; outp[(R0 + t) * opitch + c] = f2bf(bf2f(*up) * (acc[i] + P.sgb[g * 128 + t])); } }
    __syncthreads();
}

constexpr int AT_SLOT = 16384, AT_K = 0, AT_V = 4 * AT_SLOT, AT_TAB = 131072 + 1024;
__device__ __forceinline__ void glds16(const void* gsrc, unsigned lds_dst) {
    unsigned keep;
    asm volatile("s_mov_b32 %0, m0\n\ts_mov_b32 m0, %2\n\ts_nop 0\n\tglobal_load_lds_dwordx4 %1, off\n\ts_mov_b32 m0, %0" : "=&s"(keep) : "v"(gsrc), "s"(lds_dst) : "memory");
}
__device__ __forceinline__ void at_qk(f32x16& p0, f32x16& p1, const LAS unsigned char* lk, const int (&koff)[4], const bf16x8 (&qf)[4]) {
    const f32x16 z = (f32x16){};
#pragma unroll
    for (int ks = 0; ks < 4; ++ks) { const bf16x8 a0 = *(const LAS bf16x8*)(lk + koff[ks]), a1 = *(const LAS bf16x8*)(lk + koff[ks] + 8192);
        p0 = MFMA32(a0, qf[ks], ks == 0 ? z : p0); p1 = MFMA32(a1, qf[ks], ks == 0 ? z : p1); }
}
__device__ __forceinline__ void at_bias(f32x16& p0, f32x16& p1, const LAS float* tb) {
#pragma unroll
    for (int i = 0; i < 16; ++i) { const int kk = (i & 3) + 8 * (i >> 2); p0[i] += tb[kk]; p1[i] += tb[32 + kk]; }
}
template <bool DOQK, int VAR> __device__ __forceinline__ void at_fused(f32x16& pn0, f32x16& pn1, f32x16& pc0, f32x16& pc1, f32x16 (&o)[4], float& lsum,
                                         const LAS unsigned char* lk, const LAS unsigned char* lv, const int (&koff)[4], const int (&voff)[4], const bf16x8 (&qf)[4]) {
    constexpr int PD = 4, NF = PD + 1;
    bf16x8 fr[NF], pf[4];
#define AT_FRAG(g) ((VAR == 4) ? qf[(g) & 3] : (((g) < 8) ? *(const LAS bf16x8*)(lk + koff[(g) >> 1] + ((g) & 1) * 8192) : *(const LAS bf16x8*)(lv + voff[((g) - 8) >> 2] + (((g) - 8) & 3) * 4096)))
#define AT_EX2(x) ((VAR == 1) ? (x) : __builtin_amdgcn_exp2f(x))
#define AT_EXP(e) do { if ((e) < 16) { pc0[(e)] = AT_EX2(pc0[(e)]); s0 += pc0[(e)]; } else { pc1[(e) - 16] = AT_EX2(pc1[(e) - 16]); s1 += pc1[(e) - 16]; } } while (0)
#pragma unroll
    for (int g = 0; g < PD; ++g) { if (DOQK || g >= 8) fr[g % NF] = AT_FRAG(g); else fr[g % NF] = (bf16x8){}; }
    float s0 = 0.f, s1 = 0.f;
    const f32x16 z = (f32x16){};
#pragma unroll
    for (int g = 0; g < 24; ++g) {
        if (g + PD < 24 && (DOQK || g + PD >= 8)) fr[(g + PD) % NF] = AT_FRAG(g + PD);
        if (g < 8) { const int ks = g >> 1;
            if (!DOQK || VAR == 2) {} else if (g & 1) pn1 = MFMA32(fr[g % NF], qf[ks], ks == 0 ? z : pn1); else pn0 = MFMA32(fr[g % NF], qf[ks], ks == 0 ? z : pn0);
        } else if (VAR != 2) { const int sp = (g - 8) >> 2, db = (g - 8) & 3; o[db] = MFMA32(fr[g % NF], pf[sp], o[db]); }
        else { const int sp = (g - 8) >> 2; asm volatile("" :: "v"(fr[g % NF]), "v"(pf[sp])); }
        if (g < 16) { AT_EXP(2 * g); AT_EXP(2 * g + 1); asm volatile("" : "+v"(s0), "+v"(s1)); }
        if (g == 3) pf[0] = pack8(pc0[0], pc0[1], pc0[2], pc0[3], pc0[4], pc0[5], pc0[6], pc0[7]);
        if (g == 7) pf[1] = pack8(pc0[8], pc0[9], pc0[10], pc0[11], pc0[12], pc0[13], pc0[14], pc0[15]);
        if (g == 11) pf[2] = pack8(pc1[0], pc1[1], pc1[2], pc1[3], pc1[4], pc1[5], pc1[6], pc1[7]);
        if (g == 15) pf[3] = pack8(pc1[8], pc1[9], pc1[10], pc1[11], pc1[12], pc1[13], pc1[14], pc1[15]);
        __builtin_amdgcn_sched_barrier(0);
    }
    lsum += s0 + s1;
#undef AT_FRAG
#undef AT_EXP
#undef AT_EX2
}
template <int VAR> __device__ __forceinline__ void attn_unit(LAS unsigned char* lds, const bf16_t* proj, const bf16_t* vt, bf16_t* outp, int opitch, int b, int hd, int qb, float lam, float osc, const float* relb, const float* subg, int tid_in) {
    int tid = tid_in; asm volatile("" : "+v"(tid));
    const int lane = tid & 63, r = lane & 31, h = lane >> 5, w = __builtin_amdgcn_readfirstlane(tid >> 6), mp = w >> 2, rs = w & 3;
    LAS float* tab = (LAS float*)(lds + AT_TAB);
    const size_t Rb = (size_t)b * SEQ, R0 = Rb + (size_t)qb * 128;
    const int NT = 2 * qb + 2;
    const bool deep = NT >= 8;
    const int rk0 = 8 * w + (lane >> 4), rk1 = rk0 + 4, rv0 = 16 * w + (lane >> 3), rv1 = rv0 + 8;
    const bf16_t* ks0 = proj + (Rb + rk0) * PJ + 1536 + hd * 128 + (((lane & 15) ^ (rk0 & 15)) * 8);
    const bf16_t* ks1 = proj + (Rb + rk1) * PJ + 1536 + hd * 128 + (((lane & 15) ^ (rk1 & 15)) * 8);
    const bf16_t* vs0 = vt + ((size_t)((b * 4 + hd) * 128 + rv0)) * SEQ + (((lane & 7) ^ ((rv0 >> 1) & 7)) * 8);
    const bf16_t* vs1 = vt + ((size_t)((b * 4 + hd) * 128 + rv1)) * SEQ + (((lane & 7) ^ ((rv1 >> 1) & 7)) * 8);
    const unsigned ldsb = (unsigned)(uintptr_t)lds, kd = ldsb + AT_K + w * 2048, vd = ldsb + AT_V + w * 2048;
#define AT_ISSUE_K(j) do { const unsigned d_ = (unsigned)__builtin_amdgcn_readfirstlane(kd + ((j) & 3) * AT_SLOT); if (VAR != 3) { glds16(ks0 + (size_t)(j) * 64 * PJ, d_); glds16(ks1 + (size_t)(j) * 64 * PJ, d_ + 1024u); } } while (0)
#define AT_ISSUE_V(j) do { const unsigned d_ = (unsigned)__builtin_amdgcn_readfirstlane(vd + ((j) & 3) * AT_SLOT); if (VAR != 3) { glds16(vs0 + (j) * 64, d_); glds16(vs1 + (j) * 64, d_ + 1024u); } } while (0)
#define AT_WAITBAR(N) asm volatile("s_waitcnt vmcnt(" #N ") lgkmcnt(0)\n\ts_barrier" ::: "memory")
    AT_ISSUE_K(0); AT_ISSUE_K(1); AT_ISSUE_V(0);
    if (2 < NT) AT_ISSUE_K(2);
    AT_ISSUE_V(1);
    if (3 < NT) AT_ISSUE_K(3);
    if (2 < NT) AT_ISSUE_V(2);
    { const float cfar = relb[15 * 4 + hd];
      if (tid < 64) tab[1216 + tid] = -INFINITY;
      for (int idx = tid; idx < 1216; idx += 512) { const int rel = idx - 1151, n = rel < 0 ? -rel : rel; int bk = (n < 8) ? n : (5 + (31 - __builtin_clz(n))); bk = bk > 15 ? 15 : bk; if (rel > 0) bk += 16; tab[idx] = (relb[bk * 4 + hd] - cfar) * LOG2E; } }
    bf16x8 qf[4];
    { const bf16_t* qp = proj + (R0 + 32 * rs + r) * PJ + 1024 + hd * 128 + mp * 64 + 8 * h;
#pragma unroll
      for (int ks = 0; ks < 4; ++ks) qf[ks] = *(const bf16x8*)(qp + 16 * ks); }
    int koff[4], voff[4];
    { const int kx = (mp * 8 + h) ^ (r & 15), vx = h ^ ((r >> 1) & 7);
#pragma unroll
      for (int i = 0; i < 4; ++i) { koff[i] = r * 256 + ((kx ^ (2 * i)) << 4); voff[i] = r * 128 + ((vx ^ (2 * i)) << 4); } }
    if (deep) AT_WAITBAR(8); else AT_WAITBAR(0);
    f32x16 o[4]; o[0] = (f32x16){}; o[1] = (f32x16){}; o[2] = (f32x16){}; o[3] = (f32x16){};
    float lsum = 0.f;
    const int qpos = qb * 128 + 32 * rs + r;
    const LAS float* tb0 = tab + (1151 + 4 * h - qpos);
    f32x16 pa0, pa1, pb0, pb1;
    pb0 = (f32x16){}; pb1 = (f32x16){};
    at_qk(pa0, pa1, lds + AT_K, koff, qf);
    if (1088 > qb * 128) at_bias(pa0, pa1, tb0);
    asm volatile("s_waitcnt lgkmcnt(0)\n\ts_barrier" ::: "memory");
#define AT_STEP(t, C0, C1, N0, N1) do { \
        if ((t) + 4 < NT) AT_ISSUE_K((t) + 4); \
        if ((t) + 3 < NT) AT_ISSUE_V((t) + 3); \
        at_fused<true, VAR>(N0, N1, C0, C1, o, lsum, lds + AT_K + (((t) + 1) & 3) * AT_SLOT, lds + AT_V + ((t) & 3) * AT_SLOT, koff, voff, qf); \
        if (((t) + 1) * 64 + 1088 > qb * 128) at_bias(N0, N1, (rs < 2 && (t) + 2 == NT) ? (const LAS float*)(tab + 1216) : tb0 + ((t) + 1) * 64); \
        if ((t) + 4 < NT) AT_WAITBAR(8); else AT_WAITBAR(0); } while (0)
    for (int t = 0; t + 2 < NT; t += 2) {
        AT_STEP(t, pa0, pa1, pb0, pb1);
        AT_STEP(t + 1, pb0, pb1, pa0, pa1);
    }
    AT_STEP(NT - 2, pa0, pa1, pb0, pb1);
    at_fused<false, VAR>(pa0, pa1, pb0, pb1, o, lsum, lds + AT_K, lds + AT_V + ((NT - 1) & 3) * AT_SLOT, koff, voff, qf);
    __syncthreads();
#undef AT_STEP
#undef AT_ISSUE_K
#undef AT_ISSUE_V
#undef AT_WAITBAR
    int lane_e = tid & 63; asm volatile("" : "+v"(lane_e));
    lsum += shx(lsum, 32, lane_e);
    const float inv = __builtin_amdgcn_rcpf(lsum);
    LAS float* ex = (LAS float*)lds;
    if (mp == 1) {
#pragma unroll
        for (int db = 0; db < 4; ++db)
#pragma unroll
            for (int i = 0; i < 16; ++i) ex[((rs * 4 + db) * 16 + i) * 64 + lane_e] = o[db][i] * inv;
    }
    __syncthreads();
    if (mp == 0) {
        float ss = 0.f;
#pragma unroll
        for (int db = 0; db < 4; ++db)
#pragma unroll
            for (int i = 0; i < 16; ++i) { const float v = o[db][i] * inv - lam * ex[((rs * 4 + db) * 16 + i) * 64 + lane_e]; o[db][i] = v; ss += v * v; }
        ss += shx(ss, 32, lane_e);
        const float rsn = __builtin_amdgcn_rsqf(ss * (1.f / 128.f) + EPS) * osc;
        const int r_e = lane_e & 31, h_e = lane_e >> 5; bf16_t* op = outp + (R0 + 32 * rs + r_e) * opitch + hd * 128;
#pragma unroll
        for (int db = 0; db < 4; ++db)
#pragma unroll
            for (int i4 = 0; i4 < 4; ++i4) { const int d = 32 * db + 8 * i4 + 4 * h_e; const f32x4 g4 = *(const f32x4*)(subg + d);
                u32x2 wv; wv.x = pk2(o[db][4 * i4] * rsn * g4[0], o[db][4 * i4 + 1] * rsn * g4[1]); wv.y = pk2(o[db][4 * i4 + 2] * rsn * g4[2], o[db][4 * i4 + 3] * rsn * g4[3]);
                *(u32x2*)(op + d) = wv; }
    }
    __syncthreads();
}

__global__ void __launch_bounds__(512, 2) mega_fwd(Args a) {
    extern __shared__ __attribute__((aligned(16))) unsigned char lds_raw[];
    cg::grid_group grid = cg::this_grid();
    LAS unsigned char* lds = (LAS unsigned char*)lds_raw;
    const int G = gridDim.x, bid = blockIdx.x;
    const int wave = __builtin_amdgcn_readfirstlane(threadIdx.x >> 6);
#define IS_T0(v) bool v; { int l_; asm volatile("v_mbcnt_lo_u32_b32 %0, -1, 0\n\tv_mbcnt_hi_u32_b32 %0, -1, %0" : "=v"(l_)); v = (wave == 0) && (l_ == 0); }
    { IS_T0(t0_); if (t0_) { ((LAS unsigned*)(lds + MISC_OFF))[8] = 0u; ((LAS unsigned*)(lds + MISC_OFF))[9] = 0u; } __syncthreads();
      (void)xcd_barrier_post((unsigned*)kin(32) + CW_BAR, (volatile LAS unsigned*)(lds + MISC_OFF) + 8, t0_); }
#define GRID_BAR() do { XcdBarrier b_; b_.bar = (unsigned*)kin(32) + CW_BAR; b_.x = xb_xcc_id(); b_.st = (volatile LAS unsigned*)(lds + MISC_OFF) + 8; IS_T0(t0_); xcd_barrier(b_, t0_); } while (0)
#define PH_BEGIN int tid, bidp = bid, Gp = G; { int l_; asm volatile("v_mbcnt_lo_u32_b32 %0, -1, 0\n\tv_mbcnt_hi_u32_b32 %0, -1, %0" : "=v"(l_)); asm volatile("" : "+s"(bidp), "+s"(Gp)); tid = wave * 64 + l_; }
#define WSB(off) ((unsigned char*)kin(32) + (off))
#define ssqA ((float*)WSB(WS_SSQA))
#define ssqB ((float*)WSB(WS_SSQB))
#define agg ((float*)WSB(WS_AGG))
#define sm ((bf16_t*)WSB(WS_SMALL))
#define xb ((bf16_t*)WSB(WS_XB))
#define merged ((bf16_t*)WSB(WS_XB))
#define proj ((bf16_t*)WSB(WS_PROJ))
#define xb2 ((bf16_t*)WSB(WS_PROJ))
#define vt ((bf16_t*)WSB(WS_VT))
#define gates ((bf16_t*)WSB(WS_GATES))
#define hid ((bf16_t*)WSB(WS_GATES))
#define out ((float*)kin(31))
#define ws WSB(0)

    { PH_BEGIN; convert_layer(0, ws + WS_W0, (LAS float*)lds, tid, bidp, Gp);
      convert_small(sm, tid, bidp, Gp);
      x_pass(kin(0), xb, ssqA, tid & 63, bidp * 8 + wave, Gp * 8); }
    grid.sync();

    for (int l = 0; l < NL; ++l) {
#define WL(off) (ws + WS_W0 + (size_t)(l & 1) * WS_WSZ + (off))
#ifndef NO_A
        {
            PH_BEGIN;
            pg8::Gemm g{xb, (const bf16_t*)WL(W_IN), MT, INC, DM, DM}; pg8::StaticOrder S; S.init(MT, INC, Gp, bidp);
            pg8::EpiInProj E{proj, vt, gates, ssqA, kin(3) + l * 3072};
            pg8::gemm_phase<pg8::EpiInProj, pg8::StaticOrder, true, true>(lds, g, S, E, tid);
#ifdef PROBE_A
            pg8::gemm_phase<pg8::EpiInProj, pg8::StaticOrder, true, true>(lds, g, S, E, tid);
#endif
        }
#endif
        GRID_BAR();
        {
            PH_BEGIN; const int lane = tid & 63, gw = bidp * 8 + wave, NGW = Gp * 8;
            const bf16_t* sml = sm + (size_t)l * SMALL_PER_LAYER;
#if defined(PROBE_B) && PROBE_B == 3
            { LruP LP{kin(4) + l * 1024, kin(5) + l * 256, kin(7) + l * 256, kin(9) + l * 256, kin(10) + l * 256, sml, sml + 16384};
              for (int u = bidp; u < 512; u += Gp) lru_unit<false>(lds, proj, proj, PJ, agg, LP, u >> 8, u & 255, tid); }
            if (l + 1 < NL) convert_layer(l + 1, ws + WS_W0 + (size_t)((l + 1) & 1) * WS_WSZ, (LAS float*)lds, tid, bidp, Gp);
#elif defined(PROBE_B)
#if PROBE_B == 1
            qk_norm(proj, xb, 1024, kin(15) + l * 64, kin(16) + l * 64, lane, gw, NGW);
#endif
            { LruP LP{kin(4) + l * 1024, kin(5) + l * 256, kin(7) + l * 256, kin(9) + l * 256, kin(10) + l * 256, sml, sml + 16384};
              for (int u = bidp; u < 512; u += Gp) lru_unit<false>(lds, proj, proj, PJ, agg, LP, u >> 8, u & 255, tid); }
            { SgP SP{kin(11) + l * 256, kin(12) + l * 256, kin(14) + l * 512, sml + 32768};
              for (int u = bidp; u < 256; u += Gp) sg_unit(lds, proj, xb, 1024, SP, u, tid); }
#if PROBE_B == 1
            if (l + 1 < NL) convert_layer(l + 1, ws + WS_W0 + (size_t)((l + 1) & 1) * WS_WSZ, (LAS float*)lds, tid, bidp, Gp);
#endif
#endif
            qk_norm(proj, proj + 1024, PJ, kin(15) + l * 64, kin(16) + l * 64, lane, gw, NGW);
            { LruP LP{kin(4) + l * 1024, kin(5) + l * 256, kin(7) + l * 256, kin(9) + l * 256, kin(10) + l * 256, sml, sml + 16384};
              for (int u = bidp; u < 512; u += Gp) lru_unit<false>(lds, proj, proj, PJ, agg, LP, u >> 8, u & 255, tid); }
            { SgP SP{kin(11) + l * 256, kin(12) + l * 256, kin(14) + l * 512, sml + 32768};
              for (int u = bidp; u < 256; u += Gp) sg_unit(lds, proj, proj + 512, PJ, SP, u, tid); }
            if (l + 1 < NL) convert_layer(l + 1, ws + WS_W0 + (size_t)((l + 1) & 1) * WS_WSZ, (LAS float*)lds, tid, bidp, Gp);
        }
        GRID_BAR();
        {
            PH_BEGIN; const int lane = tid & 63;
            float d1 = kin(17)[l * 64 + lane] * kin(18)[l * 64 + lane], d2 = kin(19)[l * 64 + lane] * kin(20)[l * 64 + lane];
            d1 = wave_sum(d1, lane); d2 = wave_sum(d2, lane);
            const float lam_init = 0.8f - 0.6f * __builtin_amdgcn_exp2f(-0.3f * LOG2E * (float)l);
            const float lam = __builtin_amdgcn_exp2f(d1 * LOG2E) - __builtin_amdgcn_exp2f(d2 * LOG2E) + lam_init;
            const float* relb = kin(22); const float* subg = kin(21) + l * 128;
#ifndef NO_ATT
#ifdef PROBE_ATT
            if (Gp == 256) {
                const int vcu = (bidp % 8) * 32 + bidp / 8, bh = vcu >> 5, s = vcu & 31;
#define ATT_OUT xb, 1024
                for (int i = 0; i < 4; ++i) { const int qb = (i == 0) ? 127 - s : (i == 1) ? 95 - s : (i == 2) ? 32 + s : s; attn_unit<PROBE_ATT>(lds, proj, vt, ATT_OUT, bh >> 2, bh & 3, qb, lam, 1.f - lam_init, relb, subg, tid); }
#undef ATT_OUT
            }
#endif
#define ATT_OUT proj + 1024, PJ
            if (Gp == 256) {
                const int vcu = (bidp % 8) * 32 + bidp / 8, bh = vcu >> 5, s = vcu & 31;
                for (int i = 0; i < 4; ++i) { const int qb = (i == 0) ? 127 - s : (i == 1) ? 95 - s : (i == 2) ? 32 + s : s; attn_unit<0>(lds, proj, vt, ATT_OUT, bh >> 2, bh & 3, qb, lam, 1.f - lam_init, relb, subg, tid); }
            } else {
                for (int u = bidp; u < 1024; u += Gp) attn_unit<0>(lds, proj, vt, ATT_OUT, u >> 9, (u >> 7) & 3, u & 127, lam, 1.f - lam_init, relb, subg, tid);
            }
#endif
            { const bf16_t* sml = sm + (size_t)l * SMALL_PER_LAYER;
              LruP LP{kin(4) + l * 1024, kin(5) + l * 256, kin(7) + l * 256, kin(9) + l * 256, kin(10) + l * 256, sml, sml + 16384};
#if defined(PROBE_B) && PROBE_B != 3
              for (int u = bidp; u < 512; u += Gp) lru_unit<true>(lds, proj, xb, 1024, agg, LP, u >> 8, u & 255, tid);
#endif
              for (int u = bidp; u < 512; u += Gp) lru_unit<true>(lds, proj, proj + 256, PJ, agg, LP, u >> 8, u & 255, tid); }
        }
        GRID_BAR();
#ifndef NO_C1
        { PH_BEGIN; pg8::StaticOrder S; S.init(MT, DM, Gp, bidp); pg8::Gemm g{proj + 256, (const bf16_t*)WL(W_PA), MT, DM, 256, PJ}; pg8::EpiMerge<0> E{gates, merged}; pg8::gemm_phase<pg8::EpiMerge<0>, pg8::StaticOrder, true, true>(lds, g, S, E, tid); }
        { PH_BEGIN; pg8::StaticOrder S; S.init(MT, DM, Gp, bidp); pg8::Gemm g{proj + 512, (const bf16_t*)WL(W_PB), MT, DM, 256, PJ}; pg8::EpiMerge<1> E{gates, merged}; pg8::gemm_phase<pg8::EpiMerge<1>, pg8::StaticOrder, true, true>(lds, g, S, E, tid); }
        { PH_BEGIN; pg8::StaticOrder S; S.init(MT, DM, Gp, bidp); pg8::Gemm g{proj + 1024, (const bf16_t*)WL(W_PC), MT, DM, 512, PJ}; pg8::EpiMerge<2> E{gates, merged}; pg8::gemm_phase<pg8::EpiMerge<2>, pg8::StaticOrder, true, true>(lds, g, S, E, tid); }
#ifdef PROBE_C1
        { PH_BEGIN; pg8::StaticOrder S; S.init(MT, DM, Gp, bidp); pg8::Gemm g{proj + 256, (const bf16_t*)WL(W_PA), MT, DM, 256, PJ}; pg8::EpiMerge<0> E{gates, merged}; pg8::gemm_phase<pg8::EpiMerge<0>, pg8::StaticOrder, true, true>(lds, g, S, E, tid); }
        { PH_BEGIN; pg8::StaticOrder S; S.init(MT, DM, Gp, bidp); pg8::Gemm g{proj + 512, (const bf16_t*)WL(W_PB), MT, DM, 256, PJ}; pg8::EpiMerge<1> E{gates, merged}; pg8::gemm_phase<pg8::EpiMerge<1>, pg8::StaticOrder, true, true>(lds, g, S, E, tid); }
        { PH_BEGIN; pg8::StaticOrder S; S.init(MT, DM, Gp, bidp); pg8::Gemm g{proj + 1024, (const bf16_t*)WL(W_PC), MT, DM, 512, PJ}; pg8::EpiMerge<2> E{gates, merged}; pg8::gemm_phase<pg8::EpiMerge<2>, pg8::StaticOrder, true, true>(lds, g, S, E, tid); }
#endif
#endif
        GRID_BAR();
#ifndef NO_C2
        {
            PH_BEGIN;
            pg8::Gemm g{merged, (const bf16_t*)WL(W_O), MT, DM, DM, DM}; pg8::StaticOrder S; S.init(MT, DM, Gp, bidp);
#ifdef PROBE_C24
            { pg8::EpiResid E0{(l == 0) ? kin(0) : out, (float*)gates, xb2, ssqB}; pg8::gemm_phase<pg8::EpiResid, pg8::StaticOrder, true, true>(lds, g, S, E0, tid); }
#endif
            pg8::EpiResid E{(l == 0) ? kin(0) : out, out, xb2, ssqB};
            pg8::gemm_phase<pg8::EpiResid, pg8::StaticOrder, true, true>(lds, g, S, E, tid);
        }
#endif
        GRID_BAR();
#ifndef NO_C3
        {
            PH_BEGIN;
            pg8::Gemm g{xb2, (const bf16_t*)WL(W_FF), MT, 2 * FF, DM, DM}; pg8::StaticOrder S; S.init(MT, 2 * FF, Gp, bidp);
            pg8::EpiFfn1 E{hid, ssqB};
            pg8::gemm_phase<pg8::EpiFfn1, pg8::StaticOrder, true, true>(lds, g, S, E, tid);
#ifdef PROBE_C3
            pg8::gemm_phase<pg8::EpiFfn1, pg8::StaticOrder, true, true>(lds, g, S, E, tid);
#endif
        }
#endif
        GRID_BAR();
#ifndef NO_C4
        {
            PH_BEGIN;
            pg8::Gemm g{hid, (const bf16_t*)WL(W_DN), MT, DM, FF, FF}; pg8::StaticOrder S; S.init(MT, DM, Gp, bidp);
#ifdef PROBE_C24
            { pg8::EpiResid E0{out, (float*)proj, xb, ssqA}; pg8::gemm_phase<pg8::EpiResid, pg8::StaticOrder, true, true>(lds, g, S, E0, tid); }
#endif
            pg8::EpiResid E{out, out, xb, ssqA};
            pg8::gemm_phase<pg8::EpiResid, pg8::StaticOrder, true, true>(lds, g, S, E, tid);
        }
#endif
        if (l + 1 < NL) GRID_BAR();
    }
}
#undef WL
#undef GRID_BAR
#undef IS_T0
#undef PH_BEGIN
#undef ws
#undef out
#undef hid
#undef gates
#undef vt
#undef xb2
#undef proj
#undef merged
#undef xb
#undef sm
#undef agg
#undef ssqB
#undef ssqA
extern "C" void kernel_launch(void* const* d_in, const int* in_sizes, int n_in, void* d_out, int out_size, void* d_ws, size_t ws_size, hipStream_t stream) {
    static int grid = 0;
    if (grid == 0) {
        if (n_in != 31 || out_size != MT * DM || ws_size < WS_END) { fprintf(stderr, "kernel_launch: unexpected shapes (n_in %d out %d ws %zu)\n", n_in, out_size, ws_size); grid = -1; return; }
        int dev = 0, cus = 0, per_cu = 0;
        hipGetDevice(&dev); hipDeviceGetAttribute(&cus, hipDeviceAttributeMultiprocessorCount, dev);
        if (hipFuncSetAttribute((const void*)mega_fwd, hipFuncAttributeMaxDynamicSharedMemorySize, LDS_BYTES) != hipSuccess) { fprintf(stderr, "kernel_launch: hipFuncSetAttribute failed\n"); grid = -1; return; }
        if (hipOccupancyMaxActiveBlocksPerMultiprocessor(&per_cu, (const void*)mega_fwd, 512, LDS_BYTES) != hipSuccess || per_cu < 1) { fprintf(stderr, "kernel_launch: occupancy query says %d\n", per_cu); per_cu = 1; }
        (void)hipGetLastError();
        grid = cus;
    }
    if (grid < 0) return;
    if (hipMemsetAsync(d_ws, 0, CTL_ZERO_BYTES, stream) != hipSuccess) { fprintf(stderr, "kernel_launch: memset failed\n"); return; }
    Args a{};
    for (int i = 0; i < 31; ++i) a.in[i] = (const float*)d_in[i];
    a.out = (float*)d_out; a.ws = (unsigned char*)d_ws;
    void* args[] = {&a};
    hipError_t e = hipLaunchCooperativeKernel((const void*)mega_fwd, dim3(grid), dim3(512), args, LDS_BYTES, stream);
    if (e != hipSuccess) fprintf(stderr, "cooperative launch failed: %s (grid %d)\n", hipGetErrorString(e), grid);
}
```

```cpp
#include <hip/hip_runtime.h>
#include <hip/hip_cooperative_groups.h>
#include <hip/hip_bf16.h>
#include <cstdio>
#include <cstdint>
#include <cmath>
namespace cg = cooperative_groups;
namespace pg8 {
#define PG8_LAS __attribute__((address_space(3)))
typedef unsigned short bf16_t;
typedef short bf16x8 __attribute__((ext_vector_type(8)));
typedef float f32x4 __attribute__((ext_vector_type(4)));
typedef unsigned u32x4 __attribute__((ext_vector_type(4)));
constexpr int BM = 256, BK = 64, HALF = 128, HTB = HALF * BK * 2  , STAGE_BYTES = 8 * HTB, NXCD = 8, WGM = 8;

__host__ __device__ __forceinline__ int lds_byte(int r, int c) { const int st = (r >> 4) * 2 + (c >> 5), rr = r & 15, cc = c & 31, ob = rr * 64 + cc * 2; return st * 1024 + (ob ^ (((ob >> 9) & 1) << 5)); }
__host__ __device__ __forceinline__ void stage_rc(int b, int& R, int& C) { const int st = b / 1024, sb = b % 1024, swz = sb ^ (((sb >> 9) & 1) << 5); R = (st >> 1) * 16 + swz / 64; C = (st & 1) * 32 + (swz % 64) / 2; }
__host__ __device__ __forceinline__ int perm32(int rho) { const int n = rho >> 4, i = rho & 15; return 8 * (i >> 2) + 4 * n + (i & 3); }

struct Unit { int pm, pn; };
struct Gemm { const bf16_t* A; const bf16_t* Bt; int M, N, K, lda; };

struct StaticOrder {
    int nM, nN, nwg, G, c;
    __host__ __device__ void init(int M, int N, int G_, int c_) { nM = M / BM; nN = N / BM; nwg = nM * nN; G = G_; c = c_; }
    __host__ __device__ bool next(int i, Unit& u) const {
        const long L = (long)i * G + c; if (L >= nwg) return false;
        int wgid = (int)L; { const int q = nwg / NXCD, r = nwg % NXCD, xcd = wgid % NXCD, off = wgid / NXCD; wgid = (xcd < r ? xcd * (q + 1) : r * (q + 1) + (xcd - r) * q) + off; }
        const int nig = WGM * nN, gid = wgid / nig, fm = gid * WGM, gsz = (nM - fm) < WGM ? (nM - fm) : WGM;
        u.pm = fm + ((wgid % nig) % gsz); u.pn = (wgid % nig) / gsz; return true;
    }
    __device__ __forceinline__ void a_ready(const Unit&) const {}
    __device__ __forceinline__ void done(const Unit&) const {}
};

template <class Epi, class Sched, bool ALIGN_EPI = false, bool SP2 = false>
__device__ __forceinline__ void gemm_phase(PG8_LAS unsigned char* lds, const Gemm g, const Sched& S, const Epi& E, const int tid) {
    const int wid = __builtin_amdgcn_readfirstlane(tid >> 6), lane = tid & 63, wr = wid >> 2, wc = wid & 3, fr = lane & 15, fq = lane >> 4;
    const int K = g.K, nt = K / BK;
    unsigned voffA[2], voffB[2];
#pragma unroll
    for (int i = 0; i < 2; ++i) { int R, C; stage_rc(tid * 16 + i * 8192, R, C); const int Rb = Epi::PERM ? ((R & ~31) + perm32(R & 31)) : R;
        voffA[i] = (unsigned)(R * g.lda + C) * 2u; voffB[i] = (unsigned)(Rb * K + C) * 2u; }
    const size_t kstep = (size_t)(BK * 2);
    const size_t hstepA = (size_t)HALF * g.lda * 2, hstepB = (size_t)HALF * K * 2;
    const size_t tstepA = 2 * hstepA, tstepB = 2 * hstepB;
    const unsigned ldsw = (unsigned)wid * 1024u;
    const int aoff = lds_byte(wr * 64 + fr, fq * 8), boff = lds_byte(wc * 32 + fr, fq * 8);
#define PG8_SA(b, h) (((b) * 2 + (h)) * HTB)
#define PG8_SB(b, h) ((4 + (b) * 2 + (h)) * HTB)
#define PG8_STAGE(bufoff, gbase, voff) do { _Pragma("unroll") for (int _i = 0; _i < 2; ++_i) \
        __builtin_amdgcn_global_load_lds((const unsigned*)((const char*)(gbase) + (voff)[_i]), (PG8_LAS unsigned*)(lds + (bufoff) + ldsw + _i * 8192), 16, 0, 0); } while (0)
#define PG8_LDA(dst, b, h) do { _Pragma("unroll") for (int m = 0; m < 4; ++m) _Pragma("unroll") for (int k = 0; k < 2; ++k) dst[m][k] = *(const PG8_LAS bf16x8*)(lds + PG8_SA(b, h) + aoff + m * 2048 + k * 1024); } while (0)
#define PG8_LDB(dst, b, h) do { _Pragma("unroll") for (int n = 0; n < 2; ++n) _Pragma("unroll") for (int k = 0; k < 2; ++k) dst[n][k] = *(const PG8_LAS bf16x8*)(lds + PG8_SB(b, h) + boff + n * 2048 + k * 1024); } while (0)
#define PG8_MMA(ai, bj, At, Bt) do { __builtin_amdgcn_s_setprio(1); _Pragma("unroll") for (int m = 0; m < 4; ++m) _Pragma("unroll") for (int n = 0; n < 2; ++n) _Pragma("unroll") for (int k = 0; k < 2; ++k) \
        acc[ai][bj][m][n] = __builtin_amdgcn_mfma_f32_16x16x32_bf16(Bt[n][k], At[m][k], acc[ai][bj][m][n], 0, 0, 0); __builtin_amdgcn_s_setprio(0); } while (0)
#define PG8_WAIT_V(n) asm volatile("s_waitcnt vmcnt(" #n ")" ::: "memory")
#define PG8_WAIT_L(n) asm volatile("s_waitcnt lgkmcnt(" #n ")" ::: "memory")
#define PG8_BAR __builtin_amdgcn_s_barrier()
#define PG8_SCHED __builtin_amdgcn_sched_barrier(0)
    Unit cur, nxt; int ui = 0;
    if (!S.next(0, cur)) return;
    f32x4 acc[2][2][4][2];
#pragma unroll
    for (int a = 0; a < 2; ++a)
#pragma unroll
        for (int b = 0; b < 2; ++b)
#pragma unroll
            for (int m = 0; m < 4; ++m)
#pragma unroll
                for (int n = 0; n < 2; ++n) acc[a][b][m][n] = (f32x4){0.f, 0.f, 0.f, 0.f};
    bf16x8 At[4][2], B0[2][2], B1[2][2];
    const char* cA = (const char*)g.A + (size_t)cur.pm * tstepA; const char* cB = (const char*)g.Bt + (size_t)cur.pn * tstepB;
    S.a_ready(cur);
    if constexpr (SP2) {
        PG8_STAGE(PG8_SB(0, 0), cB, voffB); PG8_STAGE(PG8_SB(0, 1), cB + hstepB, voffB); PG8_STAGE(PG8_SA(0, 0), cA, voffA); PG8_STAGE(PG8_SA(0, 1), cA + hstepA, voffA);
        if (wr == 1) PG8_BAR;
        PG8_WAIT_V(2); PG8_BAR;
        PG8_STAGE(PG8_SB(1, 0), cB + kstep, voffB); PG8_STAGE(PG8_SA(1, 0), cA + kstep, voffA); PG8_STAGE(PG8_SB(1, 1), cB + hstepB + kstep, voffB);
        PG8_WAIT_V(6); PG8_BAR;
    } else {
        PG8_STAGE(PG8_SB(0, 0), cB, voffB); PG8_STAGE(PG8_SA(0, 0), cA, voffA); PG8_STAGE(PG8_SB(0, 1), cB + hstepB, voffB); PG8_STAGE(PG8_SA(0, 1), cA + hstepA, voffA);
        if (wr == 1) PG8_BAR;
        PG8_WAIT_V(4); PG8_BAR;
        PG8_STAGE(PG8_SB(1, 0), cB + kstep, voffB); PG8_STAGE(PG8_SA(1, 0), cA + kstep, voffA); PG8_STAGE(PG8_SB(1, 1), cB + hstepB + kstep, voffB);
        PG8_WAIT_V(6); PG8_BAR;
    }
    for (;;) {
        const bool has_next = S.next(ui + 1, nxt);
        const char* nA = has_next ? (const char*)g.A + (size_t)nxt.pm * tstepA : cA; const char* nB = has_next ? (const char*)g.Bt + (size_t)nxt.pn * tstepB : cB;
        for (int t = 0; t < nt; t += 2) {
            const bool last = (t == nt - 2);
            const char* a1 = cA + (size_t)(t + 1) * kstep;
            const char* a2 = last ? nA : cA + (size_t)(t + 2) * kstep; const char* b2 = last ? nB : cB + (size_t)(t + 2) * kstep;
            const char* a3 = a2 + kstep; const char* b3 = b2 + kstep;
            if (last && has_next) S.a_ready(nxt);
            if constexpr (SP2) {
            PG8_LDB(B0, 0, 0); PG8_LDB(B1, 0, 1); PG8_SCHED; PG8_LDA(At, 0, 0); PG8_STAGE(PG8_SA(1, 1), a1 + hstepA, voffA);
            PG8_WAIT_V(8); PG8_WAIT_L(0); PG8_BAR; PG8_MMA(0, 0, At, B0); PG8_MMA(0, 1, At, B1); PG8_BAR; PG8_SCHED;
            PG8_LDA(At, 0, 1); PG8_STAGE(PG8_SB(0, 0), b2, voffB); PG8_STAGE(PG8_SB(0, 1), b2 + hstepB, voffB); PG8_STAGE(PG8_SA(0, 0), a2, voffA);
            PG8_WAIT_V(8); PG8_WAIT_L(0); PG8_BAR; PG8_MMA(1, 0, At, B0); PG8_MMA(1, 1, At, B1); PG8_BAR; PG8_SCHED;
            PG8_LDB(B0, 1, 0); PG8_LDB(B1, 1, 1); PG8_SCHED; PG8_LDA(At, 1, 0); PG8_STAGE(PG8_SA(0, 1), a2 + hstepA, voffA);
            PG8_WAIT_V(8); PG8_WAIT_L(0); PG8_BAR; PG8_MMA(0, 0, At, B0); PG8_MMA(0, 1, At, B1); PG8_BAR; PG8_SCHED;
            PG8_LDA(At, 1, 1); PG8_STAGE(PG8_SB(1, 0), b3, voffB); PG8_STAGE(PG8_SB(1, 1), b3 + hstepB, voffB); PG8_STAGE(PG8_SA(1, 0), a3, voffA);
            PG8_WAIT_V(8); PG8_WAIT_L(0); PG8_BAR; PG8_MMA(1, 0, At, B0); PG8_MMA(1, 1, At, B1); PG8_BAR; PG8_SCHED;
            } else {
            PG8_LDB(B0, 0, 0); PG8_SCHED; PG8_LDA(At, 0, 0); PG8_STAGE(PG8_SA(1, 1), a1 + hstepA, voffA);
            PG8_WAIT_L(8); PG8_BAR; PG8_WAIT_L(0); PG8_MMA(0, 0, At, B0); PG8_BAR; PG8_SCHED;
            PG8_LDB(B1, 0, 1); PG8_STAGE(PG8_SB(0, 0), b2, voffB);
            PG8_BAR; PG8_WAIT_L(0); PG8_MMA(0, 1, At, B1); PG8_BAR;
            PG8_LDA(At, 0, 1); PG8_STAGE(PG8_SA(0, 0), a2, voffA);
            PG8_BAR; PG8_WAIT_L(0); PG8_MMA(1, 0, At, B0); PG8_BAR; PG8_SCHED;
            PG8_STAGE(PG8_SB(0, 1), b2 + hstepB, voffB);
            PG8_WAIT_V(6); PG8_BAR; PG8_MMA(1, 1, At, B1); PG8_BAR;
            PG8_LDB(B0, 1, 0); PG8_SCHED; PG8_LDA(At, 1, 0); PG8_STAGE(PG8_SA(0, 1), a2 + hstepA, voffA);
            PG8_WAIT_L(8); PG8_BAR; PG8_WAIT_L(0); PG8_MMA(0, 0, At, B0); PG8_BAR; PG8_SCHED;
            PG8_LDB(B1, 1, 1); PG8_STAGE(PG8_SB(1, 0), b3, voffB);
            PG8_BAR; PG8_WAIT_L(0); PG8_MMA(0, 1, At, B1); PG8_BAR;
            PG8_LDA(At, 1, 1); PG8_STAGE(PG8_SA(1, 0), a3, voffA);
            PG8_BAR; PG8_WAIT_L(0); PG8_MMA(1, 0, At, B0); PG8_BAR; PG8_SCHED;
            PG8_STAGE(PG8_SB(1, 1), b3 + hstepB, voffB);
            PG8_WAIT_V(6); PG8_BAR; PG8_MMA(1, 1, At, B1); PG8_BAR;
            }
        }
        if constexpr (ALIGN_EPI) { if (wr == 0) PG8_BAR; }
        if constexpr (!Epi::AFTER_DRAIN) { int l2_; asm volatile("v_mbcnt_lo_u32_b32 %0, -1, 0\n\tv_mbcnt_hi_u32_b32 %0, -1, %0" : "=v"(l2_)); E(acc, cur, wr, wc, l2_ & 15, l2_ >> 4); S.done(cur); }
        if (!has_next) break;
#pragma unroll
        for (int a = 0; a < 2; ++a)
#pragma unroll
            for (int b = 0; b < 2; ++b)
#pragma unroll
                for (int m = 0; m < 4; ++m)
#pragma unroll
                    for (int n = 0; n < 2; ++n) acc[a][b][m][n] = (f32x4){0.f, 0.f, 0.f, 0.f};
        cur = nxt; cA = nA; cB = nB; ++ui;
        if constexpr (ALIGN_EPI) { if (wr == 1) PG8_BAR; }
    }
    PG8_WAIT_V(0);
    if constexpr (!ALIGN_EPI) { if (wr == 0) PG8_BAR; }
    PG8_BAR;
    if constexpr (Epi::AFTER_DRAIN) { E.fused(acc, cur, wr, wc, fr, fq, lds, wid, lane); S.done(cur); }
#undef PG8_SA
#undef PG8_SB
#undef PG8_STAGE
#undef PG8_LDA
#undef PG8_LDB
#undef PG8_MMA
#undef PG8_WAIT_V
#undef PG8_WAIT_L
#undef PG8_BAR
#undef PG8_SCHED
}
}

#define LAS __attribute__((address_space(3)))
typedef unsigned short bf16_t;
typedef short bf16x8 __attribute__((ext_vector_type(8)));
typedef float f32x4 __attribute__((ext_vector_type(4)));
typedef float f32x2 __attribute__((ext_vector_type(2)));
typedef float f32x16 __attribute__((ext_vector_type(16)));
typedef unsigned u32x4 __attribute__((ext_vector_type(4)));
typedef unsigned u32x2 __attribute__((ext_vector_type(2)));
typedef __bf16 bf16x2_t __attribute__((ext_vector_type(2)));

constexpr int NB = 2, SEQ = 16384, DM = 1024, NL = 4, MT = NB * SEQ;
constexpr int INC = 5632, PJ = 2048, GP = 3072, FF = 2816;
constexpr float EPS = 1e-6f, LOG2E = 1.4426950408889634f;
constexpr size_t MiB = 1u << 20;
constexpr size_t WS_SSQA = 1 * MiB, WS_SSQB = 3 * MiB, WS_AGG = 5 * MiB, WS_SMALL = 6 * MiB;
constexpr size_t WS_W0 = 8 * MiB, WS_WSZ = 32 * MiB;
constexpr size_t WS_XB = 72 * MiB, WS_PROJ = 136 * MiB, WS_VT = 264 * MiB, WS_GATES = 296 * MiB, WS_END = 488 * MiB;
constexpr size_t W_IN = 0, W_PA = 11 * MiB, W_PB = W_PA + MiB / 2, W_PC = 12 * MiB, W_O = 13 * MiB, W_FF = 15 * MiB, W_DN = 26 * MiB;
constexpr int SMALL_PER_LAYER = 16384 + 16384 + 65536;
constexpr int LDS_BYTES = 147456, MISC_OFF = 131072 + 320;
constexpr int CW_BAR = 4096; constexpr size_t CTL_ZERO_BYTES = 65536;

__device__ __forceinline__ unsigned pk2(float lo, float hi) { f32x2 v = {lo, hi}; bf16x2_t b = __builtin_convertvector(v, bf16x2_t); return __builtin_bit_cast(unsigned, b); }
__device__ __forceinline__ bf16_t f2bf(float f) { unsigned u = __builtin_bit_cast(unsigned, f); return (bf16_t)((u + 0x7fffu + ((u >> 16) & 1u)) >> 16); }
__device__ __forceinline__ float bf2f(bf16_t b) { return __builtin_bit_cast(float, (unsigned)b << 16); }
__device__ __forceinline__ float bflo(unsigned w) { return __builtin_bit_cast(float, w << 16); }
__device__ __forceinline__ float bfhi(unsigned w) { return __builtin_bit_cast(float, w & 0xffff0000u); }
__device__ __forceinline__ float fsigmoid(float x) { return __builtin_amdgcn_rcpf(1.f + __builtin_amdgcn_exp2f(-x * LOG2E)); }
__device__ __forceinline__ float shx(float v, int mask, int lane) { return __builtin_bit_cast(float, __builtin_amdgcn_ds_bpermute((lane ^ mask) << 2, __builtin_bit_cast(int, v))); }
__device__ __forceinline__ float wave_sum(float v, int lane) {
#pragma unroll
    for (int o = 1; o < 64; o <<= 1) v += shx(v, o, lane);
    return v;
}
__device__ __forceinline__ int crow(int r, int hi) { return (r & 3) + 8 * (r >> 2) + 4 * hi; }
#define MFMA32(a, b, c) __builtin_amdgcn_mfma_f32_32x32x16_bf16((a), (b), (c), 0, 0, 0)
__device__ __forceinline__ bf16x8 pack8(float a0, float a1, float a2, float a3, float a4, float a5, float a6, float a7) {
    u32x4 p; p.x = pk2(a0, a1); p.y = pk2(a2, a3); p.z = pk2(a4, a5); p.w = pk2(a6, a7); return __builtin_bit_cast(bf16x8, p);
}

namespace pg8 {
__device__ __forceinline__ float row_rstd(const float* ssq, int r) {
    const f32x4* p = (const f32x4*)(ssq + (size_t)r * 16);
    const f32x4 a = p[0], b = p[1], c = p[2], d = p[3];
    const float s = ((a[0] + a[1]) + (a[2] + a[3])) + ((b[0] + b[1]) + (b[2] + b[3])) + ((c[0] + c[1]) + (c[2] + c[3])) + ((d[0] + d[1]) + (d[2] + d[3]));
    return __builtin_amdgcn_rsqf(s * (1.f / 1024.f) + EPS);
}
__device__ __forceinline__ u32x4 pack_f8(const f32x4 v0, const f32x4 v1) { u32x4 w; w.x = pk2(v0[0], v0[1]); w.y = pk2(v0[2], v0[3]); w.z = pk2(v1[0], v1[1]); w.w = pk2(v1[2], v1[3]); return w; }

struct EpiInProj {
    static constexpr bool PERM = true, AFTER_DRAIN = false;
    bf16_t* proj; bf16_t* vt; bf16_t* gates; const float* ssq; const float* bgate;
    __device__ __forceinline__ void operator()(const f32x4 (&acc)[2][2][4][2], const Unit& u, int wr, int wc, int fr, int fq) const {
        const int row0 = u.pm * BM + wr * 64 + fr, cin = wc * 32 + 8 * fq;
        if (u.pn < 8) {
#pragma unroll
            for (int ai = 0; ai < 2; ++ai)
#pragma unroll
                for (int m = 0; m < 4; ++m) { const int r = row0 + ai * HALF + m * 16; const float rs = row_rstd(ssq, r); bf16_t* rowp = proj + (size_t)r * PJ + u.pn * BM + cin;
#pragma unroll
                    for (int bj = 0; bj < 2; ++bj) *(u32x4*)(rowp + bj * HALF) = pack_f8(acc[ai][bj][m][0] * rs, acc[ai][bj][m][1] * rs); }
        } else if (u.pn < 10) {
#pragma unroll
            for (int ai = 0; ai < 2; ++ai)
#pragma unroll
                for (int m = 0; m < 4; ++m) { const int r = row0 + ai * HALF + m * 16; const float rs = row_rstd(ssq, r);
                    const int b = r >> 14, s = r & (SEQ - 1), ko = s & 15, gq = ko >> 2, sg = (gq == 1) ? 2 : ((gq == 2) ? 1 : gq), slot = (s & ~15) | (sg * 4 + (ko & 3));
#pragma unroll
                    for (int bj = 0; bj < 2; ++bj) { const int head = (u.pn - 8) * 2 + bj; bf16_t* base = vt + ((size_t)((b * 4 + head) * 128 + cin)) * SEQ + slot;
                        const f32x4 v0 = acc[ai][bj][m][0] * rs, v1 = acc[ai][bj][m][1] * rs;
                        base[0] = f2bf(v0[0]); base[(size_t)SEQ] = f2bf(v0[1]); base[(size_t)2 * SEQ] = f2bf(v0[2]); base[(size_t)3 * SEQ] = f2bf(v0[3]);
                        base[(size_t)4 * SEQ] = f2bf(v1[0]); base[(size_t)5 * SEQ] = f2bf(v1[1]); base[(size_t)6 * SEQ] = f2bf(v1[2]); base[(size_t)7 * SEQ] = f2bf(v1[3]); } }
        } else {
            const int colg = (u.pn - 10) * BM + cin;
            f32x4 bv[2][2];
#pragma unroll
            for (int bj = 0; bj < 2; ++bj) { bv[bj][0] = *(const f32x4*)(bgate + colg + bj * HALF); bv[bj][1] = *(const f32x4*)(bgate + colg + bj * HALF + 4); }
#pragma unroll
            for (int ai = 0; ai < 2; ++ai)
#pragma unroll
                for (int m = 0; m < 4; ++m) { const int r = row0 + ai * HALF + m * 16; const float rs = row_rstd(ssq, r); bf16_t* rowp = gates + (size_t)r * GP + colg;
#pragma unroll
                    for (int bj = 0; bj < 2; ++bj) { f32x4 v0 = acc[ai][bj][m][0] * rs + bv[bj][0], v1 = acc[ai][bj][m][1] * rs + bv[bj][1];
#pragma unroll
                        for (int e = 0; e < 4; ++e) { v0[e] = fsigmoid(v0[e]); v1[e] = fsigmoid(v1[e]); }
                        *(u32x4*)(rowp + bj * HALF) = pack_f8(v0, v1); } }
        }
    }
};
template <int BR> struct EpiMerge {
    static constexpr bool PERM = true, AFTER_DRAIN = false;
    const bf16_t* gates; bf16_t* merged;
    __device__ __forceinline__ void operator()(const f32x4 (&acc)[2][2][4][2], const Unit& u, int wr, int wc, int fr, int fq) const {
        const int row0 = u.pm * BM + wr * 64 + fr, cin = wc * 32 + 8 * fq;
#pragma unroll
        for (int ai = 0; ai < 2; ++ai)
#pragma unroll
            for (int m = 0; m < 4; ++m) { const int r = row0 + ai * HALF + m * 16;
#pragma unroll
                for (int bj = 0; bj < 2; ++bj) { const int col = u.pn * BM + bj * HALF + cin;
                    const u32x4 g = *(const u32x4*)(gates + (size_t)r * GP + BR * 1024 + col);
                    bf16_t* mp = merged + (size_t)r * DM + col;
                    f32x4 o0 = {0.f, 0.f, 0.f, 0.f}, o1 = {0.f, 0.f, 0.f, 0.f};
                    if (BR > 0) { const u32x4 p = *(const u32x4*)mp; o0 = (f32x4){bflo(p.x), bfhi(p.x), bflo(p.y), bfhi(p.y)}; o1 = (f32x4){bflo(p.z), bfhi(p.z), bflo(p.w), bfhi(p.w)}; }
                    const f32x4 g0 = {bflo(g.x), bfhi(g.x), bflo(g.y), bfhi(g.y)}, g1 = {bflo(g.z), bfhi(g.z), bflo(g.w), bfhi(g.w)};
                    o0 += g0 * acc[ai][bj][m][0]; o1 += g1 * acc[ai][bj][m][1];
                    *(u32x4*)mp = pack_f8(o0, o1); }
                asm volatile("" ::: "memory"); }
    }
};
struct EpiResid {
    static constexpr bool PERM = true, AFTER_DRAIN = false;
    const float* xin; float* xout; bf16_t* xb; float* ssq;
    __device__ __forceinline__ void operator()(const f32x4 (&acc)[2][2][4][2], const Unit& u, int wr, int wc, int fr, int fq) const {
        const int row0 = u.pm * BM + wr * 64 + fr, cin = wc * 32 + 8 * fq;
#pragma unroll
        for (int ai = 0; ai < 2; ++ai)
#pragma unroll
            for (int m = 0; m < 4; ++m) { const int r = row0 + ai * HALF + m * 16; float ss = 0.f;
#pragma unroll
                for (int bj = 0; bj < 2; ++bj) { const size_t off = (size_t)r * DM + u.pn * BM + bj * HALF + cin;
                    f32x4 x0 = *(const f32x4*)(xin + off), x1 = *(const f32x4*)(xin + off + 4);
                    x0 += acc[ai][bj][m][0]; x1 += acc[ai][bj][m][1];
                    *(f32x4*)(xout + off) = x0; *(f32x4*)(xout + off + 4) = x1;
                    *(u32x4*)(xb + off) = pack_f8(x0, x1);
                    ss += (x0[0] * x0[0] + x0[1] * x0[1]) + (x0[2] * x0[2] + x0[3] * x0[3]) + (x1[0] * x1[0] + x1[1] * x1[1]) + (x1[2] * x1[2] + x1[3] * x1[3]); }
                { const int ln_ = fr | (fq << 4); ss += shx(ss, 16, ln_); ss += shx(ss, 32, ln_); }
                if (fq == 0) ssq[(size_t)r * 16 + u.pn * 4 + wc] = ss;
                asm volatile("" ::: "memory"); }
    }
};
struct EpiFfn1 {
    static constexpr bool PERM = true, AFTER_DRAIN = false;
    bf16_t* hid; const float* ssq;
    __device__ __forceinline__ void operator()(const f32x4 (&acc)[2][2][4][2], const Unit& u, int wr, int wc, int fr, int fq) const {
        const int row0 = u.pm * BM + wr * 64 + fr, cin = wc * 32 + 8 * fq;
#pragma unroll
        for (int ai = 0; ai < 2; ++ai)
#pragma unroll
            for (int m = 0; m < 4; ++m) { const int r = row0 + ai * HALF + m * 16; const float rs = row_rstd(ssq, r);
                f32x4 o[2];
#pragma unroll
                for (int n = 0; n < 2; ++n) { const f32x4 g = acc[ai][0][m][n] * rs, up = acc[ai][1][m][n] * rs;
#pragma unroll
                    for (int e = 0; e < 4; ++e) o[n][e] = g[e] * fsigmoid(g[e]) * up[e]; }
                *(u32x4*)(hid + (size_t)r * FF + u.pn * HALF + cin) = pack_f8(o[0], o[1]);
                asm volatile("" ::: "memory"); }
    }
};
}

#define XB_TMO      128
#define XB_XCNT(j)  (256  + 64 * (j))
#define XB_XSUB(j)  (1280 + 64 * (j))
#define XB_XGEN(j)  (2304 + 64 * (j))
#define XB_TOP      3328
#define XB_TOPGEN   3392
#define XCD_BAR_WORDS 3456
#define XB_SPIN_CAP (1u << 18)

__device__ __forceinline__ unsigned xb_ld(unsigned* p)              { return __hip_atomic_load(p, __ATOMIC_RELAXED, __HIP_MEMORY_SCOPE_AGENT); }
__device__ __forceinline__ unsigned xb_add(unsigned* p, unsigned v) { return __hip_atomic_fetch_add(p, v, __ATOMIC_RELAXED, __HIP_MEMORY_SCOPE_AGENT); }
__device__ __forceinline__ unsigned xb_xcc_id() { return (unsigned)__builtin_amdgcn_s_getreg((3 << 11) | 20) & 0xFu; }
#define XB_SPIN(cond, bar) do { unsigned _sp = 0; while (cond) { __builtin_amdgcn_s_sleep(1); \
    if ((++_sp & 255u) == 0u) { if (xb_ld(&(bar)[XB_TMO])) break; if (_sp > XB_SPIN_CAP) { atomicAdd(&(bar)[XB_TMO], 1u); break; } } } } while (0)

struct XcdBarrier {
    unsigned* bar; unsigned x;
    volatile LAS unsigned* st;
};

__device__ __forceinline__ XcdBarrier xcd_barrier_post(unsigned* bar, volatile LAS unsigned* st, bool is0) {
    XcdBarrier b; b.bar = bar; b.x = xb_xcc_id(); b.st = st;
    if (is0) (void)xb_add(&bar[XB_XCNT(b.x)], 1u);
    return b;
}
__device__ __forceinline__ void xcd_barrier_complete(unsigned* bar, unsigned x, unsigned& nloc, unsigned& nx) {
    const unsigned G = gridDim.x * gridDim.y * gridDim.z;
    unsigned sum, cnt, mine, sp = 0u;
    for (;;) {
        sum = 0u; cnt = 0u; mine = 0u;
#pragma unroll
        for (unsigned j = 0; j < 16; ++j) { const unsigned c = xb_ld(&bar[XB_XCNT(j)]); sum += c; cnt += (c > 0u) ? 1u : 0u; mine = (j == x) ? c : mine; }
        if (sum == G) break;
        __builtin_amdgcn_s_sleep(1);
        if ((++sp & 255u) == 0u) { if (xb_ld(&bar[XB_TMO])) break; if (sp > XB_SPIN_CAP) { atomicAdd(&bar[XB_TMO], 1u); break; } }
    }
    nloc = mine > 0u ? mine : 1u; nx = cnt > 0u ? cnt : 1u;
}

__device__ __forceinline__ void xcd_barrier(const XcdBarrier& b, bool is0) {
    asm volatile("s_waitcnt vmcnt(0)" ::: "memory");
    __syncthreads();
    if (is0) {
        unsigned* bar = b.bar;
        __builtin_amdgcn_s_waitcnt(0);
        unsigned nloc = b.st[0], nx = b.st[1];
        if (nloc == 0u) { xcd_barrier_complete(bar, b.x, nloc, nx); b.st[0] = nloc; b.st[1] = nx; }
        const unsigned old = xb_add(&bar[XB_XSUB(b.x)], 1u);
        const unsigned gen = old / nloc;
        if (old + 1u == (gen + 1u) * nloc) {
            __builtin_amdgcn_fence(__ATOMIC_RELEASE, "agent");
            asm volatile("s_waitcnt vmcnt(0)" ::: "memory");
            const unsigned og = xb_add(&bar[XB_TOP], 1u);
            const unsigned tg = og / nx;
            if (og + 1u == (tg + 1u) * nx) xb_add(&bar[XB_TOPGEN], 1u);
            else XB_SPIN(xb_ld(&bar[XB_TOPGEN]) == tg, bar);
            __builtin_amdgcn_fence(__ATOMIC_ACQUIRE, "agent");
            xb_add(&bar[XB_XGEN(b.x)], 1u);
            asm volatile("s_waitcnt vmcnt(0)" ::: "memory");
        } else {
            XB_SPIN(xb_ld(&bar[XB_XGEN(b.x)]) == gen, bar);
            __builtin_amdgcn_fence(__ATOMIC_ACQUIRE, "agent");
            asm volatile("s_waitcnt vmcnt(0)" ::: "memory");
        }
    }
    __syncthreads();
}


struct Args { const float* in[31]; float* out; unsigned char* ws; };
typedef const float* cfptr_t;
__device__ __forceinline__ cfptr_t kin(int i) { const volatile __attribute__((address_space(4))) cfptr_t* p = (const volatile __attribute__((address_space(4))) cfptr_t*)__builtin_amdgcn_kernarg_segment_ptr(); return p[i]; }

__device__ __forceinline__ void conv_item(const float* W, int N, int k0, int n0, bf16_t* dst, int ldk, const float* gain, LAS float* scr, int tid) {
    const int n = tid & 63, kq = tid >> 6;
#pragma unroll
    for (int i = 0; i < 8; ++i) { const int k = kq + 8 * i; float v = W[(size_t)(k0 + k) * N + n0 + n]; if (gain) v *= gain[k0 + k]; scr[k * 65 + n] = v; }
    __syncthreads();
    const int nn = tid >> 3, c = tid & 7;
    const LAS float* s = scr + (8 * c) * 65 + nn;
    u32x4 o; o.x = pk2(s[0], s[65]); o.y = pk2(s[130], s[195]); o.z = pk2(s[260], s[325]); o.w = pk2(s[390], s[455]);
    *(u32x4*)(dst + (size_t)nn * ldk + k0 + 8 * c) = o;
    __syncthreads();
}
__device__ __forceinline__ void convert_layer(int l, unsigned char* Wb, LAS float* scr, int tid, int bid, int G) {
    for (int it = bid; it < 4032; it += G) {
        int r = it;
        if (r < 1408) { const int kb = r / 88, nb = r % 88; conv_item(kin(2) + (size_t)l * DM * INC, INC, kb * 64, nb * 64, (bf16_t*)(Wb + W_IN) + (size_t)nb * 64 * DM, DM, kin(1) + l * DM, scr, tid); continue; } r -= 1408;
        if (r < 64) { const int kb = r / 16, nb = r % 16; conv_item(kin(23) + (size_t)l * 256 * DM, DM, kb * 64, nb * 64, (bf16_t*)(Wb + W_PA) + (size_t)nb * 64 * 256, 256, nullptr, scr, tid); continue; } r -= 64;
        if (r < 64) { const int kb = r / 16, nb = r % 16; conv_item(kin(24) + (size_t)l * 256 * DM, DM, kb * 64, nb * 64, (bf16_t*)(Wb + W_PB) + (size_t)nb * 64 * 256, 256, nullptr, scr, tid); continue; } r -= 64;
        if (r < 128) { const int kb = r / 16, nb = r % 16; conv_item(kin(25) + (size_t)l * 512 * DM, DM, kb * 64, nb * 64, (bf16_t*)(Wb + W_PC) + (size_t)nb * 64 * 512, 512, nullptr, scr, tid); continue; } r -= 128;
        if (r < 256) { const int kb = r / 16, nb = r % 16; conv_item(kin(26) + (size_t)l * DM * DM, DM, kb * 64, nb * 64, (bf16_t*)(Wb + W_O) + (size_t)nb * 64 * DM, DM, nullptr, scr, tid); continue; } r -= 256;
        if (r < 704) { const int kb = r / 44, nb = r % 44; conv_item(kin(28) + (size_t)l * DM * FF, FF, kb * 64, nb * 64, (bf16_t*)(Wb + W_FF) + (size_t)(256 * (nb >> 1) + 64 * (nb & 1)) * DM, DM, kin(27) + l * DM, scr, tid); continue; } r -= 704;
        if (r < 704) { const int kb = r / 44, nb = r % 44; conv_item(kin(29) + (size_t)l * DM * FF, FF, kb * 64, nb * 64, (bf16_t*)(Wb + W_FF) + (size_t)(256 * (nb >> 1) + 128 + 64 * (nb & 1)) * DM, DM, kin(27) + l * DM, scr, tid); continue; } r -= 704;
        { const int kb = r / 16, nb = r % 16; conv_item(kin(30) + (size_t)l * FF * DM, DM, kb * 64, nb * 64, (bf16_t*)(Wb + W_DN) + (size_t)nb * 64 * FF, FF, nullptr, scr, tid); }
    }
}
__device__ __forceinline__ void convert_small(bf16_t* sm, int tid, int bid, int G) {
    for (int idx = bid * 512 + tid; idx < NL * SMALL_PER_LAYER; idx += G * 512) {
        const int l = idx / SMALL_PER_LAYER, e = idx % SMALL_PER_LAYER; float v;
        if (e < 32768) { const int e2 = e & 16383, hd = e2 >> 12, o = (e2 >> 6) & 63, i = e2 & 63; const float* src = (e < 16384) ? kin(6) : kin(8); v = src[(size_t)((l * 4 + hd) * 64 + i) * 64 + o]; }
        else { const int e2 = e - 32768, t = (e2 >> 7) & 127, s = e2 & 127; v = (s <= t) ? kin(13)[(size_t)l * 65536 + e2] : 0.f; }
        sm[idx] = f2bf(v);
    }
}
__device__ __forceinline__ void x_pass(const float* x, bf16_t* xb, float* ssq, int lane, int gw, int NGW) {
    for (int m = gw; m < MT; m += NGW) {
        const f32x4* xr = (const f32x4*)(x + (size_t)m * DM) + lane; u32x2* o = (u32x2*)(xb + (size_t)m * DM) + lane; float ss = 0.f;
#pragma unroll
        for (int j = 0; j < 4; ++j) { const f32x4 v = xr[64 * j]; ss += (v[0] * v[0] + v[1] * v[1]) + (v[2] * v[2] + v[3] * v[3]); u32x2 w; w.x = pk2(v[0], v[1]); w.y = pk2(v[2], v[3]); o[64 * j] = w; }
        ss = wave_sum(ss, lane);
        if (lane < 16) ssq[(size_t)m * 16 + lane] = (lane == 0) ? ss : 0.f;
    }
}
__device__ __forceinline__ void qk_norm(bf16_t* proj, bf16_t* outp, int opitch, const float* qg, const float* kg, int lane, int gw, int NGW) {
    const int d0 = (lane * 8) & 63; float gq[8], gk[8];
#pragma unroll
    for (int e = 0; e < 8; ++e) { gq[e] = qg[d0 + e] * (0.125f * LOG2E); gk[e] = kg[d0 + e]; }
    for (int m = gw; m < MT; m += NGW) {
        bf16_t* base = proj + (size_t)m * PJ + 1024;
#pragma unroll
        for (int i = 0; i < 2; ++i) { const u32x4* p = (const u32x4*)(base + (lane + 64 * i) * 8); const u32x4 v = *p; u32x4* po = (u32x4*)(outp + (size_t)m * opitch + (lane + 64 * i) * 8);
            float f[8] = {bflo(v.x), bfhi(v.x), bflo(v.y), bfhi(v.y), bflo(v.z), bfhi(v.z), bflo(v.w), bfhi(v.w)};
            float ss = 0.f;
#pragma unroll
            for (int e = 0; e < 8; ++e) ss += f[e] * f[e];
            ss += shx(ss, 1, lane); ss += shx(ss, 2, lane); ss += shx(ss, 4, lane);
            const float rs = __builtin_amdgcn_rsqf(ss * (1.f / 64.f) + EPS);
#pragma unroll
            for (int e = 0; e < 8; ++e) f[e] *= rs * (i == 0 ? gq[e] : gk[e]);
            u32x4 w; w.x = pk2(f[0], f[1]); w.y = pk2(f[2], f[3]); w.z = pk2(f[4], f[5]); w.w = pk2(f[6], f[7]); *po = w; }
    }
}

constexpr int LRU_XA = 0, LRU_XP = 528, LRU_CW = 35392;
struct LruP { const float *cw, *cb, *ba, *bi, *lam; const bf16_t *waT, *wiT; };
template <bool FINAL> __device__ __forceinline__ void lru_unit(LAS unsigned char* lds, bf16_t* proj, bf16_t* outp, int opitch, float* agg, const LruP& P, int b, int chunk, int tid) {
    const int lane = tid & 63, r = lane & 31, h = lane >> 5, w = __builtin_amdgcn_readfirstlane(tid >> 6), hd = w >> 1, cbk = w & 1;
    const size_t Rb = (size_t)b * SEQ; const int t0 = chunk * 64;
    for (int c = tid; c < 67 * 32; c += 512) { const int j = c >> 5, cc = c & 31, tok = t0 - 3 + j; u32x4 v = {0u, 0u, 0u, 0u};
        if (tok >= 0) v = *(const u32x4*)(proj + (Rb + tok) * PJ + cc * 8);
        *(LAS u32x4*)(lds + LRU_XA + j * LRU_XP + cc * 16) = v; }
    LAS float* CWl = (LAS float*)(lds + LRU_CW);
    for (int i = tid; i < 1280; i += 512) CWl[i] = (i < 1024) ? P.cw[i] : P.cb[i - 1024];
    __syncthreads();
    const int oc = hd * 64 + cbk * 32 + r;
    float Hc = 0.f;
    if (FINAL) {
        const int mid = chunk >> 1, lo = h ? mid : 0, hi2 = h ? chunk : mid; float PA = 1.f, PH = 0.f;
        const f32x2* ap = (const f32x2*)agg + ((size_t)b * 256) * 256 + oc;
#pragma unroll 4
        for (int j = lo; j < hi2; ++j) { const f32x2 q = ap[(size_t)j * 256]; PH = q.x * PH + q.y; PA *= q.x; }
        const float oPA = shx(PA, 32, lane), oPH = shx(PH, 32, lane);
        Hc = h ? (PA * oPH + PH) : (oPA * PH + oPH);
        asm volatile("" : "+v"(Hc));
    }
    const float cw0 = CWl[oc], cw1 = CWl[256 + oc], cw2 = CWl[512 + oc], cw3 = CWl[768 + oc], cbv = CWl[1024 + oc];
    const float bav = P.ba[oc], biv = P.bi[oc], elam = __builtin_amdgcn_exp2f(-P.lam[oc] * LOG2E), cl = -8.f * ((elam < 0.03f) ? elam * (1.f - elam * (0.5f - elam * (0.33333334f - elam * 0.25f))) : __builtin_amdgcn_logf(1.f + elam) * 0.6931471805599453f);
    float av[2][16], bv[2][16];
#pragma unroll
    for (int rb = 0; rb < 2; ++rb) { f32x16 acca = (f32x16){}, acci = (f32x16){};
#pragma unroll
        for (int ks = 0; ks < 4; ++ks) { const int ci0 = hd * 64 + 16 * ks + 8 * h;
            const bf16x8 waf = *(const bf16x8*)(P.waT + (size_t)oc * 64 + 16 * ks + 8 * h), wif = *(const bf16x8*)(P.wiT + (size_t)oc * 64 + 16 * ks + 8 * h);
            const f32x4 c0 = *(const LAS f32x4*)(CWl + 1024 + ci0), c1 = *(const LAS f32x4*)(CWl + 1024 + ci0 + 4);
            float xc[8] = {c0[0], c0[1], c0[2], c0[3], c1[0], c1[1], c1[2], c1[3]};
#pragma unroll
            for (int tap = 0; tap < 4; ++tap) { const u32x4 xv = *(const LAS u32x4*)(lds + LRU_XA + (32 * rb + r + tap) * LRU_XP + ci0 * 2);
                const f32x4 w0 = *(const LAS f32x4*)(CWl + tap * 256 + ci0), w1 = *(const LAS f32x4*)(CWl + tap * 256 + ci0 + 4);
                xc[0] += w0[0] * bflo(xv.x); xc[1] += w0[1] * bfhi(xv.x); xc[2] += w0[2] * bflo(xv.y); xc[3] += w0[3] * bfhi(xv.y);
                xc[4] += w1[0] * bflo(xv.z); xc[5] += w1[1] * bfhi(xv.z); xc[6] += w1[2] * bflo(xv.w); xc[7] += w1[3] * bfhi(xv.w); }
            const bf16x8 af = pack8(xc[0], xc[1], xc[2], xc[3], xc[4], xc[5], xc[6], xc[7]);
            acca = MFMA32(af, waf, acca); acci = MFMA32(af, wif, acci); }
#pragma unroll
        for (int i = 0; i < 16; ++i) { const int tok = 32 * rb + crow(i, h);
            const LAS bf16_t* xp = (const LAS bf16_t*)(lds + LRU_XA + tok * LRU_XP + oc * 2);
            const float xc = cbv + cw0 * bf2f(xp[0]) + cw1 * bf2f(xp[LRU_XP / 2]) + cw2 * bf2f(xp[LRU_XP]) + cw3 * bf2f(xp[3 * LRU_XP / 2]);
            const float rg = fsigmoid(acca[i] + bav), ig = fsigmoid(acci[i] + biv), la = cl * rg;
            const float x2 = 2.f * la;
            const float em1 = (x2 > -0.03f) ? x2 * (1.f + x2 * (0.5f + x2 * (0.16666667f + x2 * 0.041666668f))) : (__builtin_amdgcn_exp2f(x2 * LOG2E) - 1.f);
            av[rb][i] = __builtin_amdgcn_exp2f(la * LOG2E); bv[rb][i] = __builtin_amdgcn_sqrtf(-em1) * ig * xc; }
#pragma unroll
        for (int i = 0; i < 16; ++i) asm volatile("" : "+v"(av[rb][i]), "+v"(bv[rb][i]));
    }
    float Ag[8], Bg[8];
#pragma unroll
    for (int k = 0; k < 8; ++k) { const int rb = k >> 2, i0 = 4 * (k & 3);
        Ag[k] = (av[rb][i0] * av[rb][i0 + 1]) * (av[rb][i0 + 2] * av[rb][i0 + 3]);
        Bg[k] = ((bv[rb][i0] * av[rb][i0 + 1] + bv[rb][i0 + 1]) * av[rb][i0 + 2] + bv[rb][i0 + 2]) * av[rb][i0 + 3] + bv[rb][i0 + 3]; }
    float myin[8]; float Pp = 1.f;
#pragma unroll
    for (int k = 0; k < 8; ++k) { const float pA = shx(Ag[k], 32, lane), pB = shx(Bg[k], 32, lane);
        const float A0 = h ? pA : Ag[k], B0 = h ? pB : Bg[k], A1 = h ? Ag[k] : pA, B1 = h ? Bg[k] : pB;
        const float in0 = Hc; Hc = A0 * Hc + B0; const float in1 = Hc; Hc = A1 * Hc + B1; myin[k] = h ? in1 : in0; Pp *= A0 * A1; }
    if (!FINAL) { if (h == 0) { f32x2 q; q.x = Pp; q.y = Hc; ((f32x2*)agg)[((size_t)b * 256 + chunk) * 256 + oc] = q; } }
    else {
#pragma unroll
        for (int k = 0; k < 8; ++k) { const int rb = k >> 2, i0 = 4 * (k & 3); float hh = myin[k];
#pragma unroll
            for (int j = 0; j < 4; ++j) { hh = av[rb][i0 + j] * hh + bv[rb][i0 + j]; const int tok = 32 * rb + 8 * (k & 3) + 4 * h + j;
                const bf16_t* gp = proj + (Rb + t0 + tok) * PJ + 256 + oc; const float ga = bf2f(*gp); bf16_t* go = outp + (Rb + t0 + tok) * opitch + oc;
                const float z = 1.5957691216057308f * (ga + 0.044715f * ga * ga * ga);
                *go = f2bf(hh * ga * fsigmoid(z)); }
            asm volatile("" ::: "memory"); }
    }
    __syncthreads();
}

constexpr int SG_VP = 272;
struct SgP { const float *lng, *lnb, *sgb; const bf16_t* sgw; };
__device__ __forceinline__ void sg_unit(LAS unsigned char* lds, bf16_t* proj, bf16_t* outp, int opitch, const SgP& P, int n, int tid) {
    const int lane = tid & 63, r = lane & 31, h = lane >> 5, w = __builtin_amdgcn_readfirstlane(tid >> 6);
    const size_t R0 = (size_t)n * 128;
    { const f32x4 g4 = *(const f32x4*)(P.lng + lane * 4), b4 = *(const f32x4*)(P.lnb + lane * 4);
      for (int rr = 0; rr < 16; ++rr) { const int t = w * 16 + rr; const u32x2 raw = *(const u32x2*)(proj + (R0 + t) * PJ + 768 + lane * 4);
        float v[4] = {bflo(raw.x), bfhi(raw.x), bflo(raw.y), bfhi(raw.y)};
        const float mean = wave_sum((v[0] + v[1]) + (v[2] + v[3]), lane) * (1.f / 256.f);
#pragma unroll
        for (int e = 0; e < 4; ++e) v[e] -= mean;
        const float var = wave_sum((v[0] * v[0] + v[1] * v[1]) + (v[2] * v[2] + v[3] * v[3]), lane) * (1.f / 256.f);
        const float rs = __builtin_amdgcn_rsqf(var + EPS);
#pragma unroll
        for (int e = 0; e < 4; ++e) *(LAS bf16_t*)(lds + (lane * 4 + e) * SG_VP + t * 2) = f2bf(v[e] * rs * g4[e] + b4[e]); } }
    __syncthreads();
    const int g = w >> 1, cbk = w & 1, c = g * 64 + cbk * 32 + r;
#pragma unroll
    for (int tb = 0; tb < 4; ++tb) { f32x16 acc = (f32x16){};
        const bf16_t* wp = P.sgw + (size_t)(g * 128 + 32 * tb + r) * 128 + 8 * h;
#pragma unroll
        for (int ks = 0; ks < 2 * tb + 2; ++ks) { const bf16x8 af = *(const bf16x8*)(wp + 16 * ks); const bf16x8 bfr = *(const LAS bf16x8*)(lds + c * SG_VP + (16 * ks + 8 * h) * 2); acc = MFMA32(af, bfr, acc); }
#pragma unroll
        for (int i = 0; i < 16; ++i) { const int t = 32 * tb + crow(i, h); const bf16_t* up = proj + (R0 + t) * PJ + 512 + c; outp[(R0 + t) * opitch + c] = f2bf(bf2f(*up) * (acc[i] + P.sgb[g * 128 + t])); } }
    __syncthreads();
}

constexpr int AT_SLOT = 16384, AT_K = 0, AT_V = 4 * AT_SLOT, AT_TAB = 131072 + 1024;
__device__ __forceinline__ void glds16(const void* gsrc, unsigned lds_dst) {
    unsigned keep;
    asm volatile("s_mov_b32 %0, m0\n\ts_mov_b32 m0, %2\n\ts_nop 0\n\tglobal_load_lds_dwordx4 %1, off\n\ts_mov_b32 m0, %0" : "=&s"(keep) : "v"(gsrc), "s"(lds_dst) : "memory");
}
__device__ __forceinline__ void at_qk(f32x16& p0, f32x16& p1, const LAS unsigned char* lk, const int (&koff)[4], const bf16x8 (&qf)[4]) {
    const f32x16 z = (f32x16){};
#pragma unroll
    for (int ks = 0; ks < 4; ++ks) { const bf16x8 a0 = *(const LAS bf16x8*)(lk + koff[ks]), a1 = *(const LAS bf16x8*)(lk + koff[ks] + 8192);
        p0 = MFMA32(a0, qf[ks], ks == 0 ? z : p0); p1 = MFMA32(a1, qf[ks], ks == 0 ? z : p1); }
}
__device__ __forceinline__ void at_bias(f32x16& p0, f32x16& p1, const LAS float* tb) {
#pragma unroll
    for (int i = 0; i < 16; ++i) { const int kk = (i & 3) + 8 * (i >> 2); p0[i] += tb[kk]; p1[i] += tb[32 + kk]; }
}
template <bool DOQK, bool DOEXP, bool DOPV, int VAR> __device__ __forceinline__ void at_fused(f32x16& pn0, f32x16& pn1, f32x16& pc0, f32x16& pc1, bf16x8 (&pfc)[4], const bf16x8 (&pfp)[4], f32x16 (&o)[4], float& lsum,
                                         const LAS unsigned char* lk, const LAS unsigned char* lv, const int (&koff)[4], const int (&voff)[4], const bf16x8 (&qf)[4]) {
    constexpr int PD = 4, NF = PD + 1;
    bf16x8 fr[NF];
#define AT_NEED(g) (((g) < 8) ? DOQK : DOPV)
#define AT_FRAG(g) (((g) < 8) ? *(const LAS bf16x8*)(lk + koff[(g) >> 1] + ((g) & 1) * 8192) : *(const LAS bf16x8*)(lv + voff[((g) - 8) >> 2] + (((g) - 8) & 3) * 4096))
#define AT_EX2(x) ((VAR == 1) ? (x) : __builtin_amdgcn_exp2f(x))
#define AT_EXP(e) do { if ((e) < 16) { pc0[(e)] = AT_EX2(pc0[(e)]); s0 += pc0[(e)]; } else { pc1[(e) - 16] = AT_EX2(pc1[(e) - 16]); s1 += pc1[(e) - 16]; } } while (0)
#pragma unroll
    for (int g = 0; g < PD; ++g) { if (AT_NEED(g)) fr[g % NF] = AT_FRAG(g); else fr[g % NF] = (bf16x8){}; }
    float s0 = 0.f, s1 = 0.f;
    const f32x16 z = (f32x16){};
#pragma unroll
    for (int g = 0; g < 24; ++g) {
        if (g + PD < 24 && AT_NEED(g + PD)) fr[(g + PD) % NF] = AT_FRAG(g + PD);
        if (g < 8) { const int ks = g >> 1;
            if (!DOQK || VAR == 2) {} else if (g & 1) pn1 = MFMA32(fr[g % NF], qf[ks], ks == 0 ? z : pn1); else pn0 = MFMA32(fr[g % NF], qf[ks], ks == 0 ? z : pn0);
        } else if (DOPV && VAR != 2) { const int sp = (g - 8) >> 2, db = (g - 8) & 3; o[db] = MFMA32(fr[g % NF], pfp[sp], o[db]); }
        if (DOEXP) {
            const int e0 = g + (g + 2) / 3, e1 = (g + 1) + (g + 3) / 3;
#pragma unroll
            for (int e = e0; e < e1; ++e) AT_EXP(e);
            asm volatile("" : "+v"(s0), "+v"(s1));
            if (g == 6) pfc[0] = pack8(pc0[0], pc0[1], pc0[2], pc0[3], pc0[4], pc0[5], pc0[6], pc0[7]);
            if (g == 12) pfc[1] = pack8(pc0[8], pc0[9], pc0[10], pc0[11], pc0[12], pc0[13], pc0[14], pc0[15]);
            if (g == 18) pfc[2] = pack8(pc1[0], pc1[1], pc1[2], pc1[3], pc1[4], pc1[5], pc1[6], pc1[7]);
        }
        __builtin_amdgcn_sched_barrier(0);
    }
    if (DOEXP) { pfc[3] = pack8(pc1[8], pc1[9], pc1[10], pc1[11], pc1[12], pc1[13], pc1[14], pc1[15]); lsum += s0 + s1; }
#undef AT_FRAG
#undef AT_NEED
#undef AT_EXP
#undef AT_EX2
}
template <int VAR> __device__ __forceinline__ void attn_unit(LAS unsigned char* lds, const bf16_t* proj, const bf16_t* vt, bf16_t* outp, int opitch, int b, int hd, int qb, float lam, float osc, const float* relb, const float* subg, int tid_in) {
    int tid = tid_in; asm volatile("" : "+v"(tid));
    const int lane = tid & 63, r = lane & 31, h = lane >> 5, w = __builtin_amdgcn_readfirstlane(tid >> 6), mp = w >> 2, rs = w & 3;
    LAS float* tab = (LAS float*)(lds + AT_TAB);
    const size_t Rb = (size_t)b * SEQ, R0 = Rb + (size_t)qb * 128;
    const int NT = 2 * qb + 2;
    const bool deep = NT >= 8;
    const int rk0 = 8 * w + (lane >> 4), rk1 = rk0 + 4, rv0 = 16 * w + (lane >> 3), rv1 = rv0 + 8;
    const bf16_t* ks0 = proj + (Rb + rk0) * PJ + 1536 + hd * 128 + (((lane & 15) ^ (rk0 & 15)) * 8);
    const bf16_t* ks1 = proj + (Rb + rk1) * PJ + 1536 + hd * 128 + (((lane & 15) ^ (rk1 & 15)) * 8);
    const bf16_t* vs0 = vt + ((size_t)((b * 4 + hd) * 128 + rv0)) * SEQ + (((lane & 7) ^ ((rv0 >> 1) & 7)) * 8);
    const bf16_t* vs1 = vt + ((size_t)((b * 4 + hd) * 128 + rv1)) * SEQ + (((lane & 7) ^ ((rv1 >> 1) & 7)) * 8);
    const unsigned ldsb = (unsigned)(uintptr_t)lds, kd = ldsb + AT_K + w * 2048, vd = ldsb + AT_V + w * 2048;
#define AT_ISSUE_K(j) do { const unsigned d_ = (unsigned)__builtin_amdgcn_readfirstlane(kd + ((j) & 3) * AT_SLOT); if (VAR != 3) { glds16(ks0 + (size_t)(j) * 64 * PJ, d_); glds16(ks1 + (size_t)(j) * 64 * PJ, d_ + 1024u); } } while (0)
#define AT_ISSUE_V(j) do { const unsigned d_ = (unsigned)__builtin_amdgcn_readfirstlane(vd + ((j) & 3) * AT_SLOT); if (VAR != 3) { glds16(vs0 + (j) * 64, d_); glds16(vs1 + (j) * 64, d_ + 1024u); } } while (0)
#define AT_WAITBAR(N) asm volatile("s_waitcnt vmcnt(" #N ") lgkmcnt(0)\n\ts_barrier" ::: "memory")
    AT_ISSUE_K(0); AT_ISSUE_K(1);
    if (2 < NT) AT_ISSUE_K(2);
    AT_ISSUE_V(0);
    if (3 < NT) AT_ISSUE_K(3);
    AT_ISSUE_V(1);
    { const float cfar = relb[15 * 4 + hd];
      if (tid < 64) tab[1216 + tid] = -INFINITY;
      for (int idx = tid; idx < 1216; idx += 512) { const int rel = idx - 1151, n = rel < 0 ? -rel : rel; int bk = (n < 8) ? n : (5 + (31 - __builtin_clz(n))); bk = bk > 15 ? 15 : bk; if (rel > 0) bk += 16; tab[idx] = (relb[bk * 4 + hd] - cfar) * LOG2E; } }
    bf16x8 qf[4];
    { const bf16_t* qp = proj + (R0 + 32 * rs + r) * PJ + 1024 + hd * 128 + mp * 64 + 8 * h;
#pragma unroll
      for (int ks = 0; ks < 4; ++ks) qf[ks] = *(const bf16x8*)(qp + 16 * ks); }
    int koff[4], voff[4];
    { const int kx = (mp * 8 + h) ^ (r & 15), vx = h ^ ((r >> 1) & 7);
#pragma unroll
      for (int i = 0; i < 4; ++i) { koff[i] = r * 256 + ((kx ^ (2 * i)) << 4); voff[i] = r * 128 + ((vx ^ (2 * i)) << 4); } }
    if (deep) AT_WAITBAR(8); else AT_WAITBAR(0);
    f32x16 o[4]; o[0] = (f32x16){}; o[1] = (f32x16){}; o[2] = (f32x16){}; o[3] = (f32x16){};
    float lsum = 0.f;
    const int qpos = qb * 128 + 32 * rs + r;
    const LAS float* tb0 = tab + (1151 + 4 * h - qpos);
    f32x16 pa0, pa1, pb0, pb1; bf16x8 pfA[4], pfB[4];
    pb0 = (f32x16){}; pb1 = (f32x16){};
#pragma unroll
    for (int i = 0; i < 4; ++i) { pfA[i] = (bf16x8){}; pfB[i] = (bf16x8){}; }
    at_qk(pa0, pa1, lds + AT_K, koff, qf);
    if (1088 > qb * 128) at_bias(pa0, pa1, tb0);
    asm volatile("s_waitcnt lgkmcnt(0)\n\ts_barrier" ::: "memory");
#define AT_STEP(t, C0, C1, N0, N1, PC, PP, DOPV) do { \
        if ((t) + 4 < NT) AT_ISSUE_K((t) + 4); \
        if ((t) + 2 < NT) AT_ISSUE_V((t) + 2); \
        at_fused<true, true, DOPV, VAR>(N0, N1, C0, C1, PC, PP, o, lsum, lds + AT_K + (((t) + 1) & 3) * AT_SLOT, lds + AT_V + (((t) + 3) & 3) * AT_SLOT, koff, voff, qf); \
        if (((t) + 1) * 64 + 1088 > qb * 128) at_bias(N0, N1, (rs < 2 && (t) + 2 == NT) ? (const LAS float*)(tab + 1216) : tb0 + ((t) + 1) * 64); \
        if ((t) + 4 < NT) AT_WAITBAR(8); else AT_WAITBAR(0); } while (0)
    AT_STEP(0, pa0, pa1, pb0, pb1, pfA, pfB, false);
    for (int t = 1; t + 1 < NT; t += 2) {
        AT_STEP(t, pb0, pb1, pa0, pa1, pfB, pfA, true);
        AT_STEP(t + 1, pa0, pa1, pb0, pb1, pfA, pfB, true);
    }
    at_fused<false, true, true, VAR>(pa0, pa1, pb0, pb1, pfB, pfA, o, lsum, lds + AT_K, lds + AT_V + ((NT - 2) & 3) * AT_SLOT, koff, voff, qf);
    at_fused<false, false, true, VAR>(pa0, pa1, pb0, pb1, pfA, pfB, o, lsum, lds + AT_K, lds + AT_V + ((NT - 1) & 3) * AT_SLOT, koff, voff, qf);
    __syncthreads();
#undef AT_STEP
#undef AT_ISSUE_K
#undef AT_ISSUE_V
#undef AT_WAITBAR
    int lane_e = tid & 63; asm volatile("" : "+v"(lane_e));
    lsum += shx(lsum, 32, lane_e);
    const float inv = __builtin_amdgcn_rcpf(lsum);
    LAS float* ex = (LAS float*)lds;
    if (mp == 1) {
#pragma unroll
        for (int db = 0; db < 4; ++db)
#pragma unroll
            for (int i = 0; i < 16; ++i) ex[((rs * 4 + db) * 16 + i) * 64 + lane_e] = o[db][i] * inv;
    }
    __syncthreads();
    if (mp == 0) {
        float ss = 0.f;
#pragma unroll
        for (int db = 0; db < 4; ++db)
#pragma unroll
            for (int i = 0; i < 16; ++i) { const float v = o[db][i] * inv - lam * ex[((rs * 4 + db) * 16 + i) * 64 + lane_e]; o[db][i] = v; ss += v * v; }
        ss += shx(ss, 32, lane_e);
        const float rsn = __builtin_amdgcn_rsqf(ss * (1.f / 128.f) + EPS) * osc;
        const int r_e = lane_e & 31, h_e = lane_e >> 5; bf16_t* op = outp + (R0 + 32 * rs + r_e) * opitch + hd * 128;
#pragma unroll
        for (int db = 0; db < 4; ++db)
#pragma unroll
            for (int i4 = 0; i4 < 4; ++i4) { const int d = 32 * db + 8 * i4 + 4 * h_e; const f32x4 g4 = *(const f32x4*)(subg + d);
                u32x2 wv; wv.x = pk2(o[db][4 * i4] * rsn * g4[0], o[db][4 * i4 + 1] * rsn * g4[1]); wv.y = pk2(o[db][4 * i4 + 2] * rsn * g4[2], o[db][4 * i4 + 3] * rsn * g4[3]);
                *(u32x2*)(op + d) = wv; }
    }
    __syncthreads();
}

__global__ void __launch_bounds__(512, 2) mega_fwd(Args a) {
    extern __shared__ __attribute__((aligned(16))) unsigned char lds_raw[];
    cg::grid_group grid = cg::this_grid();
    LAS unsigned char* lds = (LAS unsigned char*)lds_raw;
    const int G = gridDim.x, bid = blockIdx.x;
    const int wave = __builtin_amdgcn_readfirstlane(threadIdx.x >> 6);
#define IS_T0(v) bool v; { int l_; asm volatile("v_mbcnt_lo_u32_b32 %0, -1, 0\n\tv_mbcnt_hi_u32_b32 %0, -1, %0" : "=v"(l_)); v = (wave == 0) && (l_ == 0); }
    { IS_T0(t0_); if (t0_) { ((LAS unsigned*)(lds + MISC_OFF))[8] = 0u; ((LAS unsigned*)(lds + MISC_OFF))[9] = 0u; } __syncthreads();
      (void)xcd_barrier_post((unsigned*)kin(32) + CW_BAR, (volatile LAS unsigned*)(lds + MISC_OFF) + 8, t0_); }
#define GRID_BAR() do { XcdBarrier b_; b_.bar = (unsigned*)kin(32) + CW_BAR; b_.x = xb_xcc_id(); b_.st = (volatile LAS unsigned*)(lds + MISC_OFF) + 8; IS_T0(t0_); xcd_barrier(b_, t0_); } while (0)
#define PH_BEGIN int tid, bidp = bid, Gp = G; { int l_; asm volatile("v_mbcnt_lo_u32_b32 %0, -1, 0\n\tv_mbcnt_hi_u32_b32 %0, -1, %0" : "=v"(l_)); asm volatile("" : "+s"(bidp), "+s"(Gp)); tid = wave * 64 + l_; }
#define WSB(off) ((unsigned char*)kin(32) + (off))
#define ssqA ((float*)WSB(WS_SSQA))
#define ssqB ((float*)WSB(WS_SSQB))
#define agg ((float*)WSB(WS_AGG))
#define sm ((bf16_t*)WSB(WS_SMALL))
#define xb ((bf16_t*)WSB(WS_XB))
#define merged ((bf16_t*)WSB(WS_XB))
#define proj ((bf16_t*)WSB(WS_PROJ))
#define xb2 ((bf16_t*)WSB(WS_PROJ))
#define vt ((bf16_t*)WSB(WS_VT))
#define gates ((bf16_t*)WSB(WS_GATES))
#define hid ((bf16_t*)WSB(WS_GATES))
#define out ((float*)kin(31))
#define ws WSB(0)

    { PH_BEGIN; convert_layer(0, ws + WS_W0, (LAS float*)lds, tid, bidp, Gp);
      convert_small(sm, tid, bidp, Gp);
      x_pass(kin(0), xb, ssqA, tid & 63, bidp * 8 + wave, Gp * 8); }
    grid.sync();

    for (int l = 0; l < NL; ++l) {
#define WL(off) (ws + WS_W0 + (size_t)(l & 1) * WS_WSZ + (off))
#ifndef NO_A
        {
            PH_BEGIN;
            pg8::Gemm g{xb, (const bf16_t*)WL(W_IN), MT, INC, DM, DM}; pg8::StaticOrder S; S.init(MT, INC, Gp, bidp);
            pg8::EpiInProj E{proj, vt, gates, ssqA, kin(3) + l * 3072};
            pg8::gemm_phase<pg8::EpiInProj, pg8::StaticOrder, true, true>(lds, g, S, E, tid);
#ifdef PROBE_A
            pg8::gemm_phase<pg8::EpiInProj, pg8::StaticOrder, true, true>(lds, g, S, E, tid);
#endif
        }
#endif
        GRID_BAR();
        {
            PH_BEGIN; const int lane = tid & 63, gw = bidp * 8 + wave, NGW = Gp * 8;
            const bf16_t* sml = sm + (size_t)l * SMALL_PER_LAYER;
#if defined(PROBE_B) && PROBE_B == 3
            { LruP LP{kin(4) + l * 1024, kin(5) + l * 256, kin(7) + l * 256, kin(9) + l * 256, kin(10) + l * 256, sml, sml + 16384};
              for (int u = bidp; u < 512; u += Gp) lru_unit<false>(lds, proj, proj, PJ, agg, LP, u >> 8, u & 255, tid); }
            if (l + 1 < NL) convert_layer(l + 1, ws + WS_W0 + (size_t)((l + 1) & 1) * WS_WSZ, (LAS float*)lds, tid, bidp, Gp);
#elif defined(PROBE_B)
#if PROBE_B == 1
            qk_norm(proj, xb, 1024, kin(15) + l * 64, kin(16) + l * 64, lane, gw, NGW);
#endif
            { LruP LP{kin(4) + l * 1024, kin(5) + l * 256, kin(7) + l * 256, kin(9) + l * 256, kin(10) + l * 256, sml, sml + 16384};
              for (int u = bidp; u < 512; u += Gp) lru_unit<false>(lds, proj, proj, PJ, agg, LP, u >> 8, u & 255, tid); }
            { SgP SP{kin(11) + l * 256, kin(12) + l * 256, kin(14) + l * 512, sml + 32768};
              for (int u = bidp; u < 256; u += Gp) sg_unit(lds, proj, xb, 1024, SP, u, tid); }
#if PROBE_B == 1
            if (l + 1 < NL) convert_layer(l + 1, ws + WS_W0 + (size_t)((l + 1) & 1) * WS_WSZ, (LAS float*)lds, tid, bidp, Gp);
#endif
#endif
            qk_norm(proj, proj + 1024, PJ, kin(15) + l * 64, kin(16) + l * 64, lane, gw, NGW);
            { LruP LP{kin(4) + l * 1024, kin(5) + l * 256, kin(7) + l * 256, kin(9) + l * 256, kin(10) + l * 256, sml, sml + 16384};
              for (int u = bidp; u < 512; u += Gp) lru_unit<false>(lds, proj, proj, PJ, agg, LP, u >> 8, u & 255, tid); }
            { SgP SP{kin(11) + l * 256, kin(12) + l * 256, kin(14) + l * 512, sml + 32768};
              for (int u = bidp; u < 256; u += Gp) sg_unit(lds, proj, proj + 512, PJ, SP, u, tid); }
            if (l + 1 < NL) convert_layer(l + 1, ws + WS_W0 + (size_t)((l + 1) & 1) * WS_WSZ, (LAS float*)lds, tid, bidp, Gp);
        }
        GRID_BAR();
        {
            PH_BEGIN; const int lane = tid & 63;
            float d1 = kin(17)[l * 64 + lane] * kin(18)[l * 64 + lane], d2 = kin(19)[l * 64 + lane] * kin(20)[l * 64 + lane];
            d1 = wave_sum(d1, lane); d2 = wave_sum(d2, lane);
            const float lam_init = 0.8f - 0.6f * __builtin_amdgcn_exp2f(-0.3f * LOG2E * (float)l);
            const float lam = __builtin_amdgcn_exp2f(d1 * LOG2E) - __builtin_amdgcn_exp2f(d2 * LOG2E) + lam_init;
            const float* relb = kin(22); const float* subg = kin(21) + l * 128;
#ifndef NO_ATT
#ifdef PROBE_ATT
            if (Gp == 256) {
                const int vcu = (bidp % 8) * 32 + bidp / 8, bh = vcu >> 5, s = vcu & 31;
#define ATT_OUT xb, 1024
                for (int i = 0; i < 4; ++i) { const int qb = (i == 0) ? 127 - s : (i == 1) ? 95 - s : (i == 2) ? 32 + s : s; attn_unit<PROBE_ATT>(lds, proj, vt, ATT_OUT, bh >> 2, bh & 3, qb, lam, 1.f - lam_init, relb, subg, tid); }
#undef ATT_OUT
            }
#endif
#define ATT_OUT proj + 1024, PJ
            if (Gp == 256) {
                const int vcu = (bidp % 8) * 32 + bidp / 8, bh = vcu >> 5, s = vcu & 31;
                for (int i = 0; i < 4; ++i) { const int qb = (i == 0) ? 127 - s : (i == 1) ? 95 - s : (i == 2) ? 32 + s : s; attn_unit<0>(lds, proj, vt, ATT_OUT, bh >> 2, bh & 3, qb, lam, 1.f - lam_init, relb, subg, tid); }
            } else {
                for (int u = bidp; u < 1024; u += Gp) attn_unit<0>(lds, proj, vt, ATT_OUT, u >> 9, (u >> 7) & 3, u & 127, lam, 1.f - lam_init, relb, subg, tid);
            }
#endif
            { const bf16_t* sml = sm + (size_t)l * SMALL_PER_LAYER;
              LruP LP{kin(4) + l * 1024, kin(5) + l * 256, kin(7) + l * 256, kin(9) + l * 256, kin(10) + l * 256, sml, sml + 16384};
#if defined(PROBE_B) && PROBE_B != 3
              for (int u = bidp; u < 512; u += Gp) lru_unit<true>(lds, proj, xb, 1024, agg, LP, u >> 8, u & 255, tid);
#endif
              for (int u = bidp; u < 512; u += Gp) lru_unit<true>(lds, proj, proj + 256, PJ, agg, LP, u >> 8, u & 255, tid); }
        }
        GRID_BAR();
#ifndef NO_C1
        { PH_BEGIN; pg8::StaticOrder S; S.init(MT, DM, Gp, bidp); pg8::Gemm g{proj + 256, (const bf16_t*)WL(W_PA), MT, DM, 256, PJ}; pg8::EpiMerge<0> E{gates, merged}; pg8::gemm_phase<pg8::EpiMerge<0>, pg8::StaticOrder, true, true>(lds, g, S, E, tid); }
        { PH_BEGIN; pg8::StaticOrder S; S.init(MT, DM, Gp, bidp); pg8::Gemm g{proj + 512, (const bf16_t*)WL(W_PB), MT, DM, 256, PJ}; pg8::EpiMerge<1> E{gates, merged}; pg8::gemm_phase<pg8::EpiMerge<1>, pg8::StaticOrder, true, true>(lds, g, S, E, tid); }
        { PH_BEGIN; pg8::StaticOrder S; S.init(MT, DM, Gp, bidp); pg8::Gemm g{proj + 1024, (const bf16_t*)WL(W_PC), MT, DM, 512, PJ}; pg8::EpiMerge<2> E{gates, merged}; pg8::gemm_phase<pg8::EpiMerge<2>, pg8::StaticOrder, true, true>(lds, g, S, E, tid); }
#ifdef PROBE_C1
        { PH_BEGIN; pg8::StaticOrder S; S.init(MT, DM, Gp, bidp); pg8::Gemm g{proj + 256, (const bf16_t*)WL(W_PA), MT, DM, 256, PJ}; pg8::EpiMerge<0> E{gates, merged}; pg8::gemm_phase<pg8::EpiMerge<0>, pg8::StaticOrder, true, true>(lds, g, S, E, tid); }
        { PH_BEGIN; pg8::StaticOrder S; S.init(MT, DM, Gp, bidp); pg8::Gemm g{proj + 512, (const bf16_t*)WL(W_PB), MT, DM, 256, PJ}; pg8::EpiMerge<1> E{gates, merged}; pg8::gemm_phase<pg8::EpiMerge<1>, pg8::StaticOrder, true, true>(lds, g, S, E, tid); }
        { PH_BEGIN; pg8::StaticOrder S; S.init(MT, DM, Gp, bidp); pg8::Gemm g{proj + 1024, (const bf16_t*)WL(W_PC), MT, DM, 512, PJ}; pg8::EpiMerge<2> E{gates, merged}; pg8::gemm_phase<pg8::EpiMerge<2>, pg8::StaticOrder, true, true>(lds, g, S, E, tid); }
#endif
#endif
        GRID_BAR();
#ifndef NO_C2
        {
            PH_BEGIN;
            pg8::Gemm g{merged, (const bf16_t*)WL(W_O), MT, DM, DM, DM}; pg8::StaticOrder S; S.init(MT, DM, Gp, bidp);
#ifdef PROBE_C24
            { pg8::EpiResid E0{(l == 0) ? kin(0) : out, (float*)gates, xb2, ssqB}; pg8::gemm_phase<pg8::EpiResid, pg8::StaticOrder, true, true>(lds, g, S, E0, tid); }
#endif
            pg8::EpiResid E{(l == 0) ? kin(0) : out, out, xb2, ssqB};
            pg8::gemm_phase<pg8::EpiResid, pg8::StaticOrder, true, true>(lds, g, S, E, tid);
        }
#endif
        GRID_BAR();
#ifndef NO_C3
        {
            PH_BEGIN;
            pg8::Gemm g{xb2, (const bf16_t*)WL(W_FF), MT, 2 * FF, DM, DM}; pg8::StaticOrder S; S.init(MT, 2 * FF, Gp, bidp);
            pg8::EpiFfn1 E{hid, ssqB};
            pg8::gemm_phase<pg8::EpiFfn1, pg8::StaticOrder, true, true>(lds, g, S, E, tid);
#ifdef PROBE_C3
            pg8::gemm_phase<pg8::EpiFfn1, pg8::StaticOrder, true, true>(lds, g, S, E, tid);
#endif
        }
#endif
        GRID_BAR();
#ifndef NO_C4
        {
            PH_BEGIN;
            pg8::Gemm g{hid, (const bf16_t*)WL(W_DN), MT, DM, FF, FF}; pg8::StaticOrder S; S.init(MT, DM, Gp, bidp);
#ifdef PROBE_C24
            { pg8::EpiResid E0{out, (float*)proj, xb, ssqA}; pg8::gemm_phase<pg8::EpiResid, pg8::StaticOrder, true, true>(lds, g, S, E0, tid); }
#endif
            pg8::EpiResid E{out, out, xb, ssqA};
            pg8::gemm_phase<pg8::EpiResid, pg8::StaticOrder, true, true>(lds, g, S, E, tid);
        }
#endif
        if (l + 1 < NL) GRID_BAR();
    }
}
#undef WL
#undef GRID_BAR
#undef IS_T0
#undef PH_BEGIN
#undef ws
#undef out
#undef hid
#undef gates
#undef vt
#undef xb2
#undef proj
#undef merged
#undef xb
#undef sm
#undef agg
#undef ssqB
#undef ssqA
extern "C" void kernel_launch(void* const* d_in, const int* in_sizes, int n_in, void* d_out, int out_size, void* d_ws, size_t ws_size, hipStream_t stream) {
    static int grid = 0;
    if (grid == 0) {
        if (n_in != 31 || out_size != MT * DM || ws_size < WS_END) { fprintf(stderr, "kernel_launch: unexpected shapes (n_in %d out %d ws %zu)\n", n_in, out_size, ws_size); grid = -1; return; }
        int dev = 0, cus = 0, per_cu = 0;
        hipGetDevice(&dev); hipDeviceGetAttribute(&cus, hipDeviceAttributeMultiprocessorCount, dev);
        if (hipFuncSetAttribute((const void*)mega_fwd, hipFuncAttributeMaxDynamicSharedMemorySize, LDS_BYTES) != hipSuccess) { fprintf(stderr, "kernel_launch: hipFuncSetAttribute failed\n"); grid = -1; return; }
        if (hipOccupancyMaxActiveBlocksPerMultiprocessor(&per_cu, (const void*)mega_fwd, 512, LDS_BYTES) != hipSuccess || per_cu < 1) { fprintf(stderr, "kernel_launch: occupancy query says %d\n", per_cu); per_cu = 1; }
        (void)hipGetLastError();
        grid = cus;
    }
    if (grid < 0) return;
    if (hipMemsetAsync(d_ws, 0, CTL_ZERO_BYTES, stream) != hipSuccess) { fprintf(stderr, "kernel_launch: memset failed\n"); return; }
    Args a{};
    for (int i = 0; i < 31; ++i) a.in[i] = (const float*)d_in[i];
    a.out = (float*)d_out; a.ws = (unsigned char*)d_ws;
    void* args[] = {&a};
    hipError_t e = hipLaunchCooperativeKernel((const void*)mega_fwd, dim3(grid), dim3(512), args, LDS_BYTES, stream);
    if (e != hipSuccess) fprintf(stderr, "cooperative launch failed: %s (grid %d)\n", hipGetErrorString(e), grid);
}
```

```cpp
#include <hip/hip_runtime.h>
#include <hip/hip_cooperative_groups.h>
#include <hip/hip_bf16.h>
#include <cstdio>
#include <cstdint>
#include <cmath>
namespace cg = cooperative_groups;
namespace pg8 {
#define PG8_LAS __attribute__((address_space(3)))
typedef unsigned short bf16_t;
typedef short bf16x8 __attribute__((ext_vector_type(8)));
typedef float f32x4 __attribute__((ext_vector_type(4)));
typedef unsigned u32x4 __attribute__((ext_vector_type(4)));
constexpr int BM = 256, BK = 64, HALF = 128, HTB = HALF * BK * 2  , STAGE_BYTES = 8 * HTB, NXCD = 8, WGM = 8;

__host__ __device__ __forceinline__ int lds_byte(int r, int c) { const int st = (r >> 4) * 2 + (c >> 5), rr = r & 15, cc = c & 31, ob = rr * 64 + cc * 2; return st * 1024 + (ob ^ (((ob >> 9) & 1) << 5)); }
__host__ __device__ __forceinline__ void stage_rc(int b, int& R, int& C) { const int st = b / 1024, sb = b % 1024, swz = sb ^ (((sb >> 9) & 1) << 5); R = (st >> 1) * 16 + swz / 64; C = (st & 1) * 32 + (swz % 64) / 2; }
__host__ __device__ __forceinline__ int perm32(int rho) { const int n = rho >> 4, i = rho & 15; return 8 * (i >> 2) + 4 * n + (i & 3); }

struct Unit { int pm, pn; };
struct Gemm { const bf16_t* A; const bf16_t* Bt; int M, N, K, lda; };

struct StaticOrder {
    int nM, nN, nwg, G, c;
    __host__ __device__ void init(int M, int N, int G_, int c_) { nM = M / BM; nN = N / BM; nwg = nM * nN; G = G_; c = c_; }
    __host__ __device__ bool next(int i, Unit& u) const {
        const long L = (long)i * G + c; if (L >= nwg) return false;
        int wgid = (int)L; { const int q = nwg / NXCD, r = nwg % NXCD, xcd = wgid % NXCD, off = wgid / NXCD; wgid = (xcd < r ? xcd * (q + 1) : r * (q + 1) + (xcd - r) * q) + off; }
        const int nig = WGM * nN, gid = wgid / nig, fm = gid * WGM, gsz = (nM - fm) < WGM ? (nM - fm) : WGM;
        u.pm = fm + ((wgid % nig) % gsz); u.pn = (wgid % nig) / gsz; return true;
    }
    __device__ __forceinline__ void a_ready(const Unit&) const {}
    __device__ __forceinline__ void done(const Unit&) const {}
};

template <class Epi, class Sched, bool ALIGN_EPI = false, bool SP2 = false>
__device__ __forceinline__ void gemm_phase(PG8_LAS unsigned char* lds, const Gemm g, const Sched& S, const Epi& E, const int tid) {
    const int wid = __builtin_amdgcn_readfirstlane(tid >> 6), lane = tid & 63, wr = wid >> 2, wc = wid & 3, fr = lane & 15, fq = lane >> 4;
    const int K = g.K, nt = K / BK;
    unsigned voffA[2], voffB[2];
#pragma unroll
    for (int i = 0; i < 2; ++i) { int R, C; stage_rc(tid * 16 + i * 8192, R, C); const int Rb = Epi::PERM ? ((R & ~31) + perm32(R & 31)) : R;
        voffA[i] = (unsigned)(R * g.lda + C) * 2u; voffB[i] = (unsigned)(Rb * K + C) * 2u; }
    const size_t kstep = (size_t)(BK * 2);
    const size_t hstepA = (size_t)HALF * g.lda * 2, hstepB = (size_t)HALF * K * 2;
    const size_t tstepA = 2 * hstepA, tstepB = 2 * hstepB;
    const unsigned ldsw = (unsigned)wid * 1024u;
    const int aoff = lds_byte(wr * 64 + fr, fq * 8), boff = lds_byte(wc * 32 + fr, fq * 8);
#define PG8_SA(b, h) (((b) * 2 + (h)) * HTB)
#define PG8_SB(b, h) ((4 + (b) * 2 + (h)) * HTB)
#define PG8_STAGE(bufoff, gbase, voff) do { _Pragma("unroll") for (int _i = 0; _i < 2; ++_i) \
        __builtin_amdgcn_global_load_lds((const unsigned*)((const char*)(gbase) + (voff)[_i]), (PG8_LAS unsigned*)(lds + (bufoff) + ldsw + _i * 8192), 16, 0, 0); } while (0)
#define PG8_LDA(dst, b, h) do { _Pragma("unroll") for (int m = 0; m < 4; ++m) _Pragma("unroll") for (int k = 0; k < 2; ++k) dst[m][k] = *(const PG8_LAS bf16x8*)(lds + PG8_SA(b, h) + aoff + m * 2048 + k * 1024); } while (0)
#define PG8_LDB(dst, b, h) do { _Pragma("unroll") for (int n = 0; n < 2; ++n) _Pragma("unroll") for (int k = 0; k < 2; ++k) dst[n][k] = *(const PG8_LAS bf16x8*)(lds + PG8_SB(b, h) + boff + n * 2048 + k * 1024); } while (0)
#define PG8_MMA(ai, bj, At, Bt) do { __builtin_amdgcn_s_setprio(1); _Pragma("unroll") for (int m = 0; m < 4; ++m) _Pragma("unroll") for (int n = 0; n < 2; ++n) _Pragma("unroll") for (int k = 0; k < 2; ++k) \
        acc[ai][bj][m][n] = __builtin_amdgcn_mfma_f32_16x16x32_bf16(Bt[n][k], At[m][k], acc[ai][bj][m][n], 0, 0, 0); __builtin_amdgcn_s_setprio(0); } while (0)
#define PG8_WAIT_V(n) asm volatile("s_waitcnt vmcnt(" #n ")" ::: "memory")
#define PG8_WAIT_L(n) asm volatile("s_waitcnt lgkmcnt(" #n ")" ::: "memory")
#define PG8_BAR __builtin_amdgcn_s_barrier()
#define PG8_SCHED __builtin_amdgcn_sched_barrier(0)
    Unit cur, nxt; int ui = 0;
    if (!S.next(0, cur)) return;
    f32x4 acc[2][2][4][2];
#pragma unroll
    for (int a = 0; a < 2; ++a)
#pragma unroll
        for (int b = 0; b < 2; ++b)
#pragma unroll
            for (int m = 0; m < 4; ++m)
#pragma unroll
                for (int n = 0; n < 2; ++n) acc[a][b][m][n] = (f32x4){0.f, 0.f, 0.f, 0.f};
    bf16x8 At[4][2], B0[2][2], B1[2][2];
    const char* cA = (const char*)g.A + (size_t)cur.pm * tstepA; const char* cB = (const char*)g.Bt + (size_t)cur.pn * tstepB;
    S.a_ready(cur);
    if constexpr (SP2) {
        PG8_STAGE(PG8_SB(0, 0), cB, voffB); PG8_STAGE(PG8_SB(0, 1), cB + hstepB, voffB); PG8_STAGE(PG8_SA(0, 0), cA, voffA); PG8_STAGE(PG8_SA(0, 1), cA + hstepA, voffA);
        if (wr == 1) PG8_BAR;
        PG8_WAIT_V(2); PG8_BAR;
        PG8_STAGE(PG8_SB(1, 0), cB + kstep, voffB); PG8_STAGE(PG8_SA(1, 0), cA + kstep, voffA); PG8_STAGE(PG8_SB(1, 1), cB + hstepB + kstep, voffB);
        PG8_WAIT_V(6); PG8_BAR;
    } else {
        PG8_STAGE(PG8_SB(0, 0), cB, voffB); PG8_STAGE(PG8_SA(0, 0), cA, voffA); PG8_STAGE(PG8_SB(0, 1), cB + hstepB, voffB); PG8_STAGE(PG8_SA(0, 1), cA + hstepA, voffA);
        if (wr == 1) PG8_BAR;
        PG8_WAIT_V(4); PG8_BAR;
        PG8_STAGE(PG8_SB(1, 0), cB + kstep, voffB); PG8_STAGE(PG8_SA(1, 0), cA + kstep, voffA); PG8_STAGE(PG8_SB(1, 1), cB + hstepB + kstep, voffB);
        PG8_WAIT_V(6); PG8_BAR;
    }
    for (;;) {
        const bool has_next = S.next(ui + 1, nxt);
        const char* nA = has_next ? (const char*)g.A + (size_t)nxt.pm * tstepA : cA; const char* nB = has_next ? (const char*)g.Bt + (size_t)nxt.pn * tstepB : cB;
        for (int t = 0; t < nt; t += 2) {
            const bool last = (t == nt - 2);
            const char* a1 = cA + (size_t)(t + 1) * kstep;
            const char* a2 = last ? nA : cA + (size_t)(t + 2) * kstep; const char* b2 = last ? nB : cB + (size_t)(t + 2) * kstep;
            const char* a3 = a2 + kstep; const char* b3 = b2 + kstep;
            if (last && has_next) S.a_ready(nxt);
            if constexpr (SP2) {
            PG8_LDB(B0, 0, 0); PG8_LDB(B1, 0, 1); PG8_SCHED; PG8_LDA(At, 0, 0); PG8_STAGE(PG8_SA(1, 1), a1 + hstepA, voffA);
            PG8_WAIT_V(8); PG8_WAIT_L(0); PG8_BAR; PG8_MMA(0, 0, At, B0); PG8_MMA(0, 1, At, B1); PG8_BAR; PG8_SCHED;
            PG8_LDA(At, 0, 1); PG8_STAGE(PG8_SB(0, 0), b2, voffB); PG8_STAGE(PG8_SB(0, 1), b2 + hstepB, voffB); PG8_STAGE(PG8_SA(0, 0), a2, voffA);
            PG8_WAIT_V(8); PG8_WAIT_L(0); PG8_BAR; PG8_MMA(1, 0, At, B0); PG8_MMA(1, 1, At, B1); PG8_BAR; PG8_SCHED;
            PG8_LDB(B0, 1, 0); PG8_LDB(B1, 1, 1); PG8_SCHED; PG8_LDA(At, 1, 0); PG8_STAGE(PG8_SA(0, 1), a2 + hstepA, voffA);
            PG8_WAIT_V(8); PG8_WAIT_L(0); PG8_BAR; PG8_MMA(0, 0, At, B0); PG8_MMA(0, 1, At, B1); PG8_BAR; PG8_SCHED;
            PG8_LDA(At, 1, 1); PG8_STAGE(PG8_SB(1, 0), b3, voffB); PG8_STAGE(PG8_SB(1, 1), b3 + hstepB, voffB); PG8_STAGE(PG8_SA(1, 0), a3, voffA);
            PG8_WAIT_V(8); PG8_WAIT_L(0); PG8_BAR; PG8_MMA(1, 0, At, B0); PG8_MMA(1, 1, At, B1); PG8_BAR; PG8_SCHED;
            } else {
            PG8_LDB(B0, 0, 0); PG8_SCHED; PG8_LDA(At, 0, 0); PG8_STAGE(PG8_SA(1, 1), a1 + hstepA, voffA);
            PG8_WAIT_L(8); PG8_BAR; PG8_WAIT_L(0); PG8_MMA(0, 0, At, B0); PG8_BAR; PG8_SCHED;
            PG8_LDB(B1, 0, 1); PG8_STAGE(PG8_SB(0, 0), b2, voffB);
            PG8_BAR; PG8_WAIT_L(0); PG8_MMA(0, 1, At, B1); PG8_BAR;
            PG8_LDA(At, 0, 1); PG8_STAGE(PG8_SA(0, 0), a2, voffA);
            PG8_BAR; PG8_WAIT_L(0); PG8_MMA(1, 0, At, B0); PG8_BAR; PG8_SCHED;
            PG8_STAGE(PG8_SB(0, 1), b2 + hstepB, voffB);
            PG8_WAIT_V(6); PG8_BAR; PG8_MMA(1, 1, At, B1); PG8_BAR;
            PG8_LDB(B0, 1, 0); PG8_SCHED; PG8_LDA(At, 1, 0); PG8_STAGE(PG8_SA(0, 1), a2 + hstepA, voffA);
            PG8_WAIT_L(8); PG8_BAR; PG8_WAIT_L(0); PG8_MMA(0, 0, At, B0); PG8_BAR; PG8_SCHED;
            PG8_LDB(B1, 1, 1); PG8_STAGE(PG8_SB(1, 0), b3, voffB);
            PG8_BAR; PG8_WAIT_L(0); PG8_MMA(0, 1, At, B1); PG8_BAR;
            PG8_LDA(At, 1, 1); PG8_STAGE(PG8_SA(1, 0), a3, voffA);
            PG8_BAR; PG8_WAIT_L(0); PG8_MMA(1, 0, At, B0); PG8_BAR; PG8_SCHED;
            PG8_STAGE(PG8_SB(1, 1), b3 + hstepB, voffB);
            PG8_WAIT_V(6); PG8_BAR; PG8_MMA(1, 1, At, B1); PG8_BAR;
            }
        }
        if constexpr (ALIGN_EPI) { if (wr == 0) PG8_BAR; }
        if constexpr (!Epi::AFTER_DRAIN) { int l2_; asm volatile("v_mbcnt_lo_u32_b32 %0, -1, 0\n\tv_mbcnt_hi_u32_b32 %0, -1, %0" : "=v"(l2_)); E(acc, cur, wr, wc, l2_ & 15, l2_ >> 4); S.done(cur); }
        if (!has_next) break;
#pragma unroll
        for (int a = 0; a < 2; ++a)
#pragma unroll
            for (int b = 0; b < 2; ++b)
#pragma unroll
                for (int m = 0; m < 4; ++m)
#pragma unroll
                    for (int n = 0; n < 2; ++n) acc[a][b][m][n] = (f32x4){0.f, 0.f, 0.f, 0.f};
        cur = nxt; cA = nA; cB = nB; ++ui;
        if constexpr (ALIGN_EPI) { if (wr == 1) PG8_BAR; }
    }
    PG8_WAIT_V(0);
    if constexpr (!ALIGN_EPI) { if (wr == 0) PG8_BAR; }
    PG8_BAR;
    if constexpr (Epi::AFTER_DRAIN) { E.fused(acc, cur, wr, wc, fr, fq, lds, wid, lane); S.done(cur); }
#undef PG8_SA
#undef PG8_SB
#undef PG8_STAGE
#undef PG8_LDA
#undef PG8_LDB
#undef PG8_MMA
#undef PG8_WAIT_V
#undef PG8_WAIT_L
#undef PG8_BAR
#undef PG8_SCHED
}
}

#define LAS __attribute__((address_space(3)))
typedef unsigned short bf16_t;
typedef short bf16x8 __attribute__((ext_vector_type(8)));
typedef float f32x4 __attribute__((ext_vector_type(4)));
typedef float f32x2 __attribute__((ext_vector_type(2)));
typedef float f32x16 __attribute__((ext_vector_type(16)));
typedef unsigned u32x4 __attribute__((ext_vector_type(4)));
typedef unsigned u32x2 __attribute__((ext_vector_type(2)));
typedef __bf16 bf16x2_t __attribute__((ext_vector_type(2)));

constexpr int NB = 2, SEQ = 16384, DM = 1024, NL = 4, MT = NB * SEQ;
constexpr int INC = 5632, PJ = 2048, GP = 3072, FF = 2816;
constexpr float EPS = 1e-6f, LOG2E = 1.4426950408889634f;
constexpr size_t MiB = 1u << 20;
constexpr size_t WS_SSQA = 1 * MiB, WS_SSQB = 3 * MiB, WS_AGG = 5 * MiB, WS_SMALL = 6 * MiB;
constexpr size_t WS_W0 = 8 * MiB, WS_WSZ = 32 * MiB;
constexpr size_t WS_XB = 72 * MiB, WS_PROJ = 136 * MiB, WS_VT = 264 * MiB, WS_GATES = 296 * MiB, WS_END = 488 * MiB;
constexpr size_t W_IN = 0, W_PA = 11 * MiB, W_PB = W_PA + MiB / 2, W_PC = 12 * MiB, W_O = 13 * MiB, W_FF = 15 * MiB, W_DN = 26 * MiB;
constexpr int SMALL_PER_LAYER = 16384 + 16384 + 65536;
constexpr int LDS_BYTES = 147456, MISC_OFF = 131072 + 320;
constexpr int CW_BAR = 4096; constexpr size_t CTL_ZERO_BYTES = 65536;

__device__ __forceinline__ unsigned pk2(float lo, float hi) { f32x2 v = {lo, hi}; bf16x2_t b = __builtin_convertvector(v, bf16x2_t); return __builtin_bit_cast(unsigned, b); }
__device__ __forceinline__ bf16_t f2bf(float f) { unsigned u = __builtin_bit_cast(unsigned, f); return (bf16_t)((u + 0x7fffu + ((u >> 16) & 1u)) >> 16); }
__device__ __forceinline__ float bf2f(bf16_t b) { return __builtin_bit_cast(float, (unsigned)b << 16); }
__device__ __forceinline__ float bflo(unsigned w) { return __builtin_bit_cast(float, w << 16); }
__device__ __forceinline__ float bfhi(unsigned w) { return __builtin_bit_cast(float, w & 0xffff0000u); }
__device__ __forceinline__ float fsigmoid(float x) { return __builtin_amdgcn_rcpf(1.f + __builtin_amdgcn_exp2f(-x * LOG2E)); }
__device__ __forceinline__ float shx(float v, int mask, int lane) { return __builtin_bit_cast(float, __builtin_amdgcn_ds_bpermute((lane ^ mask) << 2, __builtin_bit_cast(int, v))); }
__device__ __forceinline__ float wave_sum(float v, int lane) {
#pragma unroll
    for (int o = 1; o < 64; o <<= 1) v += shx(v, o, lane);
    return v;
}
__device__ __forceinline__ int crow(int r, int hi) { return (r & 3) + 8 * (r >> 2) + 4 * hi; }
#define MFMA32(a, b, c) __builtin_amdgcn_mfma_f32_32x32x16_bf16((a), (b), (c), 0, 0, 0)
__device__ __forceinline__ bf16x8 pack8(float a0, float a1, float a2, float a3, float a4, float a5, float a6, float a7) {
    u32x4 p; p.x = pk2(a0, a1); p.y = pk2(a2, a3); p.z = pk2(a4, a5); p.w = pk2(a6, a7); return __builtin_bit_cast(bf16x8, p);
}

namespace pg8 {
__device__ __forceinline__ float row_rstd(const float* ssq, int r) {
    const f32x4* p = (const f32x4*)(ssq + (size_t)r * 16);
    const f32x4 a = p[0], b = p[1], c = p[2], d = p[3];
    const float s = ((a[0] + a[1]) + (a[2] + a[3])) + ((b[0] + b[1]) + (b[2] + b[3])) + ((c[0] + c[1]) + (c[2] + c[3])) + ((d[0] + d[1]) + (d[2] + d[3]));
    return __builtin_amdgcn_rsqf(s * (1.f / 1024.f) + EPS);
}
__device__ __forceinline__ u32x4 pack_f8(const f32x4 v0, const f32x4 v1) { u32x4 w; w.x = pk2(v0[0], v0[1]); w.y = pk2(v0[2], v0[3]); w.z = pk2(v1[0], v1[1]); w.w = pk2(v1[2], v1[3]); return w; }

struct EpiInProj {
    static constexpr bool PERM = true, AFTER_DRAIN = false;
    bf16_t* proj; bf16_t* vt; bf16_t* gates; const float* ssq; const float* bgate; const float* qg; const float* kg;
    __device__ __forceinline__ void operator()(const f32x4 (&acc)[2][2][4][2], const Unit& u, int wr, int wc, int fr, int fq) const {
        const int row0 = u.pm * BM + wr * 64 + fr, cin = wc * 32 + 8 * fq;
        if (u.pn >= 4 && u.pn < 8) {
            const int G = 4 * (u.pn - 4) + wc, ln_ = fr | (fq << 4); const bool isq = u.pn < 6;
            const float* gp = (isq ? qg : kg) + 8 * fq; const float gs = isq ? (0.125f * LOG2E) : 1.f;
            const f32x4 g00 = *(const f32x4*)gp * gs, g01 = *(const f32x4*)(gp + 4) * gs, g10 = *(const f32x4*)(gp + 32) * gs, g11 = *(const f32x4*)(gp + 36) * gs;
#pragma unroll
            for (int ai = 0; ai < 2; ++ai)
#pragma unroll
                for (int m = 0; m < 4; ++m) { const int r = row0 + ai * HALF + m * 16; const float rs = row_rstd(ssq, r); bf16_t* rowp = proj + (size_t)r * PJ + 1024 + 64 * G + 8 * fq;
                    f32x4 a0 = acc[ai][0][m][0] * rs, a1 = acc[ai][0][m][1] * rs, b0 = acc[ai][1][m][0] * rs, b1 = acc[ai][1][m][1] * rs;
                    float ss = (a0[0] * a0[0] + a0[1] * a0[1]) + (a0[2] * a0[2] + a0[3] * a0[3]) + (a1[0] * a1[0] + a1[1] * a1[1]) + (a1[2] * a1[2] + a1[3] * a1[3])
                             + (b0[0] * b0[0] + b0[1] * b0[1]) + (b0[2] * b0[2] + b0[3] * b0[3]) + (b1[0] * b1[0] + b1[1] * b1[1]) + (b1[2] * b1[2] + b1[3] * b1[3]);
                    ss += shx(ss, 16, ln_); ss += shx(ss, 32, ln_);
                    const float rq = __builtin_amdgcn_rsqf(ss * (1.f / 64.f) + EPS);
                    *(u32x4*)rowp = pack_f8(a0 * (g00 * rq), a1 * (g01 * rq)); *(u32x4*)(rowp + 32) = pack_f8(b0 * (g10 * rq), b1 * (g11 * rq)); }
        } else if (u.pn < 8) {
#pragma unroll
            for (int ai = 0; ai < 2; ++ai)
#pragma unroll
                for (int m = 0; m < 4; ++m) { const int r = row0 + ai * HALF + m * 16; const float rs = row_rstd(ssq, r); bf16_t* rowp = proj + (size_t)r * PJ + u.pn * BM + cin;
#pragma unroll
                    for (int bj = 0; bj < 2; ++bj) *(u32x4*)(rowp + bj * HALF) = pack_f8(acc[ai][bj][m][0] * rs, acc[ai][bj][m][1] * rs); }
        } else if (u.pn < 10) {
#pragma unroll
            for (int ai = 0; ai < 2; ++ai)
#pragma unroll
                for (int m = 0; m < 4; ++m) { const int r = row0 + ai * HALF + m * 16; const float rs = row_rstd(ssq, r);
                    const int b = r >> 14, s = r & (SEQ - 1), ko = s & 15, gq = ko >> 2, sg = (gq == 1) ? 2 : ((gq == 2) ? 1 : gq), slot = (s & ~15) | (sg * 4 + (ko & 3));
#pragma unroll
                    for (int bj = 0; bj < 2; ++bj) { const int head = (u.pn - 8) * 2 + bj; bf16_t* base = vt + ((size_t)((b * 4 + head) * 128 + cin)) * SEQ + slot;
                        const f32x4 v0 = acc[ai][bj][m][0] * rs, v1 = acc[ai][bj][m][1] * rs;
                        base[0] = f2bf(v0[0]); base[(size_t)SEQ] = f2bf(v0[1]); base[(size_t)2 * SEQ] = f2bf(v0[2]); base[(size_t)3 * SEQ] = f2bf(v0[3]);
                        base[(size_t)4 * SEQ] = f2bf(v1[0]); base[(size_t)5 * SEQ] = f2bf(v1[1]); base[(size_t)6 * SEQ] = f2bf(v1[2]); base[(size_t)7 * SEQ] = f2bf(v1[3]); } }
        } else {
            const int colg = (u.pn - 10) * BM + cin;
            f32x4 bv[2][2];
#pragma unroll
            for (int bj = 0; bj < 2; ++bj) { bv[bj][0] = *(const f32x4*)(bgate + colg + bj * HALF); bv[bj][1] = *(const f32x4*)(bgate + colg + bj * HALF + 4); }
#pragma unroll
            for (int ai = 0; ai < 2; ++ai)
#pragma unroll
                for (int m = 0; m < 4; ++m) { const int r = row0 + ai * HALF + m * 16; const float rs = row_rstd(ssq, r); bf16_t* rowp = gates + (size_t)r * GP + colg;
#pragma unroll
                    for (int bj = 0; bj < 2; ++bj) { f32x4 v0 = acc[ai][bj][m][0] * rs + bv[bj][0], v1 = acc[ai][bj][m][1] * rs + bv[bj][1];
#pragma unroll
                        for (int e = 0; e < 4; ++e) { v0[e] = fsigmoid(v0[e]); v1[e] = fsigmoid(v1[e]); }
                        *(u32x4*)(rowp + bj * HALF) = pack_f8(v0, v1); } }
        }
    }
};
template <int BR> struct EpiMerge {
    static constexpr bool PERM = true, AFTER_DRAIN = false;
    const bf16_t* gates; bf16_t* merged;
    __device__ __forceinline__ void operator()(const f32x4 (&acc)[2][2][4][2], const Unit& u, int wr, int wc, int fr, int fq) const {
        const int row0 = u.pm * BM + wr * 64 + fr, cin = wc * 32 + 8 * fq;
#pragma unroll
        for (int ai = 0; ai < 2; ++ai)
#pragma unroll
            for (int m = 0; m < 4; ++m) { const int r = row0 + ai * HALF + m * 16;
#pragma unroll
                for (int bj = 0; bj < 2; ++bj) { const int col = u.pn * BM + bj * HALF + cin;
                    const u32x4 g = *(const u32x4*)(gates + (size_t)r * GP + BR * 1024 + col);
                    bf16_t* mp = merged + (size_t)r * DM + col;
                    f32x4 o0 = {0.f, 0.f, 0.f, 0.f}, o1 = {0.f, 0.f, 0.f, 0.f};
                    if (BR > 0) { const u32x4 p = *(const u32x4*)mp; o0 = (f32x4){bflo(p.x), bfhi(p.x), bflo(p.y), bfhi(p.y)}; o1 = (f32x4){bflo(p.z), bfhi(p.z), bflo(p.w), bfhi(p.w)}; }
                    const f32x4 g0 = {bflo(g.x), bfhi(g.x), bflo(g.y), bfhi(g.y)}, g1 = {bflo(g.z), bfhi(g.z), bflo(g.w), bfhi(g.w)};
                    o0 += g0 * acc[ai][bj][m][0]; o1 += g1 * acc[ai][bj][m][1];
                    *(u32x4*)mp = pack_f8(o0, o1); }
                asm volatile("" ::: "memory"); }
    }
};
struct EpiResid {
    static constexpr bool PERM = true, AFTER_DRAIN = false;
    const float* xin; float* xout; bf16_t* xb; float* ssq;
    __device__ __forceinline__ void operator()(const f32x4 (&acc)[2][2][4][2], const Unit& u, int wr, int wc, int fr, int fq) const {
        const int row0 = u.pm * BM + wr * 64 + fr, cin = wc * 32 + 8 * fq;
#pragma unroll
        for (int ai = 0; ai < 2; ++ai)
#pragma unroll
            for (int m = 0; m < 4; ++m) { const int r = row0 + ai * HALF + m * 16; float ss = 0.f;
#pragma unroll
                for (int bj = 0; bj < 2; ++bj) { const size_t off = (size_t)r * DM + u.pn * BM + bj * HALF + cin;
                    f32x4 x0 = *(const f32x4*)(xin + off), x1 = *(const f32x4*)(xin + off + 4);
                    x0 += acc[ai][bj][m][0]; x1 += acc[ai][bj][m][1];
                    *(f32x4*)(xout + off) = x0; *(f32x4*)(xout + off + 4) = x1;
                    *(u32x4*)(xb + off) = pack_f8(x0, x1);
                    ss += (x0[0] * x0[0] + x0[1] * x0[1]) + (x0[2] * x0[2] + x0[3] * x0[3]) + (x1[0] * x1[0] + x1[1] * x1[1]) + (x1[2] * x1[2] + x1[3] * x1[3]); }
                { const int ln_ = fr | (fq << 4); ss += shx(ss, 16, ln_); ss += shx(ss, 32, ln_); }
                if (fq == 0) ssq[(size_t)r * 16 + u.pn * 4 + wc] = ss;
                asm volatile("" ::: "memory"); }
    }
};
struct EpiFfn1 {
    static constexpr bool PERM = true, AFTER_DRAIN = false;
    bf16_t* hid; const float* ssq;
    __device__ __forceinline__ void operator()(const f32x4 (&acc)[2][2][4][2], const Unit& u, int wr, int wc, int fr, int fq) const {
        const int row0 = u.pm * BM + wr * 64 + fr, cin = wc * 32 + 8 * fq;
#pragma unroll
        for (int ai = 0; ai < 2; ++ai)
#pragma unroll
            for (int m = 0; m < 4; ++m) { const int r = row0 + ai * HALF + m * 16; const float rs = row_rstd(ssq, r);
                f32x4 o[2];
#pragma unroll
                for (int n = 0; n < 2; ++n) { const f32x4 g = acc[ai][0][m][n] * rs, up = acc[ai][1][m][n] * rs;
#pragma unroll
                    for (int e = 0; e < 4; ++e) o[n][e] = g[e] * fsigmoid(g[e]) * up[e]; }
                *(u32x4*)(hid + (size_t)r * FF + u.pn * HALF + cin) = pack_f8(o[0], o[1]);
                asm volatile("" ::: "memory"); }
    }
};
}

#define XB_TMO      128
#define XB_XCNT(j)  (256  + 64 * (j))
#define XB_XSUB(j)  (1280 + 64 * (j))
#define XB_XGEN(j)  (2304 + 64 * (j))
#define XB_TOP      3328
#define XB_TOPGEN   3392
#define XCD_BAR_WORDS 3456
#define XB_SPIN_CAP (1u << 18)

__device__ __forceinline__ unsigned xb_ld(unsigned* p)              { return __hip_atomic_load(p, __ATOMIC_RELAXED, __HIP_MEMORY_SCOPE_AGENT); }
__device__ __forceinline__ unsigned xb_add(unsigned* p, unsigned v) { return __hip_atomic_fetch_add(p, v, __ATOMIC_RELAXED, __HIP_MEMORY_SCOPE_AGENT); }
__device__ __forceinline__ unsigned xb_xcc_id() { return (unsigned)__builtin_amdgcn_s_getreg((3 << 11) | 20) & 0xFu; }
#define XB_SPIN(cond, bar) do { unsigned _sp = 0; while (cond) { __builtin_amdgcn_s_sleep(1); \
    if ((++_sp & 255u) == 0u) { if (xb_ld(&(bar)[XB_TMO])) break; if (_sp > XB_SPIN_CAP) { atomicAdd(&(bar)[XB_TMO], 1u); break; } } } } while (0)

struct XcdBarrier {
    unsigned* bar; unsigned x;
    volatile LAS unsigned* st;
};

__device__ __forceinline__ XcdBarrier xcd_barrier_post(unsigned* bar, volatile LAS unsigned* st, bool is0) {
    XcdBarrier b; b.bar = bar; b.x = xb_xcc_id(); b.st = st;
    if (is0) (void)xb_add(&bar[XB_XCNT(b.x)], 1u);
    return b;
}
__device__ __forceinline__ void xcd_barrier_complete(unsigned* bar, unsigned x, unsigned& nloc, unsigned& nx) {
    const unsigned G = gridDim.x * gridDim.y * gridDim.z;
    unsigned sum, cnt, mine, sp = 0u;
    for (;;) {
        sum = 0u; cnt = 0u; mine = 0u;
#pragma unroll
        for (unsigned j = 0; j < 16; ++j) { const unsigned c = xb_ld(&bar[XB_XCNT(j)]); sum += c; cnt += (c > 0u) ? 1u : 0u; mine = (j == x) ? c : mine; }
        if (sum == G) break;
        __builtin_amdgcn_s_sleep(1);
        if ((++sp & 255u) == 0u) { if (xb_ld(&bar[XB_TMO])) break; if (sp > XB_SPIN_CAP) { atomicAdd(&bar[XB_TMO], 1u); break; } }
    }
    nloc = mine > 0u ? mine : 1u; nx = cnt > 0u ? cnt : 1u;
}

__device__ __forceinline__ void xcd_barrier(const XcdBarrier& b, bool is0) {
    asm volatile("s_waitcnt vmcnt(0)" ::: "memory");
    __syncthreads();
    if (is0) {
        unsigned* bar = b.bar;
        __builtin_amdgcn_s_waitcnt(0);
        unsigned nloc = b.st[0], nx = b.st[1];
        if (nloc == 0u) { xcd_barrier_complete(bar, b.x, nloc, nx); b.st[0] = nloc; b.st[1] = nx; }
        const unsigned old = xb_add(&bar[XB_XSUB(b.x)], 1u);
        const unsigned gen = old / nloc;
        if (old + 1u == (gen + 1u) * nloc) {
            __builtin_amdgcn_fence(__ATOMIC_RELEASE, "agent");
            asm volatile("s_waitcnt vmcnt(0)" ::: "memory");
            const unsigned og = xb_add(&bar[XB_TOP], 1u);
            const unsigned tg = og / nx;
            if (og + 1u == (tg + 1u) * nx) xb_add(&bar[XB_TOPGEN], 1u);
            else XB_SPIN(xb_ld(&bar[XB_TOPGEN]) == tg, bar);
            __builtin_amdgcn_fence(__ATOMIC_ACQUIRE, "agent");
            xb_add(&bar[XB_XGEN(b.x)], 1u);
            asm volatile("s_waitcnt vmcnt(0)" ::: "memory");
        } else {
            XB_SPIN(xb_ld(&bar[XB_XGEN(b.x)]) == gen, bar);
            __builtin_amdgcn_fence(__ATOMIC_ACQUIRE, "agent");
            asm volatile("s_waitcnt vmcnt(0)" ::: "memory");
        }
    }
    __syncthreads();
}


struct Args { const float* in[31]; float* out; unsigned char* ws; };
typedef const float* cfptr_t;
__device__ __forceinline__ cfptr_t kin(int i) { const volatile __attribute__((address_space(4))) cfptr_t* p = (const volatile __attribute__((address_space(4))) cfptr_t*)__builtin_amdgcn_kernarg_segment_ptr(); return p[i]; }

__device__ __forceinline__ void conv_item(const float* W, int N, int k0, int n0, bf16_t* dst, int ldk, const float* gain, LAS float* scr, int tid, bool split = false) {
    const int n = tid & 63, kq = tid >> 6;
#pragma unroll
    for (int i = 0; i < 8; ++i) { const int k = kq + 8 * i; float v = W[(size_t)(k0 + k) * N + n0 + n]; if (gain) v *= gain[k0 + k]; scr[k * 65 + n] = v; }
    __syncthreads();
    const int nn = tid >> 3, c = tid & 7;
    const LAS float* s = scr + (8 * c) * 65 + nn;
    u32x4 o; o.x = pk2(s[0], s[65]); o.y = pk2(s[130], s[195]); o.z = pk2(s[260], s[325]); o.w = pk2(s[390], s[455]);
    *(u32x4*)(dst + (size_t)((split && nn >= 32) ? nn + 96 : nn) * ldk + k0 + 8 * c) = o;
    __syncthreads();
}
__device__ __forceinline__ void convert_layer(int l, unsigned char* Wb, LAS float* scr, int tid, int bid, int G) {
    for (int it = bid; it < 4032; it += G) {
        int r = it;
        if (r < 1408) { const int kb = r / 88, nb = r % 88; const bool qk = (nb >= 16 && nb < 32); const int brow = qk ? (256 * (4 + ((nb - 16) >> 2)) + 32 * ((nb - 16) & 3)) : nb * 64;
            conv_item(kin(2) + (size_t)l * DM * INC, INC, kb * 64, nb * 64, (bf16_t*)(Wb + W_IN) + (size_t)brow * DM, DM, kin(1) + l * DM, scr, tid, qk); continue; } r -= 1408;
        if (r < 64) { const int kb = r / 16, nb = r % 16; conv_item(kin(23) + (size_t)l * 256 * DM, DM, kb * 64, nb * 64, (bf16_t*)(Wb + W_PA) + (size_t)nb * 64 * 256, 256, nullptr, scr, tid); continue; } r -= 64;
        if (r < 64) { const int kb = r / 16, nb = r % 16; conv_item(kin(24) + (size_t)l * 256 * DM, DM, kb * 64, nb * 64, (bf16_t*)(Wb + W_PB) + (size_t)nb * 64 * 256, 256, nullptr, scr, tid); continue; } r -= 64;
        if (r < 128) { const int kb = r / 16, nb = r % 16; conv_item(kin(25) + (size_t)l * 512 * DM, DM, kb * 64, nb * 64, (bf16_t*)(Wb + W_PC) + (size_t)nb * 64 * 512, 512, nullptr, scr, tid); continue; } r -= 128;
        if (r < 256) { const int kb = r / 16, nb = r % 16; conv_item(kin(26) + (size_t)l * DM * DM, DM, kb * 64, nb * 64, (bf16_t*)(Wb + W_O) + (size_t)nb * 64 * DM, DM, nullptr, scr, tid); continue; } r -= 256;
        if (r < 704) { const int kb = r / 44, nb = r % 44; conv_item(kin(28) + (size_t)l * DM * FF, FF, kb * 64, nb * 64, (bf16_t*)(Wb + W_FF) + (size_t)(256 * (nb >> 1) + 64 * (nb & 1)) * DM, DM, kin(27) + l * DM, scr, tid); continue; } r -= 704;
        if (r < 704) { const int kb = r / 44, nb = r % 44; conv_item(kin(29) + (size_t)l * DM * FF, FF, kb * 64, nb * 64, (bf16_t*)(Wb + W_FF) + (size_t)(256 * (nb >> 1) + 128 + 64 * (nb & 1)) * DM, DM, kin(27) + l * DM, scr, tid); continue; } r -= 704;
        { const int kb = r / 16, nb = r % 16; conv_item(kin(30) + (size_t)l * FF * DM, DM, kb * 64, nb * 64, (bf16_t*)(Wb + W_DN) + (size_t)nb * 64 * FF, FF, nullptr, scr, tid); }
    }
}
__device__ __forceinline__ void convert_small(bf16_t* sm, int tid, int bid, int G) {
    for (int idx = bid * 512 + tid; idx < NL * SMALL_PER_LAYER; idx += G * 512) {
        const int l = idx / SMALL_PER_LAYER, e = idx % SMALL_PER_LAYER; float v;
        if (e < 32768) { const int e2 = e & 16383, hd = e2 >> 12, o = (e2 >> 6) & 63, i = e2 & 63; const float* src = (e < 16384) ? kin(6) : kin(8); v = src[(size_t)((l * 4 + hd) * 64 + i) * 64 + o]; }
        else { const int e2 = e - 32768, t = (e2 >> 7) & 127, s = e2 & 127; v = (s <= t) ? kin(13)[(size_t)l * 65536 + e2] : 0.f; }
        sm[idx] = f2bf(v);
    }
}
__device__ __forceinline__ void x_pass(const float* x, bf16_t* xb, float* ssq, int lane, int gw, int NGW) {
    for (int m = gw; m < MT; m += NGW) {
        const f32x4* xr = (const f32x4*)(x + (size_t)m * DM) + lane; u32x2* o = (u32x2*)(xb + (size_t)m * DM) + lane; float ss = 0.f;
#pragma unroll
        for (int j = 0; j < 4; ++j) { const f32x4 v = xr[64 * j]; ss += (v[0] * v[0] + v[1] * v[1]) + (v[2] * v[2] + v[3] * v[3]); u32x2 w; w.x = pk2(v[0], v[1]); w.y = pk2(v[2], v[3]); o[64 * j] = w; }
        ss = wave_sum(ss, lane);
        if (lane < 16) ssq[(size_t)m * 16 + lane] = (lane == 0) ? ss : 0.f;
    }
}
__device__ __forceinline__ void qk_norm(bf16_t* proj, bf16_t* outp, int opitch, const float* qg, const float* kg, int lane, int gw, int NGW) {
    const int d0 = (lane * 8) & 63; float gq[8], gk[8];
#pragma unroll
    for (int e = 0; e < 8; ++e) { gq[e] = qg[d0 + e] * (0.125f * LOG2E); gk[e] = kg[d0 + e]; }
    for (int m = gw; m < MT; m += NGW) {
        bf16_t* base = proj + (size_t)m * PJ + 1024;
#pragma unroll
        for (int i = 0; i < 2; ++i) { const u32x4* p = (const u32x4*)(base + (lane + 64 * i) * 8); const u32x4 v = *p; u32x4* po = (u32x4*)(outp + (size_t)m * opitch + (lane + 64 * i) * 8);
            float f[8] = {bflo(v.x), bfhi(v.x), bflo(v.y), bfhi(v.y), bflo(v.z), bfhi(v.z), bflo(v.w), bfhi(v.w)};
            float ss = 0.f;
#pragma unroll
            for (int e = 0; e < 8; ++e) ss += f[e] * f[e];
            ss += shx(ss, 1, lane); ss += shx(ss, 2, lane); ss += shx(ss, 4, lane);
            const float rs = __builtin_amdgcn_rsqf(ss * (1.f / 64.f) + EPS);
#pragma unroll
            for (int e = 0; e < 8; ++e) f[e] *= rs * (i == 0 ? gq[e] : gk[e]);
            u32x4 w; w.x = pk2(f[0], f[1]); w.y = pk2(f[2], f[3]); w.z = pk2(f[4], f[5]); w.w = pk2(f[6], f[7]); *po = w; }
    }
}

constexpr int LRU_XA = 0, LRU_XP = 528, LRU_CW = 35392;
struct LruP { const float *cw, *cb, *ba, *bi, *lam; const bf16_t *waT, *wiT; };
template <bool FINAL> __device__ __forceinline__ void lru_unit(LAS unsigned char* lds, bf16_t* proj, bf16_t* outp, int opitch, float* agg, const LruP& P, int b, int chunk, int tid) {
    const int lane = tid & 63, r = lane & 31, h = lane >> 5, w = __builtin_amdgcn_readfirstlane(tid >> 6), hd = w >> 1, cbk = w & 1;
    const size_t Rb = (size_t)b * SEQ; const int t0 = chunk * 64;
    for (int c = tid; c < 67 * 32; c += 512) { const int j = c >> 5, cc = c & 31, tok = t0 - 3 + j; u32x4 v = {0u, 0u, 0u, 0u};
        if (tok >= 0) v = *(const u32x4*)(proj + (Rb + tok) * PJ + cc * 8);
        *(LAS u32x4*)(lds + LRU_XA + j * LRU_XP + cc * 16) = v; }
    LAS float* CWl = (LAS float*)(lds + LRU_CW);
    for (int i = tid; i < 1280; i += 512) CWl[i] = (i < 1024) ? P.cw[i] : P.cb[i - 1024];
    __syncthreads();
    const int oc = hd * 64 + cbk * 32 + r;
    float Hc = 0.f;
    if (FINAL) {
        const int mid = chunk >> 1, lo = h ? mid : 0, hi2 = h ? chunk : mid; float PA = 1.f, PH = 0.f;
        const f32x2* ap = (const f32x2*)agg + ((size_t)b * 256) * 256 + oc;
#pragma unroll 4
        for (int j = lo; j < hi2; ++j) { const f32x2 q = ap[(size_t)j * 256]; PH = q.x * PH + q.y; PA *= q.x; }
        const float oPA = shx(PA, 32, lane), oPH = shx(PH, 32, lane);
        Hc = h ? (PA * oPH + PH) : (oPA * PH + oPH);
        asm volatile("" : "+v"(Hc));
    }
    const float cw0 = CWl[oc], cw1 = CWl[256 + oc], cw2 = CWl[512 + oc], cw3 = CWl[768 + oc], cbv = CWl[1024 + oc];
    const float bav = P.ba[oc], biv = P.bi[oc], elam = __builtin_amdgcn_exp2f(-P.lam[oc] * LOG2E), cl = -8.f * ((elam < 0.03f) ? elam * (1.f - elam * (0.5f - elam * (0.33333334f - elam * 0.25f))) : __builtin_amdgcn_logf(1.f + elam) * 0.6931471805599453f);
    float av[2][16], bv[2][16];
#pragma unroll
    for (int rb = 0; rb < 2; ++rb) { f32x16 acca = (f32x16){}, acci = (f32x16){};
#pragma unroll
        for (int ks = 0; ks < 4; ++ks) { const int ci0 = hd * 64 + 16 * ks + 8 * h;
            const bf16x8 waf = *(const bf16x8*)(P.waT + (size_t)oc * 64 + 16 * ks + 8 * h), wif = *(const bf16x8*)(P.wiT + (size_t)oc * 64 + 16 * ks + 8 * h);
            const f32x4 c0 = *(const LAS f32x4*)(CWl + 1024 + ci0), c1 = *(const LAS f32x4*)(CWl + 1024 + ci0 + 4);
            float xc[8] = {c0[0], c0[1], c0[2], c0[3], c1[0], c1[1], c1[2], c1[3]};
#pragma unroll
            for (int tap = 0; tap < 4; ++tap) { const u32x4 xv = *(const LAS u32x4*)(lds + LRU_XA + (32 * rb + r + tap) * LRU_XP + ci0 * 2);
                const f32x4 w0 = *(const LAS f32x4*)(CWl + tap * 256 + ci0), w1 = *(const LAS f32x4*)(CWl + tap * 256 + ci0 + 4);
                xc[0] += w0[0] * bflo(xv.x); xc[1] += w0[1] * bfhi(xv.x); xc[2] += w0[2] * bflo(xv.y); xc[3] += w0[3] * bfhi(xv.y);
                xc[4] += w1[0] * bflo(xv.z); xc[5] += w1[1] * bfhi(xv.z); xc[6] += w1[2] * bflo(xv.w); xc[7] += w1[3] * bfhi(xv.w); }
            const bf16x8 af = pack8(xc[0], xc[1], xc[2], xc[3], xc[4], xc[5], xc[6], xc[7]);
            acca = MFMA32(af, waf, acca); acci = MFMA32(af, wif, acci); }
#pragma unroll
        for (int i = 0; i < 16; ++i) { const int tok = 32 * rb + crow(i, h);
            const LAS bf16_t* xp = (const LAS bf16_t*)(lds + LRU_XA + tok * LRU_XP + oc * 2);
            const float xc = cbv + cw0 * bf2f(xp[0]) + cw1 * bf2f(xp[LRU_XP / 2]) + cw2 * bf2f(xp[LRU_XP]) + cw3 * bf2f(xp[3 * LRU_XP / 2]);
            const float rg = fsigmoid(acca[i] + bav), ig = fsigmoid(acci[i] + biv), la = cl * rg;
            const float x2 = 2.f * la;
            const float em1 = (x2 > -0.03f) ? x2 * (1.f + x2 * (0.5f + x2 * (0.16666667f + x2 * 0.041666668f))) : (__builtin_amdgcn_exp2f(x2 * LOG2E) - 1.f);
            av[rb][i] = __builtin_amdgcn_exp2f(la * LOG2E); bv[rb][i] = __builtin_amdgcn_sqrtf(-em1) * ig * xc; }
#pragma unroll
        for (int i = 0; i < 16; ++i) asm volatile("" : "+v"(av[rb][i]), "+v"(bv[rb][i]));
    }
    float Ag[8], Bg[8];
#pragma unroll
    for (int k = 0; k < 8; ++k) { const int rb = k >> 2, i0 = 4 * (k & 3);
        Ag[k] = (av[rb][i0] * av[rb][i0 + 1]) * (av[rb][i0 + 2] * av[rb][i0 + 3]);
        Bg[k] = ((bv[rb][i0] * av[rb][i0 + 1] + bv[rb][i0 + 1]) * av[rb][i0 + 2] + bv[rb][i0 + 2]) * av[rb][i0 + 3] + bv[rb][i0 + 3]; }
    float myin[8]; float Pp = 1.f;
#pragma unroll
    for (int k = 0; k < 8; ++k) { const float pA = shx(Ag[k], 32, lane), pB = shx(Bg[k], 32, lane);
        const float A0 = h ? pA : Ag[k], B0 = h ? pB : Bg[k], A1 = h ? Ag[k] : pA, B1 = h ? Bg[k] : pB;
        const float in0 = Hc; Hc = A0 * Hc + B0; const float in1 = Hc; Hc = A1 * Hc + B1; myin[k] = h ? in1 : in0; Pp *= A0 * A1; }
    if (!FINAL) { if (h == 0) { f32x2 q; q.x = Pp; q.y = Hc; ((f32x2*)agg)[((size_t)b * 256 + chunk) * 256 + oc] = q; } }
    else {
#pragma unroll
        for (int k = 0; k < 8; ++k) { const int rb = k >> 2, i0 = 4 * (k & 3); float hh = myin[k];
#pragma unroll
            for (int j = 0; j < 4; ++j) { hh = av[rb][i0 + j] * hh + bv[rb][i0 + j]; const int tok = 32 * rb + 8 * (k & 3) + 4 * h + j;
                const bf16_t* gp = proj + (Rb + t0 + tok) * PJ + 256 + oc; const float ga = bf2f(*gp); bf16_t* go = outp + (Rb + t0 + tok) * opitch + oc;
                const float z = 1.5957691216057308f * (ga + 0.044715f * ga * ga * ga);
                *go = f2bf(hh * ga * fsigmoid(z)); }
            asm volatile("" ::: "memory"); }
    }
    __syncthreads();
}

constexpr int SG_VP = 272;
struct SgP { const float *lng, *lnb, *sgb; const bf16_t* sgw; };
__device__ __forceinline__ void sg_unit(LAS unsigned char* lds, bf16_t* proj, bf16_t* outp, int opitch, const SgP& P, int n, int tid) {
    const int lane = tid & 63, r = lane & 31, h = lane >> 5, w = __builtin_amdgcn_readfirstlane(tid >> 6);
    const size_t R0 = (size_t)n * 128;
    { const f32x4 g4 = *(const f32x4*)(P.lng + lane * 4), b4 = *(const f32x4*)(P.lnb + lane * 4);
      for (int rr = 0; rr < 16; ++rr) { const int t = w * 16 + rr; const u32x2 raw = *(const u32x2*)(proj + (R0 + t) * PJ + 768 + lane * 4);
        float v[4] = {bflo(raw.x), bfhi(raw.x), bflo(raw.y), bfhi(raw.y)};
        const float mean = wave_sum((v[0] + v[1]) + (v[2] + v[3]), lane) * (1.f / 256.f);
#pragma unroll
        for (int e = 0; e < 4; ++e) v[e] -= mean;
        const float var = wave_sum((v[0] * v[0] + v[1] * v[1]) + (v[2] * v[2] + v[3] * v[3]), lane) * (1.f / 256.f);
        const float rs = __builtin_amdgcn_rsqf(var + EPS);
#pragma unroll
        for (int e = 0; e < 4; ++e) *(LAS bf16_t*)(lds + (lane * 4 + e) * SG_VP + t * 2) = f2bf(v[e] * rs * g4[e] + b4[e]); } }
    __syncthreads();
    const int g = w >> 1, cbk = w & 1, c = g * 64 + cbk * 32 + r;
#pragma unroll
    for (int tb = 0; tb < 4; ++tb) { f32x16 acc = (f32x16){};
        const bf16_t* wp = P.sgw + (size_t)(g * 128 + 32 * tb + r) * 128 + 8 * h;
#pragma unroll
        for (int ks = 0; ks < 2 * tb + 2; ++ks) { const bf16x8 af = *(const bf16x8*)(wp + 16 * ks); const bf16x8 bfr = *(const LAS bf16x8*)(lds + c * SG_VP + (16 * ks + 8 * h) * 2); acc = MFMA32(af, bfr, acc); }
#pragma unroll
        for (int i = 0; i < 16; ++i) { const int t = 32 * tb + crow(i, h); const bf16_t* up = proj + (R0 + t) * PJ + 512 + c; outp[(R0 + t) * opitch + c] = f2bf(bf2f(*up) * (acc[i] + P.sgb[g * 128 + t])); } }
    __syncthreads();
}

constexpr int AT_SLOT = 16384, AT_K = 0, AT_V = 4 * AT_SLOT, AT_TAB = 131072 + 1024;
__device__ __forceinline__ void glds16(const void* gsrc, unsigned lds_dst) {
    unsigned keep;
    asm volatile("s_mov_b32 %0, m0\n\ts_mov_b32 m0, %2\n\ts_nop 0\n\tglobal_load_lds_dwordx4 %1, off\n\ts_mov_b32 m0, %0" : "=&s"(keep) : "v"(gsrc), "s"(lds_dst) : "memory");
}
__device__ __forceinline__ void at_qk(f32x16& p0, f32x16& p1, const LAS unsigned char* lk, const int (&koff)[4], const bf16x8 (&qf)[4]) {
    const f32x16 z = (f32x16){};
#pragma unroll
    for (int ks = 0; ks < 4; ++ks) { const bf16x8 a0 = *(const LAS bf16x8*)(lk + koff[ks]), a1 = *(const LAS bf16x8*)(lk + koff[ks] + 8192);
        p0 = MFMA32(a0, qf[ks], ks == 0 ? z : p0); p1 = MFMA32(a1, qf[ks], ks == 0 ? z : p1); }
}
__device__ __forceinline__ void at_bias(f32x16& p0, f32x16& p1, const LAS float* tb) {
#pragma unroll
    for (int i = 0; i < 16; ++i) { const int kk = (i & 3) + 8 * (i >> 2); p0[i] += tb[kk]; p1[i] += tb[32 + kk]; }
}
template <bool DOQK, bool DOEXP, bool DOPV, int VAR> __device__ __forceinline__ void at_fused(f32x16& pn0, f32x16& pn1, f32x16& pc0, f32x16& pc1, bf16x8 (&pfc)[4], const bf16x8 (&pfp)[4], f32x16 (&o)[4], float& lsum,
                                         const LAS unsigned char* lk, const LAS unsigned char* lv, const int (&koff)[4], const int (&voff)[4], const bf16x8 (&qf)[4]) {
    constexpr int PD = 4, NF = PD + 1;
    bf16x8 fr[NF];
#define AT_NEED(g) (((g) < 8) ? DOQK : DOPV)
#define AT_FRAG(g) (((g) < 8) ? *(const LAS bf16x8*)(lk + koff[(g) >> 1] + ((g) & 1) * 8192) : *(const LAS bf16x8*)(lv + voff[((g) - 8) >> 2] + (((g) - 8) & 3) * 4096))
#define AT_EX2(x) ((VAR == 1) ? (x) : __builtin_amdgcn_exp2f(x))
#define AT_EXP(e) do { if ((e) < 16) { pc0[(e)] = AT_EX2(pc0[(e)]); s0 += pc0[(e)]; } else { pc1[(e) - 16] = AT_EX2(pc1[(e) - 16]); s1 += pc1[(e) - 16]; } } while (0)
#pragma unroll
    for (int g = 0; g < PD; ++g) { if (AT_NEED(g)) fr[g % NF] = AT_FRAG(g); else fr[g % NF] = (bf16x8){}; }
    float s0 = 0.f, s1 = 0.f;
    const f32x16 z = (f32x16){};
#pragma unroll
    for (int g = 0; g < 24; ++g) {
        if (g + PD < 24 && AT_NEED(g + PD)) fr[(g + PD) % NF] = AT_FRAG(g + PD);
        if (g < 8) { const int ks = g >> 1;
            if (!DOQK || VAR == 2) {} else if (g & 1) pn1 = MFMA32(fr[g % NF], qf[ks], ks == 0 ? z : pn1); else pn0 = MFMA32(fr[g % NF], qf[ks], ks == 0 ? z : pn0);
        } else if (DOPV && VAR != 2) { const int sp = (g - 8) >> 2, db = (g - 8) & 3; o[db] = MFMA32(fr[g % NF], pfp[sp], o[db]); }
        if (DOEXP) {
            const int e0 = g + (g + 2) / 3, e1 = (g + 1) + (g + 3) / 3;
#pragma unroll
            for (int e = e0; e < e1; ++e) AT_EXP(e);
            asm volatile("" : "+v"(s0), "+v"(s1));
            if (g == 6) pfc[0] = pack8(pc0[0], pc0[1], pc0[2], pc0[3], pc0[4], pc0[5], pc0[6], pc0[7]);
            if (g == 12) pfc[1] = pack8(pc0[8], pc0[9], pc0[10], pc0[11], pc0[12], pc0[13], pc0[14], pc0[15]);
            if (g == 18) pfc[2] = pack8(pc1[0], pc1[1], pc1[2], pc1[3], pc1[4], pc1[5], pc1[6], pc1[7]);
        }
        __builtin_amdgcn_sched_barrier(0);
    }
    if (DOEXP) { pfc[3] = pack8(pc1[8], pc1[9], pc1[10], pc1[11], pc1[12], pc1[13], pc1[14], pc1[15]); lsum += s0 + s1; }
#undef AT_FRAG
#undef AT_NEED
#undef AT_EXP
#undef AT_EX2
}
template <int VAR> __device__ __forceinline__ void attn_unit(LAS unsigned char* lds, const bf16_t* proj, const bf16_t* vt, bf16_t* outp, int opitch, int b, int hd, int qb, float lam, float osc, const float* relb, const float* subg, int tid_in) {
    int tid = tid_in; asm volatile("" : "+v"(tid));
    const int lane = tid & 63, r = lane & 31, h = lane >> 5, w = __builtin_amdgcn_readfirstlane(tid >> 6), mp = w >> 2, rs = w & 3;
    LAS float* tab = (LAS float*)(lds + AT_TAB);
    const size_t Rb = (size_t)b * SEQ, R0 = Rb + (size_t)qb * 128;
    const int NT = 2 * qb + 2;
    const bool deep = NT >= 8;
    const int rk0 = 8 * w + (lane >> 4), rk1 = rk0 + 4, rv0 = 16 * w + (lane >> 3), rv1 = rv0 + 8;
    const bf16_t* ks0 = proj + (Rb + rk0) * PJ + 1536 + hd * 128 + (((lane & 15) ^ (rk0 & 15)) * 8);
    const bf16_t* ks1 = proj + (Rb + rk1) * PJ + 1536 + hd * 128 + (((lane & 15) ^ (rk1 & 15)) * 8);
    const bf16_t* vs0 = vt + ((size_t)((b * 4 + hd) * 128 + rv0)) * SEQ + (((lane & 7) ^ ((rv0 >> 1) & 7)) * 8);
    const bf16_t* vs1 = vt + ((size_t)((b * 4 + hd) * 128 + rv1)) * SEQ + (((lane & 7) ^ ((rv1 >> 1) & 7)) * 8);
    const unsigned ldsb = (unsigned)(uintptr_t)lds, kd = ldsb + AT_K + w * 2048, vd = ldsb + AT_V + w * 2048;
#define AT_ISSUE_K(j) do { const unsigned d_ = (unsigned)__builtin_amdgcn_readfirstlane(kd + ((j) & 3) * AT_SLOT); if (VAR != 3) { glds16(ks0 + (size_t)(j) * 64 * PJ, d_); glds16(ks1 + (size_t)(j) * 64 * PJ, d_ + 1024u); } } while (0)
#define AT_ISSUE_V(j) do { const unsigned d_ = (unsigned)__builtin_amdgcn_readfirstlane(vd + ((j) & 3) * AT_SLOT); if (VAR != 3) { glds16(vs0 + (j) * 64, d_); glds16(vs1 + (j) * 64, d_ + 1024u); } } while (0)
#define AT_WAITBAR(N) asm volatile("s_waitcnt vmcnt(" #N ") lgkmcnt(0)\n\ts_barrier" ::: "memory")
    AT_ISSUE_K(0); AT_ISSUE_K(1);
    if (2 < NT) AT_ISSUE_K(2);
    AT_ISSUE_V(0);
    if (3 < NT) AT_ISSUE_K(3);
    AT_ISSUE_V(1);
    { const float cfar = relb[15 * 4 + hd];
      if (tid < 64) tab[1216 + tid] = -INFINITY;
      for (int idx = tid; idx < 1216; idx += 512) { const int rel = idx - 1151, n = rel < 0 ? -rel : rel; int bk = (n < 8) ? n : (5 + (31 - __builtin_clz(n))); bk = bk > 15 ? 15 : bk; if (rel > 0) bk += 16; tab[idx] = (relb[bk * 4 + hd] - cfar) * LOG2E; } }
    bf16x8 qf[4];
    { const bf16_t* qp = proj + (R0 + 32 * rs + r) * PJ + 1024 + hd * 128 + mp * 64 + 8 * h;
#pragma unroll
      for (int ks = 0; ks < 4; ++ks) qf[ks] = *(const bf16x8*)(qp + 16 * ks); }
    int koff[4], voff[4];
    { const int kx = (mp * 8 + h) ^ (r & 15), vx = h ^ ((r >> 1) & 7);
#pragma unroll
      for (int i = 0; i < 4; ++i) { koff[i] = r * 256 + ((kx ^ (2 * i)) << 4); voff[i] = r * 128 + ((vx ^ (2 * i)) << 4); } }
    if (deep) AT_WAITBAR(8); else AT_WAITBAR(0);
    f32x16 o[4]; o[0] = (f32x16){}; o[1] = (f32x16){}; o[2] = (f32x16){}; o[3] = (f32x16){};
    float lsum = 0.f;
    const int qpos = qb * 128 + 32 * rs + r;
    const LAS float* tb0 = tab + (1151 + 4 * h - qpos);
    f32x16 pa0, pa1, pb0, pb1; bf16x8 pfA[4], pfB[4];
    pb0 = (f32x16){}; pb1 = (f32x16){};
#pragma unroll
    for (int i = 0; i < 4; ++i) { pfA[i] = (bf16x8){}; pfB[i] = (bf16x8){}; }
    at_qk(pa0, pa1, lds + AT_K, koff, qf);
    if (1088 > qb * 128) at_bias(pa0, pa1, tb0);
    asm volatile("s_waitcnt lgkmcnt(0)\n\ts_barrier" ::: "memory");
#define AT_STEP(t, C0, C1, N0, N1, PC, PP, DOPV) do { \
        if ((t) + 4 < NT) AT_ISSUE_K((t) + 4); \
        if ((t) + 2 < NT) AT_ISSUE_V((t) + 2); \
        at_fused<true, true, DOPV, VAR>(N0, N1, C0, C1, PC, PP, o, lsum, lds + AT_K + (((t) + 1) & 3) * AT_SLOT, lds + AT_V + (((t) + 3) & 3) * AT_SLOT, koff, voff, qf); \
        if (((t) + 1) * 64 + 1088 > qb * 128) at_bias(N0, N1, (rs < 2 && (t) + 2 == NT) ? (const LAS float*)(tab + 1216) : tb0 + ((t) + 1) * 64); \
        if ((t) + 4 < NT) AT_WAITBAR(8); else AT_WAITBAR(0); } while (0)
    AT_STEP(0, pa0, pa1, pb0, pb1, pfA, pfB, false);
    for (int t = 1; t + 1 < NT; t += 2) {
        AT_STEP(t, pb0, pb1, pa0, pa1, pfB, pfA, true);
        AT_STEP(t + 1, pa0, pa1, pb0, pb1, pfA, pfB, true);
    }
    at_fused<false, true, true, VAR>(pa0, pa1, pb0, pb1, pfB, pfA, o, lsum, lds + AT_K, lds + AT_V + ((NT - 2) & 3) * AT_SLOT, koff, voff, qf);
    at_fused<false, false, true, VAR>(pa0, pa1, pb0, pb1, pfA, pfB, o, lsum, lds + AT_K, lds + AT_V + ((NT - 1) & 3) * AT_SLOT, koff, voff, qf);
    __syncthreads();
#undef AT_STEP
#undef AT_ISSUE_K
#undef AT_ISSUE_V
#undef AT_WAITBAR
    int lane_e = tid & 63; asm volatile("" : "+v"(lane_e));
    lsum += shx(lsum, 32, lane_e);
    const float inv = __builtin_amdgcn_rcpf(lsum);
    LAS float* ex = (LAS float*)lds;
    if (mp == 1) {
#pragma unroll
        for (int db = 0; db < 4; ++db)
#pragma unroll
            for (int i = 0; i < 16; ++i) ex[((rs * 4 + db) * 16 + i) * 64 + lane_e] = o[db][i] * inv;
    }
    __syncthreads();
    if (mp == 0) {
        float ss = 0.f;
#pragma unroll
        for (int db = 0; db < 4; ++db)
#pragma unroll
            for (int i = 0; i < 16; ++i) { const float v = o[db][i] * inv - lam * ex[((rs * 4 + db) * 16 + i) * 64 + lane_e]; o[db][i] = v; ss += v * v; }
        ss += shx(ss, 32, lane_e);
        const float rsn = __builtin_amdgcn_rsqf(ss * (1.f / 128.f) + EPS) * osc;
        const int r_e = lane_e & 31, h_e = lane_e >> 5; bf16_t* op = outp + (R0 + 32 * rs + r_e) * opitch + hd * 128;
#pragma unroll
        for (int db = 0; db < 4; ++db)
#pragma unroll
            for (int i4 = 0; i4 < 4; ++i4) { const int d = 32 * db + 8 * i4 + 4 * h_e; const f32x4 g4 = *(const f32x4*)(subg + d);
                u32x2 wv; wv.x = pk2(o[db][4 * i4] * rsn * g4[0], o[db][4 * i4 + 1] * rsn * g4[1]); wv.y = pk2(o[db][4 * i4 + 2] * rsn * g4[2], o[db][4 * i4 + 3] * rsn * g4[3]);
                *(u32x2*)(op + d) = wv; }
    }
    __syncthreads();
}

__global__ void __launch_bounds__(512, 2) mega_fwd(Args a) {
    extern __shared__ __attribute__((aligned(16))) unsigned char lds_raw[];
    cg::grid_group grid = cg::this_grid();
    LAS unsigned char* lds = (LAS unsigned char*)lds_raw;
    const int G = gridDim.x, bid = blockIdx.x;
    const int wave = __builtin_amdgcn_readfirstlane(threadIdx.x >> 6);
#define IS_T0(v) bool v; { int l_; asm volatile("v_mbcnt_lo_u32_b32 %0, -1, 0\n\tv_mbcnt_hi_u32_b32 %0, -1, %0" : "=v"(l_)); v = (wave == 0) && (l_ == 0); }
    { IS_T0(t0_); if (t0_) { ((LAS unsigned*)(lds + MISC_OFF))[8] = 0u; ((LAS unsigned*)(lds + MISC_OFF))[9] = 0u; } __syncthreads();
      (void)xcd_barrier_post((unsigned*)kin(32) + CW_BAR, (volatile LAS unsigned*)(lds + MISC_OFF) + 8, t0_); }
#define GRID_BAR() do { XcdBarrier b_; b_.bar = (unsigned*)kin(32) + CW_BAR; b_.x = xb_xcc_id(); b_.st = (volatile LAS unsigned*)(lds + MISC_OFF) + 8; IS_T0(t0_); xcd_barrier(b_, t0_); } while (0)
#define PH_BEGIN int tid, bidp = bid, Gp = G; { int l_; asm volatile("v_mbcnt_lo_u32_b32 %0, -1, 0\n\tv_mbcnt_hi_u32_b32 %0, -1, %0" : "=v"(l_)); asm volatile("" : "+s"(bidp), "+s"(Gp)); tid = wave * 64 + l_; }
#define WSB(off) ((unsigned char*)kin(32) + (off))
#define ssqA ((float*)WSB(WS_SSQA))
#define ssqB ((float*)WSB(WS_SSQB))
#define agg ((float*)WSB(WS_AGG))
#define sm ((bf16_t*)WSB(WS_SMALL))
#define xb ((bf16_t*)WSB(WS_XB))
#define merged ((bf16_t*)WSB(WS_XB))
#define proj ((bf16_t*)WSB(WS_PROJ))
#define xb2 ((bf16_t*)WSB(WS_PROJ))
#define vt ((bf16_t*)WSB(WS_VT))
#define gates ((bf16_t*)WSB(WS_GATES))
#define hid ((bf16_t*)WSB(WS_GATES))
#define out ((float*)kin(31))
#define ws WSB(0)

    { PH_BEGIN; convert_layer(0, ws + WS_W0, (LAS float*)lds, tid, bidp, Gp);
      convert_small(sm, tid, bidp, Gp);
      x_pass(kin(0), xb, ssqA, tid & 63, bidp * 8 + wave, Gp * 8); }
    grid.sync();

    for (int l = 0; l < NL; ++l) {
#define WL(off) (ws + WS_W0 + (size_t)(l & 1) * WS_WSZ + (off))
#ifndef NO_A
        {
            PH_BEGIN;
            pg8::Gemm g{xb, (const bf16_t*)WL(W_IN), MT, INC, DM, DM}; pg8::StaticOrder S; S.init(MT, INC, Gp, bidp);
            pg8::EpiInProj E{proj, vt, gates, ssqA, kin(3) + l * 3072, kin(15) + l * 64, kin(16) + l * 64};
            pg8::gemm_phase<pg8::EpiInProj, pg8::StaticOrder, true, true>(lds, g, S, E, tid);
#ifdef PROBE_A
            pg8::gemm_phase<pg8::EpiInProj, pg8::StaticOrder, true, true>(lds, g, S, E, tid);
#endif
        }
#endif
        GRID_BAR();
        {
            PH_BEGIN; const int lane = tid & 63, gw = bidp * 8 + wave, NGW = Gp * 8;
            const bf16_t* sml = sm + (size_t)l * SMALL_PER_LAYER;
#if defined(PROBE_B) && PROBE_B == 3
            { LruP LP{kin(4) + l * 1024, kin(5) + l * 256, kin(7) + l * 256, kin(9) + l * 256, kin(10) + l * 256, sml, sml + 16384};
              for (int u = bidp; u < 512; u += Gp) lru_unit<false>(lds, proj, proj, PJ, agg, LP, u >> 8, u & 255, tid); }
            if (l + 1 < NL) convert_layer(l + 1, ws + WS_W0 + (size_t)((l + 1) & 1) * WS_WSZ, (LAS float*)lds, tid, bidp, Gp);
#elif defined(PROBE_B)
#if PROBE_B == 1
            qk_norm(proj, xb, 1024, kin(15) + l * 64, kin(16) + l * 64, lane, gw, NGW);
#endif
            { LruP LP{kin(4) + l * 1024, kin(5) + l * 256, kin(7) + l * 256, kin(9) + l * 256, kin(10) + l * 256, sml, sml + 16384};
              for (int u = bidp; u < 512; u += Gp) lru_unit<false>(lds, proj, proj, PJ, agg, LP, u >> 8, u & 255, tid); }
            { SgP SP{kin(11) + l * 256, kin(12) + l * 256, kin(14) + l * 512, sml + 32768};
              for (int u = bidp; u < 256; u += Gp) sg_unit(lds, proj, xb, 1024, SP, u, tid); }
#if PROBE_B == 1
            if (l + 1 < NL) convert_layer(l + 1, ws + WS_W0 + (size_t)((l + 1) & 1) * WS_WSZ, (LAS float*)lds, tid, bidp, Gp);
#endif
#endif
            { LruP LP{kin(4) + l * 1024, kin(5) + l * 256, kin(7) + l * 256, kin(9) + l * 256, kin(10) + l * 256, sml, sml + 16384};
              for (int u = bidp; u < 512; u += Gp) lru_unit<false>(lds, proj, proj, PJ, agg, LP, u >> 8, u & 255, tid); }
            { SgP SP{kin(11) + l * 256, kin(12) + l * 256, kin(14) + l * 512, sml + 32768};
              for (int u = bidp; u < 256; u += Gp) sg_unit(lds, proj, proj + 512, PJ, SP, u, tid); }
            if (l + 1 < NL) convert_layer(l + 1, ws + WS_W0 + (size_t)((l + 1) & 1) * WS_WSZ, (LAS float*)lds, tid, bidp, Gp);
        }
        GRID_BAR();
        {
            PH_BEGIN; const int lane = tid & 63;
            float d1 = kin(17)[l * 64 + lane] * kin(18)[l * 64 + lane], d2 = kin(19)[l * 64 + lane] * kin(20)[l * 64 + lane];
            d1 = wave_sum(d1, lane); d2 = wave_sum(d2, lane);
            const float lam_init = 0.8f - 0.6f * __builtin_amdgcn_exp2f(-0.3f * LOG2E * (float)l);
            const float lam = __builtin_amdgcn_exp2f(d1 * LOG2E) - __builtin_amdgcn_exp2f(d2 * LOG2E) + lam_init;
            const float* relb = kin(22); const float* subg = kin(21) + l * 128;
#ifndef NO_ATT
#ifdef PROBE_ATT
            if (Gp == 256) {
                const int vcu = (bidp % 8) * 32 + bidp / 8, bh = vcu >> 5, s = vcu & 31;
#define ATT_OUT xb, 1024
                for (int i = 0; i < 4; ++i) { const int qb = (i == 0) ? 127 - s : (i == 1) ? 95 - s : (i == 2) ? 32 + s : s; attn_unit<PROBE_ATT>(lds, proj, vt, ATT_OUT, bh >> 2, bh & 3, qb, lam, 1.f - lam_init, relb, subg, tid); }
#undef ATT_OUT
            }
#endif
#define ATT_OUT proj + 1024, PJ
            if (Gp == 256) {
                const int vcu = (bidp % 8) * 32 + bidp / 8, bh = vcu >> 5, s = vcu & 31;
                for (int i = 0; i < 4; ++i) { const int qb = (i == 0) ? 127 - s : (i == 1) ? 95 - s : (i == 2) ? 32 + s : s; attn_unit<0>(lds, proj, vt, ATT_OUT, bh >> 2, bh & 3, qb, lam, 1.f - lam_init, relb, subg, tid); }
            } else {
                for (int u = bidp; u < 1024; u += Gp) attn_unit<0>(lds, proj, vt, ATT_OUT, u >> 9, (u >> 7) & 3, u & 127, lam, 1.f - lam_init, relb, subg, tid);
            }
#endif
            { const bf16_t* sml = sm + (size_t)l * SMALL_PER_LAYER;
              LruP LP{kin(4) + l * 1024, kin(5) + l * 256, kin(7) + l * 256, kin(9) + l * 256, kin(10) + l * 256, sml, sml + 16384};
#if defined(PROBE_B) && PROBE_B != 3
              for (int u = bidp; u < 512; u += Gp) lru_unit<true>(lds, proj, xb, 1024, agg, LP, u >> 8, u & 255, tid);
#endif
              for (int u = bidp; u < 512; u += Gp) lru_unit<true>(lds, proj, proj + 256, PJ, agg, LP, u >> 8, u & 255, tid); }
        }
        GRID_BAR();
#ifndef NO_C1
        { PH_BEGIN; pg8::StaticOrder S; S.init(MT, DM, Gp, bidp); pg8::Gemm g{proj + 256, (const bf16_t*)WL(W_PA), MT, DM, 256, PJ}; pg8::EpiMerge<0> E{gates, merged}; pg8::gemm_phase<pg8::EpiMerge<0>, pg8::StaticOrder, true, true>(lds, g, S, E, tid); }
        { PH_BEGIN; pg8::StaticOrder S; S.init(MT, DM, Gp, bidp); pg8::Gemm g{proj + 512, (const bf16_t*)WL(W_PB), MT, DM, 256, PJ}; pg8::EpiMerge<1> E{gates, merged}; pg8::gemm_phase<pg8::EpiMerge<1>, pg8::StaticOrder, true, true>(lds, g, S, E, tid); }
        { PH_BEGIN; pg8::StaticOrder S; S.init(MT, DM, Gp, bidp); pg8::Gemm g{proj + 1024, (const bf16_t*)WL(W_PC), MT, DM, 512, PJ}; pg8::EpiMerge<2> E{gates, merged}; pg8::gemm_phase<pg8::EpiMerge<2>, pg8::StaticOrder, true, true>(lds, g, S, E, tid); }
#ifdef PROBE_C1
        { PH_BEGIN; pg8::StaticOrder S; S.init(MT, DM, Gp, bidp); pg8::Gemm g{proj + 256, (const bf16_t*)WL(W_PA), MT, DM, 256, PJ}; pg8::EpiMerge<0> E{gates, merged}; pg8::gemm_phase<pg8::EpiMerge<0>, pg8::StaticOrder, true, true>(lds, g, S, E, tid); }
        { PH_BEGIN; pg8::StaticOrder S; S.init(MT, DM, Gp, bidp); pg8::Gemm g{proj + 512, (const bf16_t*)WL(W_PB), MT, DM, 256, PJ}; pg8::EpiMerge<1> E{gates, merged}; pg8::gemm_phase<pg8::EpiMerge<1>, pg8::StaticOrder, true, true>(lds, g, S, E, tid); }
        { PH_BEGIN; pg8::StaticOrder S; S.init(MT, DM, Gp, bidp); pg8::Gemm g{proj + 1024, (const bf16_t*)WL(W_PC), MT, DM, 512, PJ}; pg8::EpiMerge<2> E{gates, merged}; pg8::gemm_phase<pg8::EpiMerge<2>, pg8::StaticOrder, true, true>(lds, g, S, E, tid); }
#endif
#endif
        GRID_BAR();
#ifndef NO_C2
        {
            PH_BEGIN;
            pg8::Gemm g{merged, (const bf16_t*)WL(W_O), MT, DM, DM, DM}; pg8::StaticOrder S; S.init(MT, DM, Gp, bidp);
#ifdef PROBE_C24
            { pg8::EpiResid E0{(l == 0) ? kin(0) : out, (float*)gates, xb2, ssqB}; pg8::gemm_phase<pg8::EpiResid, pg8::StaticOrder, true, true>(lds, g, S, E0, tid); }
#endif
            pg8::EpiResid E{(l == 0) ? kin(0) : out, out, xb2, ssqB};
            pg8::gemm_phase<pg8::EpiResid, pg8::StaticOrder, true, true>(lds, g, S, E, tid);
        }
#endif
        GRID_BAR();
#ifndef NO_C3
        {
            PH_BEGIN;
            pg8::Gemm g{xb2, (const bf16_t*)WL(W_FF), MT, 2 * FF, DM, DM}; pg8::StaticOrder S; S.init(MT, 2 * FF, Gp, bidp);
            pg8::EpiFfn1 E{hid, ssqB};
            pg8::gemm_phase<pg8::EpiFfn1, pg8::StaticOrder, true, true>(lds, g, S, E, tid);
#ifdef PROBE_C3
            pg8::gemm_phase<pg8::EpiFfn1, pg8::StaticOrder, true, true>(lds, g, S, E, tid);
#endif
        }
#endif
        GRID_BAR();
#ifndef NO_C4
        {
            PH_BEGIN;
            pg8::Gemm g{hid, (const bf16_t*)WL(W_DN), MT, DM, FF, FF}; pg8::StaticOrder S; S.init(MT, DM, Gp, bidp);
#ifdef PROBE_C24
            { pg8::EpiResid E0{out, (float*)proj, xb, ssqA}; pg8::gemm_phase<pg8::EpiResid, pg8::StaticOrder, true, true>(lds, g, S, E0, tid); }
#endif
            pg8::EpiResid E{out, out, xb, ssqA};
            pg8::gemm_phase<pg8::EpiResid, pg8::StaticOrder, true, true>(lds, g, S, E, tid);
        }
#endif
        if (l + 1 < NL) GRID_BAR();
    }
}
#undef WL
#undef GRID_BAR
#undef IS_T0
#undef PH_BEGIN
#undef ws
#undef out
#undef hid
#undef gates
#undef vt
#undef xb2
#undef proj
#undef merged
#undef xb
#undef sm
#undef agg
#undef ssqB
#undef ssqA
extern "C" void kernel_launch(void* const* d_in, const int* in_sizes, int n_in, void* d_out, int out_size, void* d_ws, size_t ws_size, hipStream_t stream) {
    static int grid = 0;
    if (grid == 0) {
        if (n_in != 31 || out_size != MT * DM || ws_size < WS_END) { fprintf(stderr, "kernel_launch: unexpected shapes (n_in %d out %d ws %zu)\n", n_in, out_size, ws_size); grid = -1; return; }
        int dev = 0, cus = 0, per_cu = 0;
        hipGetDevice(&dev); hipDeviceGetAttribute(&cus, hipDeviceAttributeMultiprocessorCount, dev);
        if (hipFuncSetAttribute((const void*)mega_fwd, hipFuncAttributeMaxDynamicSharedMemorySize, LDS_BYTES) != hipSuccess) { fprintf(stderr, "kernel_launch: hipFuncSetAttribute failed\n"); grid = -1; return; }
        if (hipOccupancyMaxActiveBlocksPerMultiprocessor(&per_cu, (const void*)mega_fwd, 512, LDS_BYTES) != hipSuccess || per_cu < 1) { fprintf(stderr, "kernel_launch: occupancy query says %d\n", per_cu); per_cu = 1; }
        (void)hipGetLastError();
        grid = cus;
    }
    if (grid < 0) return;
    if (hipMemsetAsync(d_ws, 0, CTL_ZERO_BYTES, stream) != hipSuccess) { fprintf(stderr, "kernel_launch: memset failed\n"); return; }
    Args a{};
    for (int i = 0; i < 31; ++i) a.in[i] = (const float*)d_in[i];
    a.out = (float*)d_out; a.ws = (unsigned char*)d_ws;
    void* args[] = {&a};
    hipError_t e = hipLaunchCooperativeKernel((const void*)mega_fwd, dim3(grid), dim3(512), args, LDS_BYTES, stream);
    if (e != hipSuccess) fprintf(stderr, "cooperative launch failed: %s (grid %d)\n", hipGetErrorString(e), grid);
}
```

```cpp
#include <hip/hip_runtime.h>
#include <hip/hip_cooperative_groups.h>
#include <hip/hip_bf16.h>
#include <cstdio>
#include <cstdint>
#include <cmath>
namespace cg = cooperative_groups;
namespace pg8 {
#define PG8_LAS __attribute__((address_space(3)))
typedef unsigned short bf16_t;
typedef short bf16x8 __attribute__((ext_vector_type(8)));
typedef float f32x4 __attribute__((ext_vector_type(4)));
typedef unsigned u32x4 __attribute__((ext_vector_type(4)));
constexpr int BM = 256, BK = 64, HALF = 128, HTB = HALF * BK * 2  , STAGE_BYTES = 8 * HTB, NXCD = 8, WGM = 8;

__host__ __device__ __forceinline__ int lds_byte(int r, int c) { const int st = (r >> 4) * 2 + (c >> 5), rr = r & 15, cc = c & 31, ob = rr * 64 + cc * 2; return st * 1024 + (ob ^ (((ob >> 9) & 1) << 5)); }
__host__ __device__ __forceinline__ void stage_rc(int b, int& R, int& C) { const int st = b / 1024, sb = b % 1024, swz = sb ^ (((sb >> 9) & 1) << 5); R = (st >> 1) * 16 + swz / 64; C = (st & 1) * 32 + (swz % 64) / 2; }
__host__ __device__ __forceinline__ int perm32(int rho) { const int n = rho >> 4, i = rho & 15; return 8 * (i >> 2) + 4 * n + (i & 3); }

struct Unit { int pm, pn; };
struct Gemm { const bf16_t* A; const bf16_t* Bt; int M, N, K, lda; };

struct StaticOrder {
    int nM, nN, nwg, G, c;
    __host__ __device__ void init(int M, int N, int G_, int c_) { nM = M / BM; nN = N / BM; nwg = nM * nN; G = G_; c = c_; }
    __host__ __device__ bool next(int i, Unit& u) const {
        const long L = (long)i * G + c; if (L >= nwg) return false;
        int wgid = (int)L; { const int q = nwg / NXCD, r = nwg % NXCD, xcd = wgid % NXCD, off = wgid / NXCD; wgid = (xcd < r ? xcd * (q + 1) : r * (q + 1) + (xcd - r) * q) + off; }
        const int nig = WGM * nN, gid = wgid / nig, fm = gid * WGM, gsz = (nM - fm) < WGM ? (nM - fm) : WGM;
        u.pm = fm + ((wgid % nig) % gsz); u.pn = (wgid % nig) / gsz; return true;
    }
    __device__ __forceinline__ void a_ready(const Unit&) const {}
    __device__ __forceinline__ void done(const Unit&) const {}
};

template <class Epi, class Sched, bool ALIGN_EPI = false, bool SP2 = false>
__device__ __forceinline__ void gemm_phase(PG8_LAS unsigned char* lds, const Gemm g, const Sched& S, const Epi& E, const int tid) {
    const int wid = __builtin_amdgcn_readfirstlane(tid >> 6), lane = tid & 63, wr = wid >> 2, wc = wid & 3, fr = lane & 15, fq = lane >> 4;
    const int K = g.K, nt = K / BK;
    unsigned voffA[2], voffB[2];
#pragma unroll
    for (int i = 0; i < 2; ++i) { int R, C; stage_rc(tid * 16 + i * 8192, R, C); const int Rb = Epi::PERM ? ((R & ~31) + perm32(R & 31)) : R;
        voffA[i] = (unsigned)(R * g.lda + C) * 2u; voffB[i] = (unsigned)(Rb * K + C) * 2u; }
    const size_t kstep = (size_t)(BK * 2);
    const size_t hstepA = (size_t)HALF * g.lda * 2, hstepB = (size_t)HALF * K * 2;
    const size_t tstepA = 2 * hstepA, tstepB = 2 * hstepB;
    const unsigned ldsw = (unsigned)wid * 1024u;
    const int aoff = lds_byte(wr * 64 + fr, fq * 8), boff = lds_byte(wc * 32 + fr, fq * 8);
#define PG8_SA(b, h) (((b) * 2 + (h)) * HTB)
#define PG8_SB(b, h) ((4 + (b) * 2 + (h)) * HTB)
#define PG8_STAGE(bufoff, gbase, voff) do { _Pragma("unroll") for (int _i = 0; _i < 2; ++_i) \
        __builtin_amdgcn_global_load_lds((const unsigned*)((const char*)(gbase) + (voff)[_i]), (PG8_LAS unsigned*)(lds + (bufoff) + ldsw + _i * 8192), 16, 0, 0); } while (0)
#define PG8_LDA(dst, b, h) do { _Pragma("unroll") for (int m = 0; m < 4; ++m) _Pragma("unroll") for (int k = 0; k < 2; ++k) dst[m][k] = *(const PG8_LAS bf16x8*)(lds + PG8_SA(b, h) + aoff + m * 2048 + k * 1024); } while (0)
#define PG8_LDB(dst, b, h) do { _Pragma("unroll") for (int n = 0; n < 2; ++n) _Pragma("unroll") for (int k = 0; k < 2; ++k) dst[n][k] = *(const PG8_LAS bf16x8*)(lds + PG8_SB(b, h) + boff + n * 2048 + k * 1024); } while (0)
#define PG8_MMA(ai, bj, At, Bt) do { __builtin_amdgcn_s_setprio(1); _Pragma("unroll") for (int m = 0; m < 4; ++m) _Pragma("unroll") for (int n = 0; n < 2; ++n) _Pragma("unroll") for (int k = 0; k < 2; ++k) \
        acc[ai][bj][m][n] = __builtin_amdgcn_mfma_f32_16x16x32_bf16(Bt[n][k], At[m][k], acc[ai][bj][m][n], 0, 0, 0); __builtin_amdgcn_s_setprio(0); } while (0)
#define PG8_WAIT_V(n) asm volatile("s_waitcnt vmcnt(" #n ")" ::: "memory")
#define PG8_WAIT_L(n) asm volatile("s_waitcnt lgkmcnt(" #n ")" ::: "memory")
#define PG8_BAR __builtin_amdgcn_s_barrier()
#define PG8_SCHED __builtin_amdgcn_sched_barrier(0)
    Unit cur, nxt; int ui = 0;
    if (!S.next(0, cur)) return;
    f32x4 acc[2][2][4][2];
#pragma unroll
    for (int a = 0; a < 2; ++a)
#pragma unroll
        for (int b = 0; b < 2; ++b)
#pragma unroll
            for (int m = 0; m < 4; ++m)
#pragma unroll
                for (int n = 0; n < 2; ++n) acc[a][b][m][n] = (f32x4){0.f, 0.f, 0.f, 0.f};
    bf16x8 At[4][2], B0[2][2], B1[2][2];
    const char* cA = (const char*)g.A + (size_t)cur.pm * tstepA; const char* cB = (const char*)g.Bt + (size_t)cur.pn * tstepB;
    S.a_ready(cur);
    if constexpr (SP2) {
        PG8_STAGE(PG8_SB(0, 0), cB, voffB); PG8_STAGE(PG8_SB(0, 1), cB + hstepB, voffB); PG8_STAGE(PG8_SA(0, 0), cA, voffA); PG8_STAGE(PG8_SA(0, 1), cA + hstepA, voffA);
        if (wr == 1) PG8_BAR;
        PG8_WAIT_V(2); PG8_BAR;
        PG8_STAGE(PG8_SB(1, 0), cB + kstep, voffB); PG8_STAGE(PG8_SA(1, 0), cA + kstep, voffA); PG8_STAGE(PG8_SB(1, 1), cB + hstepB + kstep, voffB);
        PG8_WAIT_V(6); PG8_BAR;
    } else {
        PG8_STAGE(PG8_SB(0, 0), cB, voffB); PG8_STAGE(PG8_SA(0, 0), cA, voffA); PG8_STAGE(PG8_SB(0, 1), cB + hstepB, voffB); PG8_STAGE(PG8_SA(0, 1), cA + hstepA, voffA);
        if (wr == 1) PG8_BAR;
        PG8_WAIT_V(4); PG8_BAR;
        PG8_STAGE(PG8_SB(1, 0), cB + kstep, voffB); PG8_STAGE(PG8_SA(1, 0), cA + kstep, voffA); PG8_STAGE(PG8_SB(1, 1), cB + hstepB + kstep, voffB);
        PG8_WAIT_V(6); PG8_BAR;
    }
    for (;;) {
        const bool has_next = S.next(ui + 1, nxt);
        const char* nA = has_next ? (const char*)g.A + (size_t)nxt.pm * tstepA : cA; const char* nB = has_next ? (const char*)g.Bt + (size_t)nxt.pn * tstepB : cB;
        for (int t = 0; t < nt; t += 2) {
            const bool last = (t == nt - 2);
            const char* a1 = cA + (size_t)(t + 1) * kstep;
            const char* a2 = last ? nA : cA + (size_t)(t + 2) * kstep; const char* b2 = last ? nB : cB + (size_t)(t + 2) * kstep;
            const char* a3 = a2 + kstep; const char* b3 = b2 + kstep;
            if (last && has_next) S.a_ready(nxt);
            if constexpr (SP2) {
            PG8_LDB(B0, 0, 0); PG8_LDB(B1, 0, 1); PG8_SCHED; PG8_LDA(At, 0, 0); PG8_STAGE(PG8_SA(1, 1), a1 + hstepA, voffA);
            PG8_WAIT_V(8); PG8_WAIT_L(0); PG8_BAR; PG8_MMA(0, 0, At, B0); PG8_MMA(0, 1, At, B1); PG8_BAR; PG8_SCHED;
            PG8_LDA(At, 0, 1); PG8_STAGE(PG8_SB(0, 0), b2, voffB); PG8_STAGE(PG8_SB(0, 1), b2 + hstepB, voffB); PG8_STAGE(PG8_SA(0, 0), a2, voffA);
            PG8_WAIT_V(8); PG8_WAIT_L(0); PG8_BAR; PG8_MMA(1, 0, At, B0); PG8_MMA(1, 1, At, B1); PG8_BAR; PG8_SCHED;
            PG8_LDB(B0, 1, 0); PG8_LDB(B1, 1, 1); PG8_SCHED; PG8_LDA(At, 1, 0); PG8_STAGE(PG8_SA(0, 1), a2 + hstepA, voffA);
            PG8_WAIT_V(8); PG8_WAIT_L(0); PG8_BAR; PG8_MMA(0, 0, At, B0); PG8_MMA(0, 1, At, B1); PG8_BAR; PG8_SCHED;
            PG8_LDA(At, 1, 1); PG8_STAGE(PG8_SB(1, 0), b3, voffB); PG8_STAGE(PG8_SB(1, 1), b3 + hstepB, voffB); PG8_STAGE(PG8_SA(1, 0), a3, voffA);
            PG8_WAIT_V(8); PG8_WAIT_L(0); PG8_BAR; PG8_MMA(1, 0, At, B0); PG8_MMA(1, 1, At, B1); PG8_BAR; PG8_SCHED;
            } else {
            PG8_LDB(B0, 0, 0); PG8_SCHED; PG8_LDA(At, 0, 0); PG8_STAGE(PG8_SA(1, 1), a1 + hstepA, voffA);
            PG8_WAIT_L(8); PG8_BAR; PG8_WAIT_L(0); PG8_MMA(0, 0, At, B0); PG8_BAR; PG8_SCHED;
            PG8_LDB(B1, 0, 1); PG8_STAGE(PG8_SB(0, 0), b2, voffB);
            PG8_BAR; PG8_WAIT_L(0); PG8_MMA(0, 1, At, B1); PG8_BAR;
            PG8_LDA(At, 0, 1); PG8_STAGE(PG8_SA(0, 0), a2, voffA);
            PG8_BAR; PG8_WAIT_L(0); PG8_MMA(1, 0, At, B0); PG8_BAR; PG8_SCHED;
            PG8_STAGE(PG8_SB(0, 1), b2 + hstepB, voffB);
            PG8_WAIT_V(6); PG8_BAR; PG8_MMA(1, 1, At, B1); PG8_BAR;
            PG8_LDB(B0, 1, 0); PG8_SCHED; PG8_LDA(At, 1, 0); PG8_STAGE(PG8_SA(0, 1), a2 + hstepA, voffA);
            PG8_WAIT_L(8); PG8_BAR; PG8_WAIT_L(0); PG8_MMA(0, 0, At, B0); PG8_BAR; PG8_SCHED;
            PG8_LDB(B1, 1, 1); PG8_STAGE(PG8_SB(1, 0), b3, voffB);
            PG8_BAR; PG8_WAIT_L(0); PG8_MMA(0, 1, At, B1); PG8_BAR;
            PG8_LDA(At, 1, 1); PG8_STAGE(PG8_SA(1, 0), a3, voffA);
            PG8_BAR; PG8_WAIT_L(0); PG8_MMA(1, 0, At, B0); PG8_BAR; PG8_SCHED;
            PG8_STAGE(PG8_SB(1, 1), b3 + hstepB, voffB);
            PG8_WAIT_V(6); PG8_BAR; PG8_MMA(1, 1, At, B1); PG8_BAR;
            }
        }
        if constexpr (ALIGN_EPI) { if (wr == 0) PG8_BAR; }
        if constexpr (!Epi::AFTER_DRAIN) { int l2_; asm volatile("v_mbcnt_lo_u32_b32 %0, -1, 0\n\tv_mbcnt_hi_u32_b32 %0, -1, %0" : "=v"(l2_)); E(acc, cur, wr, wc, l2_ & 15, l2_ >> 4); S.done(cur); }
        if (!has_next) break;
#pragma unroll
        for (int a = 0; a < 2; ++a)
#pragma unroll
            for (int b = 0; b < 2; ++b)
#pragma unroll
                for (int m = 0; m < 4; ++m)
#pragma unroll
                    for (int n = 0; n < 2; ++n) acc[a][b][m][n] = (f32x4){0.f, 0.f, 0.f, 0.f};
        cur = nxt; cA = nA; cB = nB; ++ui;
        if constexpr (ALIGN_EPI) { if (wr == 1) PG8_BAR; }
    }
    PG8_WAIT_V(0);
    if constexpr (!ALIGN_EPI) { if (wr == 0) PG8_BAR; }
    PG8_BAR;
    if constexpr (Epi::AFTER_DRAIN) { E.fused(acc, cur, wr, wc, fr, fq, lds, wid, lane); S.done(cur); }
#undef PG8_SA
#undef PG8_SB
#undef PG8_STAGE
#undef PG8_LDA
#undef PG8_LDB
#undef PG8_MMA
#undef PG8_WAIT_V
#undef PG8_WAIT_L
#undef PG8_BAR
#undef PG8_SCHED
}
}

#define LAS __attribute__((address_space(3)))
typedef unsigned short bf16_t;
typedef short bf16x8 __attribute__((ext_vector_type(8)));
typedef float f32x4 __attribute__((ext_vector_type(4)));
typedef float f32x2 __attribute__((ext_vector_type(2)));
typedef float f32x16 __attribute__((ext_vector_type(16)));
typedef unsigned u32x4 __attribute__((ext_vector_type(4)));
typedef unsigned u32x2 __attribute__((ext_vector_type(2)));
typedef __bf16 bf16x2_t __attribute__((ext_vector_type(2)));

constexpr int NB = 2, SEQ = 16384, DM = 1024, NL = 4, MT = NB * SEQ;
constexpr int INC = 5632, PJ = 2048, GP = 3072, FF = 2816;
constexpr float EPS = 1e-6f, LOG2E = 1.4426950408889634f;
constexpr size_t MiB = 1u << 20;
constexpr size_t WS_SSQA = 1 * MiB, WS_SSQB = 3 * MiB, WS_AGG = 5 * MiB, WS_SMALL = 6 * MiB;
constexpr size_t WS_W0 = 8 * MiB, WS_WSZ = 32 * MiB;
constexpr size_t WS_XB = 72 * MiB, WS_PROJ = 136 * MiB, WS_VT = 264 * MiB, WS_GATES = 296 * MiB, WS_END = 488 * MiB;
constexpr size_t W_IN = 0, W_PA = 11 * MiB, W_PB = W_PA + MiB / 2, W_PC = 12 * MiB, W_O = 13 * MiB, W_FF = 15 * MiB, W_DN = 26 * MiB;
constexpr int SMALL_PER_LAYER = 16384 + 16384 + 65536;
constexpr int LDS_BYTES = 147456, MISC_OFF = 131072 + 320;
constexpr int CW_BAR = 4096; constexpr size_t CTL_ZERO_BYTES = 65536;

__device__ __forceinline__ unsigned pk2(float lo, float hi) { f32x2 v = {lo, hi}; bf16x2_t b = __builtin_convertvector(v, bf16x2_t); return __builtin_bit_cast(unsigned, b); }
__device__ __forceinline__ bf16_t f2bf(float f) { unsigned u = __builtin_bit_cast(unsigned, f); return (bf16_t)((u + 0x7fffu + ((u >> 16) & 1u)) >> 16); }
__device__ __forceinline__ float bf2f(bf16_t b) { return __builtin_bit_cast(float, (unsigned)b << 16); }
__device__ __forceinline__ float bflo(unsigned w) { return __builtin_bit_cast(float, w << 16); }
__device__ __forceinline__ float bfhi(unsigned w) { return __builtin_bit_cast(float, w & 0xffff0000u); }
__device__ __forceinline__ float fsigmoid(float x) { return __builtin_amdgcn_rcpf(1.f + __builtin_amdgcn_exp2f(-x * LOG2E)); }
__device__ __forceinline__ float shx(float v, int mask, int lane) { return __builtin_bit_cast(float, __builtin_amdgcn_ds_bpermute((lane ^ mask) << 2, __builtin_bit_cast(int, v))); }
__device__ __forceinline__ float wave_sum(float v, int lane) {
#pragma unroll
    for (int o = 1; o < 64; o <<= 1) v += shx(v, o, lane);
    return v;
}
__device__ __forceinline__ int crow(int r, int hi) { return (r & 3) + 8 * (r >> 2) + 4 * hi; }
#define MFMA32(a, b, c) __builtin_amdgcn_mfma_f32_32x32x16_bf16((a), (b), (c), 0, 0, 0)
__device__ __forceinline__ bf16x8 pack8(float a0, float a1, float a2, float a3, float a4, float a5, float a6, float a7) {
    u32x4 p; p.x = pk2(a0, a1); p.y = pk2(a2, a3); p.z = pk2(a4, a5); p.w = pk2(a6, a7); return __builtin_bit_cast(bf16x8, p);
}

namespace pg8 {
__device__ __forceinline__ float row_rstd(const float* ssq, int r) {
    const f32x4* p = (const f32x4*)(ssq + (size_t)r * 16);
    const f32x4 a = p[0], b = p[1], c = p[2], d = p[3];
    const float s = ((a[0] + a[1]) + (a[2] + a[3])) + ((b[0] + b[1]) + (b[2] + b[3])) + ((c[0] + c[1]) + (c[2] + c[3])) + ((d[0] + d[1]) + (d[2] + d[3]));
    return __builtin_amdgcn_rsqf(s * (1.f / 1024.f) + EPS);
}
__device__ __forceinline__ u32x4 pack_f8(const f32x4 v0, const f32x4 v1) { u32x4 w; w.x = pk2(v0[0], v0[1]); w.y = pk2(v0[2], v0[3]); w.z = pk2(v1[0], v1[1]); w.w = pk2(v1[2], v1[3]); return w; }

struct EpiInProj {
    static constexpr bool PERM = true, AFTER_DRAIN = false;
    bf16_t* proj; bf16_t* vt; bf16_t* gates; const float* ssq; const float* bgate; const float* qg; const float* kg;
    __device__ __forceinline__ void operator()(const f32x4 (&acc)[2][2][4][2], const Unit& u, int wr, int wc, int fr, int fq) const {
        const int row0 = u.pm * BM + wr * 64 + fr, cin = wc * 32 + 8 * fq;
        if (u.pn >= 4 && u.pn < 8) {
            const int G = 4 * (u.pn - 4) + wc, ln_ = fr | (fq << 4); const bool isq = u.pn < 6;
            const float* gp = (isq ? qg : kg) + 8 * fq; const float gs = isq ? (0.125f * LOG2E) : 1.f;
            const f32x4 g00 = *(const f32x4*)gp * gs, g01 = *(const f32x4*)(gp + 4) * gs, g10 = *(const f32x4*)(gp + 32) * gs, g11 = *(const f32x4*)(gp + 36) * gs;
#pragma unroll
            for (int ai = 0; ai < 2; ++ai)
#pragma unroll
                for (int m = 0; m < 4; ++m) { const int r = row0 + ai * HALF + m * 16; const float rs = row_rstd(ssq, r); bf16_t* rowp = proj + (size_t)r * PJ + 1024 + 64 * G + 8 * fq;
                    f32x4 a0 = acc[ai][0][m][0] * rs, a1 = acc[ai][0][m][1] * rs, b0 = acc[ai][1][m][0] * rs, b1 = acc[ai][1][m][1] * rs;
                    float ss = (a0[0] * a0[0] + a0[1] * a0[1]) + (a0[2] * a0[2] + a0[3] * a0[3]) + (a1[0] * a1[0] + a1[1] * a1[1]) + (a1[2] * a1[2] + a1[3] * a1[3])
                             + (b0[0] * b0[0] + b0[1] * b0[1]) + (b0[2] * b0[2] + b0[3] * b0[3]) + (b1[0] * b1[0] + b1[1] * b1[1]) + (b1[2] * b1[2] + b1[3] * b1[3]);
                    ss += shx(ss, 16, ln_); ss += shx(ss, 32, ln_);
                    const float rq = __builtin_amdgcn_rsqf(ss * (1.f / 64.f) + EPS);
                    *(u32x4*)rowp = pack_f8(a0 * (g00 * rq), a1 * (g01 * rq)); *(u32x4*)(rowp + 32) = pack_f8(b0 * (g10 * rq), b1 * (g11 * rq)); }
        } else if (u.pn < 8) {
#pragma unroll
            for (int ai = 0; ai < 2; ++ai)
#pragma unroll
                for (int m = 0; m < 4; ++m) { const int r = row0 + ai * HALF + m * 16; const float rs = row_rstd(ssq, r); bf16_t* rowp = proj + (size_t)r * PJ + u.pn * BM + cin;
#pragma unroll
                    for (int bj = 0; bj < 2; ++bj) *(u32x4*)(rowp + bj * HALF) = pack_f8(acc[ai][bj][m][0] * rs, acc[ai][bj][m][1] * rs); }
        } else if (u.pn < 10) {
#pragma unroll
            for (int ai = 0; ai < 2; ++ai)
#pragma unroll
                for (int m = 0; m < 4; ++m) { const int r = row0 + ai * HALF + m * 16; const float rs = row_rstd(ssq, r);
                    const int b = r >> 14, s = r & (SEQ - 1), ko = s & 15, gq = ko >> 2, sg = (gq == 1) ? 2 : ((gq == 2) ? 1 : gq), slot = (s & ~15) | (sg * 4 + (ko & 3));
#pragma unroll
                    for (int bj = 0; bj < 2; ++bj) { const int head = (u.pn - 8) * 2 + bj; bf16_t* base = vt + ((size_t)((b * 4 + head) * 128 + cin)) * SEQ + slot;
                        const f32x4 v0 = acc[ai][bj][m][0] * rs, v1 = acc[ai][bj][m][1] * rs;
                        base[0] = f2bf(v0[0]); base[(size_t)SEQ] = f2bf(v0[1]); base[(size_t)2 * SEQ] = f2bf(v0[2]); base[(size_t)3 * SEQ] = f2bf(v0[3]);
                        base[(size_t)4 * SEQ] = f2bf(v1[0]); base[(size_t)5 * SEQ] = f2bf(v1[1]); base[(size_t)6 * SEQ] = f2bf(v1[2]); base[(size_t)7 * SEQ] = f2bf(v1[3]); } }
        } else {
            const int colg = (u.pn - 10) * BM + cin;
            f32x4 bv[2][2];
#pragma unroll
            for (int bj = 0; bj < 2; ++bj) { bv[bj][0] = *(const f32x4*)(bgate + colg + bj * HALF); bv[bj][1] = *(const f32x4*)(bgate + colg + bj * HALF + 4); }
#pragma unroll
            for (int ai = 0; ai < 2; ++ai)
#pragma unroll
                for (int m = 0; m < 4; ++m) { const int r = row0 + ai * HALF + m * 16; const float rs = row_rstd(ssq, r); bf16_t* rowp = gates + (size_t)r * GP + colg;
#pragma unroll
                    for (int bj = 0; bj < 2; ++bj) { f32x4 v0 = acc[ai][bj][m][0] * rs + bv[bj][0], v1 = acc[ai][bj][m][1] * rs + bv[bj][1];
#pragma unroll
                        for (int e = 0; e < 4; ++e) { v0[e] = fsigmoid(v0[e]); v1[e] = fsigmoid(v1[e]); }
                        *(u32x4*)(rowp + bj * HALF) = pack_f8(v0, v1); } }
        }
    }
};
template <int BR> struct EpiMerge {
    static constexpr bool PERM = true, AFTER_DRAIN = false;
    const bf16_t* gates; bf16_t* merged;
    __device__ __forceinline__ void operator()(const f32x4 (&acc)[2][2][4][2], const Unit& u, int wr, int wc, int fr, int fq) const {
        const int row0 = u.pm * BM + wr * 64 + fr, cin = wc * 32 + 8 * fq;
#pragma unroll
        for (int ai = 0; ai < 2; ++ai)
#pragma unroll
            for (int m = 0; m < 4; ++m) { const int r = row0 + ai * HALF + m * 16;
#pragma unroll
                for (int bj = 0; bj < 2; ++bj) { const int col = u.pn * BM + bj * HALF + cin;
                    const u32x4 g = *(const u32x4*)(gates + (size_t)r * GP + BR * 1024 + col);
                    bf16_t* mp = merged + (size_t)r * DM + col;
                    f32x4 o0 = {0.f, 0.f, 0.f, 0.f}, o1 = {0.f, 0.f, 0.f, 0.f};
                    if (BR > 0) { const u32x4 p = *(const u32x4*)mp; o0 = (f32x4){bflo(p.x), bfhi(p.x), bflo(p.y), bfhi(p.y)}; o1 = (f32x4){bflo(p.z), bfhi(p.z), bflo(p.w), bfhi(p.w)}; }
                    const f32x4 g0 = {bflo(g.x), bfhi(g.x), bflo(g.y), bfhi(g.y)}, g1 = {bflo(g.z), bfhi(g.z), bflo(g.w), bfhi(g.w)};
                    o0 += g0 * acc[ai][bj][m][0]; o1 += g1 * acc[ai][bj][m][1];
                    *(u32x4*)mp = pack_f8(o0, o1); }
                asm volatile("" ::: "memory"); }
    }
};
struct EpiResid {
    static constexpr bool PERM = true, AFTER_DRAIN = false;
    const float* xin; float* xout; bf16_t* xb; float* ssq;
    __device__ __forceinline__ void operator()(const f32x4 (&acc)[2][2][4][2], const Unit& u, int wr, int wc, int fr, int fq) const {
        const int row0 = u.pm * BM + wr * 64 + fr, cin = wc * 32 + 8 * fq;
#pragma unroll
        for (int ai = 0; ai < 2; ++ai)
#pragma unroll
            for (int m = 0; m < 4; ++m) { const int r = row0 + ai * HALF + m * 16; float ss = 0.f;
#pragma unroll
                for (int bj = 0; bj < 2; ++bj) { const size_t off = (size_t)r * DM + u.pn * BM + bj * HALF + cin;
                    f32x4 x0 = *(const f32x4*)(xin + off), x1 = *(const f32x4*)(xin + off + 4);
                    x0 += acc[ai][bj][m][0]; x1 += acc[ai][bj][m][1];
                    *(f32x4*)(xout + off) = x0; *(f32x4*)(xout + off + 4) = x1;
                    *(u32x4*)(xb + off) = pack_f8(x0, x1);
                    ss += (x0[0] * x0[0] + x0[1] * x0[1]) + (x0[2] * x0[2] + x0[3] * x0[3]) + (x1[0] * x1[0] + x1[1] * x1[1]) + (x1[2] * x1[2] + x1[3] * x1[3]); }
                { const int ln_ = fr | (fq << 4); ss += shx(ss, 16, ln_); ss += shx(ss, 32, ln_); }
                if (fq == 0) ssq[(size_t)r * 16 + u.pn * 4 + wc] = ss;
                asm volatile("" ::: "memory"); }
    }
};
struct EpiFfn1 {
    static constexpr bool PERM = true, AFTER_DRAIN = false;
    bf16_t* hid; const float* ssq;
    __device__ __forceinline__ void operator()(const f32x4 (&acc)[2][2][4][2], const Unit& u, int wr, int wc, int fr, int fq) const {
        const int row0 = u.pm * BM + wr * 64 + fr, cin = wc * 32 + 8 * fq;
#pragma unroll
        for (int ai = 0; ai < 2; ++ai)
#pragma unroll
            for (int m = 0; m < 4; ++m) { const int r = row0 + ai * HALF + m * 16; const float rs = row_rstd(ssq, r);
                f32x4 o[2];
#pragma unroll
                for (int n = 0; n < 2; ++n) { const f32x4 g = acc[ai][0][m][n] * rs, up = acc[ai][1][m][n] * rs;
#pragma unroll
                    for (int e = 0; e < 4; ++e) o[n][e] = g[e] * fsigmoid(g[e]) * up[e]; }
                *(u32x4*)(hid + (size_t)r * FF + u.pn * HALF + cin) = pack_f8(o[0], o[1]);
                asm volatile("" ::: "memory"); }
    }
};
}

#define XB_TMO      128
#define XB_XCNT(j)  (256  + 64 * (j))
#define XB_XSUB(j)  (1280 + 64 * (j))
#define XB_XGEN(j)  (2304 + 64 * (j))
#define XB_TOP      3328
#define XB_TOPGEN   3392
#define XCD_BAR_WORDS 3456
#define XB_SPIN_CAP (1u << 18)

__device__ __forceinline__ unsigned xb_ld(unsigned* p)              { return __hip_atomic_load(p, __ATOMIC_RELAXED, __HIP_MEMORY_SCOPE_AGENT); }
__device__ __forceinline__ unsigned xb_add(unsigned* p, unsigned v) { return __hip_atomic_fetch_add(p, v, __ATOMIC_RELAXED, __HIP_MEMORY_SCOPE_AGENT); }
__device__ __forceinline__ unsigned xb_xcc_id() { return (unsigned)__builtin_amdgcn_s_getreg((3 << 11) | 20) & 0xFu; }
#define XB_SPIN(cond, bar) do { unsigned _sp = 0; while (cond) { __builtin_amdgcn_s_sleep(1); \
    if ((++_sp & 255u) == 0u) { if (xb_ld(&(bar)[XB_TMO])) break; if (_sp > XB_SPIN_CAP) { atomicAdd(&(bar)[XB_TMO], 1u); break; } } } } while (0)

struct XcdBarrier {
    unsigned* bar; unsigned x;
    volatile LAS unsigned* st;
};

__device__ __forceinline__ XcdBarrier xcd_barrier_post(unsigned* bar, volatile LAS unsigned* st, bool is0) {
    XcdBarrier b; b.bar = bar; b.x = xb_xcc_id(); b.st = st;
    if (is0) (void)xb_add(&bar[XB_XCNT(b.x)], 1u);
    return b;
}
__device__ __forceinline__ void xcd_barrier_complete(unsigned* bar, unsigned x, unsigned& nloc, unsigned& nx) {
    const unsigned G = gridDim.x * gridDim.y * gridDim.z;
    unsigned sum, cnt, mine, sp = 0u;
    for (;;) {
        sum = 0u; cnt = 0u; mine = 0u;
#pragma unroll
        for (unsigned j = 0; j < 16; ++j) { const unsigned c = xb_ld(&bar[XB_XCNT(j)]); sum += c; cnt += (c > 0u) ? 1u : 0u; mine = (j == x) ? c : mine; }
        if (sum == G) break;
        __builtin_amdgcn_s_sleep(1);
        if ((++sp & 255u) == 0u) { if (xb_ld(&bar[XB_TMO])) break; if (sp > XB_SPIN_CAP) { atomicAdd(&bar[XB_TMO], 1u); break; } }
    }
    nloc = mine > 0u ? mine : 1u; nx = cnt > 0u ? cnt : 1u;
}

__device__ __forceinline__ void xcd_barrier(const XcdBarrier& b, bool is0) {
    asm volatile("s_waitcnt vmcnt(0)" ::: "memory");
    __syncthreads();
    if (is0) {
        unsigned* bar = b.bar;
        __builtin_amdgcn_s_waitcnt(0);
        unsigned nloc = b.st[0], nx = b.st[1];
        if (nloc == 0u) { xcd_barrier_complete(bar, b.x, nloc, nx); b.st[0] = nloc; b.st[1] = nx; }
        const unsigned old = xb_add(&bar[XB_XSUB(b.x)], 1u);
        const unsigned gen = old / nloc;
        if (old + 1u == (gen + 1u) * nloc) {
            __builtin_amdgcn_fence(__ATOMIC_RELEASE, "agent");
            asm volatile("s_waitcnt vmcnt(0)" ::: "memory");
            const unsigned og = xb_add(&bar[XB_TOP], 1u);
            const unsigned tg = og / nx;
            if (og + 1u == (tg + 1u) * nx) xb_add(&bar[XB_TOPGEN], 1u);
            else XB_SPIN(xb_ld(&bar[XB_TOPGEN]) == tg, bar);
            __builtin_amdgcn_fence(__ATOMIC_ACQUIRE, "agent");
            xb_add(&bar[XB_XGEN(b.x)], 1u);
            asm volatile("s_waitcnt vmcnt(0)" ::: "memory");
        } else {
            XB_SPIN(xb_ld(&bar[XB_XGEN(b.x)]) == gen, bar);
            __builtin_amdgcn_fence(__ATOMIC_ACQUIRE, "agent");
            asm volatile("s_waitcnt vmcnt(0)" ::: "memory");
        }
    }
    __syncthreads();
}


struct Args { const float* in[31]; float* out; unsigned char* ws; };
typedef const float* cfptr_t;
__device__ __forceinline__ cfptr_t kin(int i) { const volatile __attribute__((address_space(4))) cfptr_t* p = (const volatile __attribute__((address_space(4))) cfptr_t*)__builtin_amdgcn_kernarg_segment_ptr(); return p[i]; }

__device__ __forceinline__ void conv_item(const float* W, int N, int k0, int n0, bf16_t* dst, int ldk, const float* gain, LAS float* scr, int tid, bool split = false) {
    const int n = tid & 63, kq = tid >> 6;
#pragma unroll
    for (int i = 0; i < 8; ++i) { const int k = kq + 8 * i; float v = W[(size_t)(k0 + k) * N + n0 + n]; if (gain) v *= gain[k0 + k]; scr[k * 65 + n] = v; }
    __syncthreads();
    const int nn = tid >> 3, c = tid & 7;
    const LAS float* s = scr + (8 * c) * 65 + nn;
    u32x4 o; o.x = pk2(s[0], s[65]); o.y = pk2(s[130], s[195]); o.z = pk2(s[260], s[325]); o.w = pk2(s[390], s[455]);
    *(u32x4*)(dst + (size_t)((split && nn >= 32) ? nn + 96 : nn) * ldk + k0 + 8 * c) = o;
    __syncthreads();
}
__device__ __forceinline__ void convert_layer(int l, unsigned char* Wb, LAS float* scr, int tid, int bid, int G) {
    for (int it = bid; it < 4032; it += G) {
        int r = it;
        if (r < 1408) { const int kb = r / 88, nb = r % 88; const bool qk = (nb >= 16 && nb < 32); const int brow = qk ? (256 * (4 + ((nb - 16) >> 2)) + 32 * ((nb - 16) & 3)) : nb * 64;
            conv_item(kin(2) + (size_t)l * DM * INC, INC, kb * 64, nb * 64, (bf16_t*)(Wb + W_IN) + (size_t)brow * DM, DM, kin(1) + l * DM, scr, tid, qk); continue; } r -= 1408;
        if (r < 64) { const int kb = r / 16, nb = r % 16; conv_item(kin(23) + (size_t)l * 256 * DM, DM, kb * 64, nb * 64, (bf16_t*)(Wb + W_PA) + (size_t)nb * 64 * 256, 256, nullptr, scr, tid); continue; } r -= 64;
        if (r < 64) { const int kb = r / 16, nb = r % 16; conv_item(kin(24) + (size_t)l * 256 * DM, DM, kb * 64, nb * 64, (bf16_t*)(Wb + W_PB) + (size_t)nb * 64 * 256, 256, nullptr, scr, tid); continue; } r -= 64;
        if (r < 128) { const int kb = r / 16, nb = r % 16; conv_item(kin(25) + (size_t)l * 512 * DM, DM, kb * 64, nb * 64, (bf16_t*)(Wb + W_PC) + (size_t)nb * 64 * 512, 512, nullptr, scr, tid); continue; } r -= 128;
        if (r < 256) { const int kb = r / 16, nb = r % 16; conv_item(kin(26) + (size_t)l * DM * DM, DM, kb * 64, nb * 64, (bf16_t*)(Wb + W_O) + (size_t)nb * 64 * DM, DM, nullptr, scr, tid); continue; } r -= 256;
        if (r < 704) { const int kb = r / 44, nb = r % 44; conv_item(kin(28) + (size_t)l * DM * FF, FF, kb * 64, nb * 64, (bf16_t*)(Wb + W_FF) + (size_t)(256 * (nb >> 1) + 64 * (nb & 1)) * DM, DM, kin(27) + l * DM, scr, tid); continue; } r -= 704;
        if (r < 704) { const int kb = r / 44, nb = r % 44; conv_item(kin(29) + (size_t)l * DM * FF, FF, kb * 64, nb * 64, (bf16_t*)(Wb + W_FF) + (size_t)(256 * (nb >> 1) + 128 + 64 * (nb & 1)) * DM, DM, kin(27) + l * DM, scr, tid); continue; } r -= 704;
        { const int kb = r / 16, nb = r % 16; conv_item(kin(30) + (size_t)l * FF * DM, DM, kb * 64, nb * 64, (bf16_t*)(Wb + W_DN) + (size_t)nb * 64 * FF, FF, nullptr, scr, tid); }
    }
}
__device__ __forceinline__ void convert_small(bf16_t* sm, int tid, int bid, int G) {
    for (int idx = bid * 512 + tid; idx < NL * SMALL_PER_LAYER; idx += G * 512) {
        const int l = idx / SMALL_PER_LAYER, e = idx % SMALL_PER_LAYER; float v;
        if (e < 32768) { const int e2 = e & 16383, hd = e2 >> 12, o = (e2 >> 6) & 63, i = e2 & 63; const float* src = (e < 16384) ? kin(6) : kin(8); v = src[(size_t)((l * 4 + hd) * 64 + i) * 64 + o]; }
        else { const int e2 = e - 32768, t = (e2 >> 7) & 127, s = e2 & 127; v = (s <= t) ? kin(13)[(size_t)l * 65536 + e2] : 0.f; }
        sm[idx] = f2bf(v);
    }
}
__device__ __forceinline__ void x_pass(const float* x, bf16_t* xb, float* ssq, int lane, int gw, int NGW) {
    for (int m = gw; m < MT; m += NGW) {
        const f32x4* xr = (const f32x4*)(x + (size_t)m * DM) + lane; u32x2* o = (u32x2*)(xb + (size_t)m * DM) + lane; float ss = 0.f;
#pragma unroll
        for (int j = 0; j < 4; ++j) { const f32x4 v = xr[64 * j]; ss += (v[0] * v[0] + v[1] * v[1]) + (v[2] * v[2] + v[3] * v[3]); u32x2 w; w.x = pk2(v[0], v[1]); w.y = pk2(v[2], v[3]); o[64 * j] = w; }
        ss = wave_sum(ss, lane);
        if (lane < 16) ssq[(size_t)m * 16 + lane] = (lane == 0) ? ss : 0.f;
    }
}
__device__ __forceinline__ void qk_norm(bf16_t* proj, bf16_t* outp, int opitch, const float* qg, const float* kg, int lane, int gw, int NGW) {
    const int d0 = (lane * 8) & 63; float gq[8], gk[8];
#pragma unroll
    for (int e = 0; e < 8; ++e) { gq[e] = qg[d0 + e] * (0.125f * LOG2E); gk[e] = kg[d0 + e]; }
    for (int m = gw; m < MT; m += NGW) {
        bf16_t* base = proj + (size_t)m * PJ + 1024;
#pragma unroll
        for (int i = 0; i < 2; ++i) { const u32x4* p = (const u32x4*)(base + (lane + 64 * i) * 8); const u32x4 v = *p; u32x4* po = (u32x4*)(outp + (size_t)m * opitch + (lane + 64 * i) * 8);
            float f[8] = {bflo(v.x), bfhi(v.x), bflo(v.y), bfhi(v.y), bflo(v.z), bfhi(v.z), bflo(v.w), bfhi(v.w)};
            float ss = 0.f;
#pragma unroll
            for (int e = 0; e < 8; ++e) ss += f[e] * f[e];
            ss += shx(ss, 1, lane); ss += shx(ss, 2, lane); ss += shx(ss, 4, lane);
            const float rs = __builtin_amdgcn_rsqf(ss * (1.f / 64.f) + EPS);
#pragma unroll
            for (int e = 0; e < 8; ++e) f[e] *= rs * (i == 0 ? gq[e] : gk[e]);
            u32x4 w; w.x = pk2(f[0], f[1]); w.y = pk2(f[2], f[3]); w.z = pk2(f[4], f[5]); w.w = pk2(f[6], f[7]); *po = w; }
    }
}

constexpr int LRU_XA = 0, LRU_XP = 528, LRU_CW = 35392;
struct LruP { const float *cw, *cb, *ba, *bi, *lam; const bf16_t *waT, *wiT; };
template <bool FINAL> __device__ __forceinline__ void lru_unit(LAS unsigned char* lds, bf16_t* proj, bf16_t* outp, int opitch, float* agg, const LruP& P, int b, int chunk, int tid) {
    const int lane = tid & 63, r = lane & 31, h = lane >> 5, w = __builtin_amdgcn_readfirstlane(tid >> 6), hd = w >> 1, cbk = w & 1;
    const size_t Rb = (size_t)b * SEQ; const int t0 = chunk * 64;
    for (int c = tid; c < 67 * 32; c += 512) { const int j = c >> 5, cc = c & 31, tok = t0 - 3 + j; u32x4 v = {0u, 0u, 0u, 0u};
        if (tok >= 0) v = *(const u32x4*)(proj + (Rb + tok) * PJ + cc * 8);
        *(LAS u32x4*)(lds + LRU_XA + j * LRU_XP + cc * 16) = v; }
    LAS float* CWl = (LAS float*)(lds + LRU_CW);
    for (int i = tid; i < 1280; i += 512) CWl[i] = (i < 1024) ? P.cw[i] : P.cb[i - 1024];
    __syncthreads();
    const int oc = hd * 64 + cbk * 32 + r;
    float Hc = 0.f;
    if (FINAL) {
        const int mid = chunk >> 1, lo = h ? mid : 0, hi2 = h ? chunk : mid; float PA = 1.f, PH = 0.f;
        const f32x2* ap = (const f32x2*)agg + ((size_t)b * 256) * 256 + oc;
        int j = lo;
        for (; j + 16 <= hi2; j += 16) { f32x2 qv[16];
#pragma unroll
            for (int i = 0; i < 16; ++i) qv[i] = ap[(size_t)(j + i) * 256];
#pragma unroll
            for (int i = 0; i < 16; ++i) { PH = qv[i].x * PH + qv[i].y; PA *= qv[i].x; } }
        for (; j < hi2; ++j) { const f32x2 q = ap[(size_t)j * 256]; PH = q.x * PH + q.y; PA *= q.x; }
        const float oPA = shx(PA, 32, lane), oPH = shx(PH, 32, lane);
        Hc = h ? (PA * oPH + PH) : (oPA * PH + oPH);
        asm volatile("" : "+v"(Hc));
    }
    const float cw0 = CWl[oc], cw1 = CWl[256 + oc], cw2 = CWl[512 + oc], cw3 = CWl[768 + oc], cbv = CWl[1024 + oc];
    const float bav = P.ba[oc], biv = P.bi[oc], elam = __builtin_amdgcn_exp2f(-P.lam[oc] * LOG2E), cl = -8.f * ((elam < 0.03f) ? elam * (1.f - elam * (0.5f - elam * (0.33333334f - elam * 0.25f))) : __builtin_amdgcn_logf(1.f + elam) * 0.6931471805599453f);
    float av[2][16], bv[2][16];
#pragma unroll
    for (int rb = 0; rb < 2; ++rb) { f32x16 acca = (f32x16){}, acci = (f32x16){};
#pragma unroll
        for (int ks = 0; ks < 4; ++ks) { const int ci0 = hd * 64 + 16 * ks + 8 * h;
            const bf16x8 waf = *(const bf16x8*)(P.waT + (size_t)oc * 64 + 16 * ks + 8 * h), wif = *(const bf16x8*)(P.wiT + (size_t)oc * 64 + 16 * ks + 8 * h);
            const f32x4 c0 = *(const LAS f32x4*)(CWl + 1024 + ci0), c1 = *(const LAS f32x4*)(CWl + 1024 + ci0 + 4);
            float xc[8] = {c0[0], c0[1], c0[2], c0[3], c1[0], c1[1], c1[2], c1[3]};
#pragma unroll
            for (int tap = 0; tap < 4; ++tap) { const u32x4 xv = *(const LAS u32x4*)(lds + LRU_XA + (32 * rb + r + tap) * LRU_XP + ci0 * 2);
                const f32x4 w0 = *(const LAS f32x4*)(CWl + tap * 256 + ci0), w1 = *(const LAS f32x4*)(CWl + tap * 256 + ci0 + 4);
                xc[0] += w0[0] * bflo(xv.x); xc[1] += w0[1] * bfhi(xv.x); xc[2] += w0[2] * bflo(xv.y); xc[3] += w0[3] * bfhi(xv.y);
                xc[4] += w1[0] * bflo(xv.z); xc[5] += w1[1] * bfhi(xv.z); xc[6] += w1[2] * bflo(xv.w); xc[7] += w1[3] * bfhi(xv.w); }
            const bf16x8 af = pack8(xc[0], xc[1], xc[2], xc[3], xc[4], xc[5], xc[6], xc[7]);
            acca = MFMA32(af, waf, acca); acci = MFMA32(af, wif, acci); }
#pragma unroll
        for (int i = 0; i < 16; ++i) { const int tok = 32 * rb + crow(i, h);
            const LAS bf16_t* xp = (const LAS bf16_t*)(lds + LRU_XA + tok * LRU_XP + oc * 2);
            const float xc = cbv + cw0 * bf2f(xp[0]) + cw1 * bf2f(xp[LRU_XP / 2]) + cw2 * bf2f(xp[LRU_XP]) + cw3 * bf2f(xp[3 * LRU_XP / 2]);
            const float rg = fsigmoid(acca[i] + bav), ig = fsigmoid(acci[i] + biv), la = cl * rg;
            const float x2 = 2.f * la;
            const float em1 = (x2 > -0.03f) ? x2 * (1.f + x2 * (0.5f + x2 * (0.16666667f + x2 * 0.041666668f))) : (__builtin_amdgcn_exp2f(x2 * LOG2E) - 1.f);
            av[rb][i] = __builtin_amdgcn_exp2f(la * LOG2E); bv[rb][i] = __builtin_amdgcn_sqrtf(-em1) * ig * xc; }
#pragma unroll
        for (int i = 0; i < 16; ++i) asm volatile("" : "+v"(av[rb][i]), "+v"(bv[rb][i]));
    }
    float Ag[8], Bg[8];
#pragma unroll
    for (int k = 0; k < 8; ++k) { const int rb = k >> 2, i0 = 4 * (k & 3);
        Ag[k] = (av[rb][i0] * av[rb][i0 + 1]) * (av[rb][i0 + 2] * av[rb][i0 + 3]);
        Bg[k] = ((bv[rb][i0] * av[rb][i0 + 1] + bv[rb][i0 + 1]) * av[rb][i0 + 2] + bv[rb][i0 + 2]) * av[rb][i0 + 3] + bv[rb][i0 + 3]; }
    float myin[8]; float Pp = 1.f;
#pragma unroll
    for (int k = 0; k < 8; ++k) { const float pA = shx(Ag[k], 32, lane), pB = shx(Bg[k], 32, lane);
        const float A0 = h ? pA : Ag[k], B0 = h ? pB : Bg[k], A1 = h ? Ag[k] : pA, B1 = h ? Bg[k] : pB;
        const float in0 = Hc; Hc = A0 * Hc + B0; const float in1 = Hc; Hc = A1 * Hc + B1; myin[k] = h ? in1 : in0; Pp *= A0 * A1; }
    if (!FINAL) { if (h == 0) { f32x2 q; q.x = Pp; q.y = Hc; ((f32x2*)agg)[((size_t)b * 256 + chunk) * 256 + oc] = q; } }
    else {
#pragma unroll
        for (int k = 0; k < 8; ++k) { const int rb = k >> 2, i0 = 4 * (k & 3); float hh = myin[k];
#pragma unroll
            for (int j = 0; j < 4; ++j) { hh = av[rb][i0 + j] * hh + bv[rb][i0 + j]; const int tok = 32 * rb + 8 * (k & 3) + 4 * h + j;
                const bf16_t* gp = proj + (Rb + t0 + tok) * PJ + 256 + oc; const float ga = bf2f(*gp); bf16_t* go = outp + (Rb + t0 + tok) * opitch + oc;
                const float z = 1.5957691216057308f * (ga + 0.044715f * ga * ga * ga);
                *go = f2bf(hh * ga * fsigmoid(z)); }
            asm volatile("" ::: "memory"); }
    }
    __syncthreads();
}

constexpr int SG_VP = 272;
struct SgP { const float *lng, *lnb, *sgb; const bf16_t* sgw; };
__device__ __forceinline__ void sg_unit(LAS unsigned char* lds, bf16_t* proj, bf16_t* outp, int opitch, const SgP& P, int n, int tid) {
    const int lane = tid & 63, r = lane & 31, h = lane >> 5, w = __builtin_amdgcn_readfirstlane(tid >> 6);
    const size_t R0 = (size_t)n * 128;
    { const f32x4 g4 = *(const f32x4*)(P.lng + lane * 4), b4 = *(const f32x4*)(P.lnb + lane * 4);
#pragma unroll 4
      for (int rr = 0; rr < 16; ++rr) { const int t = w * 16 + rr; const u32x2 raw = *(const u32x2*)(proj + (R0 + t) * PJ + 768 + lane * 4);
        float v[4] = {bflo(raw.x), bfhi(raw.x), bflo(raw.y), bfhi(raw.y)};
        const float mean = wave_sum((v[0] + v[1]) + (v[2] + v[3]), lane) * (1.f / 256.f);
#pragma unroll
        for (int e = 0; e < 4; ++e) v[e] -= mean;
        const float var = wave_sum((v[0] * v[0] + v[1] * v[1]) + (v[2] * v[2] + v[3] * v[3]), lane) * (1.f / 256.f);
        const float rs = __builtin_amdgcn_rsqf(var + EPS);
#pragma unroll
        for (int e = 0; e < 4; ++e) *(LAS bf16_t*)(lds + (lane * 4 + e) * SG_VP + t * 2) = f2bf(v[e] * rs * g4[e] + b4[e]); } }
    __syncthreads();
    const int g = w >> 1, cbk = w & 1, c = g * 64 + cbk * 32 + r;
#pragma unroll
    for (int tb = 0; tb < 4; ++tb) { f32x16 acc = (f32x16){};
        const bf16_t* wp = P.sgw + (size_t)(g * 128 + 32 * tb + r) * 128 + 8 * h;
#pragma unroll
        for (int ks = 0; ks < 2 * tb + 2; ++ks) { const bf16x8 af = *(const bf16x8*)(wp + 16 * ks); const bf16x8 bfr = *(const LAS bf16x8*)(lds + c * SG_VP + (16 * ks + 8 * h) * 2); acc = MFMA32(af, bfr, acc); }
#pragma unroll
        for (int i = 0; i < 16; ++i) { const int t = 32 * tb + crow(i, h); const bf16_t* up = proj + (R0 + t) * PJ + 512 + c; outp[(R0 + t) * opitch + c] = f2bf(bf2f(*up) * (acc[i] + P.sgb[g * 128 + t])); } }
    __syncthreads();
}

constexpr int AT_SLOT = 16384, AT_K = 0, AT_V = 4 * AT_SLOT, AT_TAB = 131072 + 1024;
__device__ __forceinline__ void glds16(const void* gsrc, unsigned lds_dst) {
    unsigned keep;
    asm volatile("s_mov_b32 %0, m0\n\ts_mov_b32 m0, %2\n\ts_nop 0\n\tglobal_load_lds_dwordx4 %1, off\n\ts_mov_b32 m0, %0" : "=&s"(keep) : "v"(gsrc), "s"(lds_dst) : "memory");
}
__device__ __forceinline__ void at_qk(f32x16& p0, f32x16& p1, const LAS unsigned char* lk, const int (&koff)[4], const bf16x8 (&qf)[4]) {
    const f32x16 z = (f32x16){};
#pragma unroll
    for (int ks = 0; ks < 4; ++ks) { const bf16x8 a0 = *(const LAS bf16x8*)(lk + koff[ks]), a1 = *(const LAS bf16x8*)(lk + koff[ks] + 8192);
        p0 = MFMA32(a0, qf[ks], ks == 0 ? z : p0); p1 = MFMA32(a1, qf[ks], ks == 0 ? z : p1); }
}
__device__ __forceinline__ void at_bias(f32x16& p0, f32x16& p1, const LAS float* tb) {
#pragma unroll
    for (int i = 0; i < 16; ++i) { const int kk = (i & 3) + 8 * (i >> 2); p0[i] += tb[kk]; p1[i] += tb[32 + kk]; }
}
template <bool DOQK, bool DOEXP, bool DOPV, int VAR> __device__ __forceinline__ void at_fused(f32x16& pn0, f32x16& pn1, f32x16& pc0, f32x16& pc1, bf16x8 (&pfc)[4], const bf16x8 (&pfp)[4], f32x16 (&o)[4], float& lsum,
                                         const LAS unsigned char* lk, const LAS unsigned char* lv, const int (&koff)[4], const int (&voff)[4], const bf16x8 (&qf)[4]) {
    constexpr int PD = 4, NF = PD + 1;
    bf16x8 fr[NF];
#define AT_NEED(g) (((g) < 8) ? DOQK : DOPV)
#define AT_FRAG(g) (((g) < 8) ? *(const LAS bf16x8*)(lk + koff[(g) >> 1] + ((g) & 1) * 8192) : *(const LAS bf16x8*)(lv + voff[((g) - 8) >> 2] + (((g) - 8) & 3) * 4096))
#define AT_EX2(x) ((VAR == 1) ? (x) : __builtin_amdgcn_exp2f(x))
#define AT_EXP(e) do { if ((e) < 16) { pc0[(e)] = AT_EX2(pc0[(e)]); s0 += pc0[(e)]; } else { pc1[(e) - 16] = AT_EX2(pc1[(e) - 16]); s1 += pc1[(e) - 16]; } } while (0)
#pragma unroll
    for (int g = 0; g < PD; ++g) { if (AT_NEED(g)) fr[g % NF] = AT_FRAG(g); else fr[g % NF] = (bf16x8){}; }
    float s0 = 0.f, s1 = 0.f;
    const f32x16 z = (f32x16){};
#pragma unroll
    for (int g = 0; g < 24; ++g) {
        if (g + PD < 24 && AT_NEED(g + PD)) fr[(g + PD) % NF] = AT_FRAG(g + PD);
        if (g < 8) { const int ks = g >> 1;
            if (!DOQK || VAR == 2) {} else if (g & 1) pn1 = MFMA32(fr[g % NF], qf[ks], ks == 0 ? z : pn1); else pn0 = MFMA32(fr[g % NF], qf[ks], ks == 0 ? z : pn0);
        } else if (DOPV && VAR != 2) { const int sp = (g - 8) >> 2, db = (g - 8) & 3; o[db] = MFMA32(fr[g % NF], pfp[sp], o[db]); }
        if (DOEXP) {
            const int e0 = g + (g + 2) / 3, e1 = (g + 1) + (g + 3) / 3;
#pragma unroll
            for (int e = e0; e < e1; ++e) AT_EXP(e);
            asm volatile("" : "+v"(s0), "+v"(s1));
            if (g == 6) pfc[0] = pack8(pc0[0], pc0[1], pc0[2], pc0[3], pc0[4], pc0[5], pc0[6], pc0[7]);
            if (g == 12) pfc[1] = pack8(pc0[8], pc0[9], pc0[10], pc0[11], pc0[12], pc0[13], pc0[14], pc0[15]);
            if (g == 18) pfc[2] = pack8(pc1[0], pc1[1], pc1[2], pc1[3], pc1[4], pc1[5], pc1[6], pc1[7]);
        }
        __builtin_amdgcn_sched_barrier(0);
    }
    if (DOEXP) { pfc[3] = pack8(pc1[8], pc1[9], pc1[10], pc1[11], pc1[12], pc1[13], pc1[14], pc1[15]); lsum += s0 + s1; }
#undef AT_FRAG
#undef AT_NEED
#undef AT_EXP
#undef AT_EX2
}
template <int VAR> __device__ __forceinline__ void attn_unit(LAS unsigned char* lds, const bf16_t* proj, const bf16_t* vt, bf16_t* outp, int opitch, int b, int hd, int qb, float lam, float osc, const float* relb, const float* subg, int tid_in) {
    int tid = tid_in; asm volatile("" : "+v"(tid));
    const int lane = tid & 63, r = lane & 31, h = lane >> 5, w = __builtin_amdgcn_readfirstlane(tid >> 6), mp = w >> 2, rs = w & 3;
    LAS float* tab = (LAS float*)(lds + AT_TAB);
    const size_t Rb = (size_t)b * SEQ, R0 = Rb + (size_t)qb * 128;
    const int NT = 2 * qb + 2;
    const bool deep = NT >= 8;
    const int rk0 = 8 * w + (lane >> 4), rk1 = rk0 + 4, rv0 = 16 * w + (lane >> 3), rv1 = rv0 + 8;
    const bf16_t* ks0 = proj + (Rb + rk0) * PJ + 1536 + hd * 128 + (((lane & 15) ^ (rk0 & 15)) * 8);
    const bf16_t* ks1 = proj + (Rb + rk1) * PJ + 1536 + hd * 128 + (((lane & 15) ^ (rk1 & 15)) * 8);
    const bf16_t* vs0 = vt + ((size_t)((b * 4 + hd) * 128 + rv0)) * SEQ + (((lane & 7) ^ ((rv0 >> 1) & 7)) * 8);
    const bf16_t* vs1 = vt + ((size_t)((b * 4 + hd) * 128 + rv1)) * SEQ + (((lane & 7) ^ ((rv1 >> 1) & 7)) * 8);
    const unsigned ldsb = (unsigned)(uintptr_t)lds, kd = ldsb + AT_K + w * 2048, vd = ldsb + AT_V + w * 2048;
#define AT_ISSUE_K(j) do { const unsigned d_ = (unsigned)__builtin_amdgcn_readfirstlane(kd + ((j) & 3) * AT_SLOT); if (VAR != 3) { glds16(ks0 + (size_t)(j) * 64 * PJ, d_); glds16(ks1 + (size_t)(j) * 64 * PJ, d_ + 1024u); } } while (0)
#define AT_ISSUE_V(j) do { const unsigned d_ = (unsigned)__builtin_amdgcn_readfirstlane(vd + ((j) & 3) * AT_SLOT); if (VAR != 3) { glds16(vs0 + (j) * 64, d_); glds16(vs1 + (j) * 64, d_ + 1024u); } } while (0)
#define AT_WAITBAR(N) asm volatile("s_waitcnt vmcnt(" #N ") lgkmcnt(0)\n\ts_barrier" ::: "memory")
    AT_ISSUE_K(0); AT_ISSUE_K(1);
    if (2 < NT) AT_ISSUE_K(2);
    AT_ISSUE_V(0);
    if (3 < NT) AT_ISSUE_K(3);
    AT_ISSUE_V(1);
    { const float cfar = relb[15 * 4 + hd];
      if (tid < 64) tab[1216 + tid] = -INFINITY;
      for (int idx = tid; idx < 1216; idx += 512) { const int rel = idx - 1151, n = rel < 0 ? -rel : rel; int bk = (n < 8) ? n : (5 + (31 - __builtin_clz(n))); bk = bk > 15 ? 15 : bk; if (rel > 0) bk += 16; tab[idx] = (relb[bk * 4 + hd] - cfar) * LOG2E; } }
    bf16x8 qf[4];
    { const bf16_t* qp = proj + (R0 + 32 * rs + r) * PJ + 1024 + hd * 128 + mp * 64 + 8 * h;
#pragma unroll
      for (int ks = 0; ks < 4; ++ks) qf[ks] = *(const bf16x8*)(qp + 16 * ks); }
    int koff[4], voff[4];
    { const int kx = (mp * 8 + h) ^ (r & 15), vx = h ^ ((r >> 1) & 7);
#pragma unroll
      for (int i = 0; i < 4; ++i) { koff[i] = r * 256 + ((kx ^ (2 * i)) << 4); voff[i] = r * 128 + ((vx ^ (2 * i)) << 4); } }
    if (deep) AT_WAITBAR(8); else AT_WAITBAR(0);
    f32x16 o[4]; o[0] = (f32x16){}; o[1] = (f32x16){}; o[2] = (f32x16){}; o[3] = (f32x16){};
    float lsum = 0.f;
    const int qpos = qb * 128 + 32 * rs + r;
    const LAS float* tb0 = tab + (1151 + 4 * h - qpos);
    f32x16 pa0, pa1, pb0, pb1; bf16x8 pfA[4], pfB[4];
    pb0 = (f32x16){}; pb1 = (f32x16){};
#pragma unroll
    for (int i = 0; i < 4; ++i) { pfA[i] = (bf16x8){}; pfB[i] = (bf16x8){}; }
    at_qk(pa0, pa1, lds + AT_K, koff, qf);
    if (1088 > qb * 128) at_bias(pa0, pa1, tb0);
    asm volatile("s_waitcnt lgkmcnt(0)\n\ts_barrier" ::: "memory");
#define AT_STEP(t, C0, C1, N0, N1, PC, PP, DOPV) do { \
        if ((t) + 4 < NT) AT_ISSUE_K((t) + 4); \
        if ((t) + 2 < NT) AT_ISSUE_V((t) + 2); \
        at_fused<true, true, DOPV, VAR>(N0, N1, C0, C1, PC, PP, o, lsum, lds + AT_K + (((t) + 1) & 3) * AT_SLOT, lds + AT_V + (((t) + 3) & 3) * AT_SLOT, koff, voff, qf); \
        if (((t) + 1) * 64 + 1088 > qb * 128) at_bias(N0, N1, (rs < 2 && (t) + 2 == NT) ? (const LAS float*)(tab + 1216) : tb0 + ((t) + 1) * 64); \
        if ((t) + 4 < NT) AT_WAITBAR(8); else AT_WAITBAR(0); } while (0)
    AT_STEP(0, pa0, pa1, pb0, pb1, pfA, pfB, false);
    for (int t = 1; t + 1 < NT; t += 2) {
        AT_STEP(t, pb0, pb1, pa0, pa1, pfB, pfA, true);
        AT_STEP(t + 1, pa0, pa1, pb0, pb1, pfA, pfB, true);
    }
    at_fused<false, true, true, VAR>(pa0, pa1, pb0, pb1, pfB, pfA, o, lsum, lds + AT_K, lds + AT_V + ((NT - 2) & 3) * AT_SLOT, koff, voff, qf);
    at_fused<false, false, true, VAR>(pa0, pa1, pb0, pb1, pfA, pfB, o, lsum, lds + AT_K, lds + AT_V + ((NT - 1) & 3) * AT_SLOT, koff, voff, qf);
    __syncthreads();
#undef AT_STEP
#undef AT_ISSUE_K
#undef AT_ISSUE_V
#undef AT_WAITBAR
    int lane_e = tid & 63; asm volatile("" : "+v"(lane_e));
    lsum += shx(lsum, 32, lane_e);
    const float inv = __builtin_amdgcn_rcpf(lsum);
    LAS float* ex = (LAS float*)lds;
    if (mp == 1) {
#pragma unroll
        for (int db = 0; db < 4; ++db)
#pragma unroll
            for (int i = 0; i < 16; ++i) ex[((rs * 4 + db) * 16 + i) * 64 + lane_e] = o[db][i] * inv;
    }
    __syncthreads();
    if (mp == 0) {
        float ss = 0.f;
#pragma unroll
        for (int db = 0; db < 4; ++db)
#pragma unroll
            for (int i = 0; i < 16; ++i) { const float v = o[db][i] * inv - lam * ex[((rs * 4 + db) * 16 + i) * 64 + lane_e]; o[db][i] = v; ss += v * v; }
        ss += shx(ss, 32, lane_e);
        const float rsn = __builtin_amdgcn_rsqf(ss * (1.f / 128.f) + EPS) * osc;
        const int r_e = lane_e & 31, h_e = lane_e >> 5; bf16_t* op = outp + (R0 + 32 * rs + r_e) * opitch + hd * 128;
#pragma unroll
        for (int db = 0; db < 4; ++db)
#pragma unroll
            for (int i4 = 0; i4 < 4; ++i4) { const int d = 32 * db + 8 * i4 + 4 * h_e; const f32x4 g4 = *(const f32x4*)(subg + d);
                u32x2 wv; wv.x = pk2(o[db][4 * i4] * rsn * g4[0], o[db][4 * i4 + 1] * rsn * g4[1]); wv.y = pk2(o[db][4 * i4 + 2] * rsn * g4[2], o[db][4 * i4 + 3] * rsn * g4[3]);
                *(u32x2*)(op + d) = wv; }
    }
    __syncthreads();
}

__global__ void __launch_bounds__(512, 2) mega_fwd(Args a) {
    extern __shared__ __attribute__((aligned(16))) unsigned char lds_raw[];
    cg::grid_group grid = cg::this_grid();
    LAS unsigned char* lds = (LAS unsigned char*)lds_raw;
    const int G = gridDim.x, bid = blockIdx.x;
    const int wave = __builtin_amdgcn_readfirstlane(threadIdx.x >> 6);
#define IS_T0(v) bool v; { int l_; asm volatile("v_mbcnt_lo_u32_b32 %0, -1, 0\n\tv_mbcnt_hi_u32_b32 %0, -1, %0" : "=v"(l_)); v = (wave == 0) && (l_ == 0); }
    { IS_T0(t0_); if (t0_) { ((LAS unsigned*)(lds + MISC_OFF))[8] = 0u; ((LAS unsigned*)(lds + MISC_OFF))[9] = 0u; } __syncthreads();
      (void)xcd_barrier_post((unsigned*)kin(32) + CW_BAR, (volatile LAS unsigned*)(lds + MISC_OFF) + 8, t0_); }
#define GRID_BAR() do { XcdBarrier b_; b_.bar = (unsigned*)kin(32) + CW_BAR; b_.x = xb_xcc_id(); b_.st = (volatile LAS unsigned*)(lds + MISC_OFF) + 8; IS_T0(t0_); xcd_barrier(b_, t0_); } while (0)
#define PH_BEGIN int tid, bidp = bid, Gp = G; { int l_; asm volatile("v_mbcnt_lo_u32_b32 %0, -1, 0\n\tv_mbcnt_hi_u32_b32 %0, -1, %0" : "=v"(l_)); asm volatile("" : "+s"(bidp), "+s"(Gp)); tid = wave * 64 + l_; }
#define WSB(off) ((unsigned char*)kin(32) + (off))
#define ssqA ((float*)WSB(WS_SSQA))
#define ssqB ((float*)WSB(WS_SSQB))
#define agg ((float*)WSB(WS_AGG))
#define sm ((bf16_t*)WSB(WS_SMALL))
#define xb ((bf16_t*)WSB(WS_XB))
#define merged ((bf16_t*)WSB(WS_XB))
#define proj ((bf16_t*)WSB(WS_PROJ))
#define xb2 ((bf16_t*)WSB(WS_PROJ))
#define vt ((bf16_t*)WSB(WS_VT))
#define gates ((bf16_t*)WSB(WS_GATES))
#define hid ((bf16_t*)WSB(WS_GATES))
#define out ((float*)kin(31))
#define ws WSB(0)

    { PH_BEGIN; convert_layer(0, ws + WS_W0, (LAS float*)lds, tid, bidp, Gp);
      convert_small(sm, tid, bidp, Gp);
      x_pass(kin(0), xb, ssqA, tid & 63, bidp * 8 + wave, Gp * 8); }
    grid.sync();

    for (int l = 0; l < NL; ++l) {
#define WL(off) (ws + WS_W0 + (size_t)(l & 1) * WS_WSZ + (off))
#ifndef NO_A
        {
            PH_BEGIN;
            pg8::Gemm g{xb, (const bf16_t*)WL(W_IN), MT, INC, DM, DM}; pg8::StaticOrder S; S.init(MT, INC, Gp, bidp);
            pg8::EpiInProj E{proj, vt, gates, ssqA, kin(3) + l * 3072, kin(15) + l * 64, kin(16) + l * 64};
            pg8::gemm_phase<pg8::EpiInProj, pg8::StaticOrder, true, true>(lds, g, S, E, tid);
#ifdef PROBE_A
            pg8::gemm_phase<pg8::EpiInProj, pg8::StaticOrder, true, true>(lds, g, S, E, tid);
#endif
        }
#endif
        GRID_BAR();
        {
            PH_BEGIN; const int lane = tid & 63, gw = bidp * 8 + wave, NGW = Gp * 8;
            const bf16_t* sml = sm + (size_t)l * SMALL_PER_LAYER;
#if defined(PROBE_B) && PROBE_B == 3
            { LruP LP{kin(4) + l * 1024, kin(5) + l * 256, kin(7) + l * 256, kin(9) + l * 256, kin(10) + l * 256, sml, sml + 16384};
              for (int u = bidp; u < 512; u += Gp) lru_unit<false>(lds, proj, proj, PJ, agg, LP, u >> 8, u & 255, tid); }
            if (l + 1 < NL) convert_layer(l + 1, ws + WS_W0 + (size_t)((l + 1) & 1) * WS_WSZ, (LAS float*)lds, tid, bidp, Gp);
#elif defined(PROBE_B)
#if PROBE_B == 1
            qk_norm(proj, xb, 1024, kin(15) + l * 64, kin(16) + l * 64, lane, gw, NGW);
#endif
            { LruP LP{kin(4) + l * 1024, kin(5) + l * 256, kin(7) + l * 256, kin(9) + l * 256, kin(10) + l * 256, sml, sml + 16384};
              for (int u = bidp; u < 512; u += Gp) lru_unit<false>(lds, proj, proj, PJ, agg, LP, u >> 8, u & 255, tid); }
            { SgP SP{kin(11) + l * 256, kin(12) + l * 256, kin(14) + l * 512, sml + 32768};
              for (int u = bidp; u < 256; u += Gp) sg_unit(lds, proj, xb, 1024, SP, u, tid); }
#if PROBE_B == 1
            if (l + 1 < NL) convert_layer(l + 1, ws + WS_W0 + (size_t)((l + 1) & 1) * WS_WSZ, (LAS float*)lds, tid, bidp, Gp);
#endif
#endif
            { LruP LP{kin(4) + l * 1024, kin(5) + l * 256, kin(7) + l * 256, kin(9) + l * 256, kin(10) + l * 256, sml, sml + 16384};
              for (int u = bidp; u < 512; u += Gp) lru_unit<false>(lds, proj, proj, PJ, agg, LP, u >> 8, u & 255, tid); }
            { SgP SP{kin(11) + l * 256, kin(12) + l * 256, kin(14) + l * 512, sml + 32768};
              for (int u = bidp; u < 256; u += Gp) sg_unit(lds, proj, proj + 512, PJ, SP, u, tid); }
            if (l + 1 < NL) convert_layer(l + 1, ws + WS_W0 + (size_t)((l + 1) & 1) * WS_WSZ, (LAS float*)lds, tid, bidp, Gp);
        }
        GRID_BAR();
        {
            PH_BEGIN; const int lane = tid & 63;
            float d1 = kin(17)[l * 64 + lane] * kin(18)[l * 64 + lane], d2 = kin(19)[l * 64 + lane] * kin(20)[l * 64 + lane];
            d1 = wave_sum(d1, lane); d2 = wave_sum(d2, lane);
            const float lam_init = 0.8f - 0.6f * __builtin_amdgcn_exp2f(-0.3f * LOG2E * (float)l);
            const float lam = __builtin_amdgcn_exp2f(d1 * LOG2E) - __builtin_amdgcn_exp2f(d2 * LOG2E) + lam_init;
            const float* relb = kin(22); const float* subg = kin(21) + l * 128;
#ifndef NO_ATT
#ifdef PROBE_ATT
            if (Gp == 256) {
                const int vcu = (bidp % 8) * 32 + bidp / 8, bh = vcu >> 5, s = vcu & 31;
#define ATT_OUT xb, 1024
                for (int i = 0; i < 4; ++i) { const int qb = (i == 0) ? 127 - s : (i == 1) ? 95 - s : (i == 2) ? 32 + s : s; attn_unit<PROBE_ATT>(lds, proj, vt, ATT_OUT, bh >> 2, bh & 3, qb, lam, 1.f - lam_init, relb, subg, tid); }
#undef ATT_OUT
            }
#endif
#define ATT_OUT proj + 1024, PJ
            if (Gp == 256) {
                const int vcu = (bidp % 8) * 32 + bidp / 8, bh = vcu >> 5, s = vcu & 31;
                for (int i = 0; i < 4; ++i) { const int qb = (i == 0) ? 127 - s : (i == 1) ? 95 - s : (i == 2) ? 32 + s : s; attn_unit<0>(lds, proj, vt, ATT_OUT, bh >> 2, bh & 3, qb, lam, 1.f - lam_init, relb, subg, tid); }
            } else {
                for (int u = bidp; u < 1024; u += Gp) attn_unit<0>(lds, proj, vt, ATT_OUT, u >> 9, (u >> 7) & 3, u & 127, lam, 1.f - lam_init, relb, subg, tid);
            }
#endif
            { const bf16_t* sml = sm + (size_t)l * SMALL_PER_LAYER;
              LruP LP{kin(4) + l * 1024, kin(5) + l * 256, kin(7) + l * 256, kin(9) + l * 256, kin(10) + l * 256, sml, sml + 16384};
#if defined(PROBE_B) && PROBE_B != 3
              for (int u = bidp; u < 512; u += Gp) lru_unit<true>(lds, proj, xb, 1024, agg, LP, u >> 8, u & 255, tid);
#endif
              for (int u = bidp; u < 512; u += Gp) lru_unit<true>(lds, proj, proj + 256, PJ, agg, LP, u >> 8, u & 255, tid); }
        }
        GRID_BAR();
#ifndef NO_C1
        { PH_BEGIN; pg8::StaticOrder S; S.init(MT, DM, Gp, bidp); pg8::Gemm g{proj + 256, (const bf16_t*)WL(W_PA), MT, DM, 256, PJ}; pg8::EpiMerge<0> E{gates, merged}; pg8::gemm_phase<pg8::EpiMerge<0>, pg8::StaticOrder, true, true>(lds, g, S, E, tid); }
        { PH_BEGIN; pg8::StaticOrder S; S.init(MT, DM, Gp, bidp); pg8::Gemm g{proj + 512, (const bf16_t*)WL(W_PB), MT, DM, 256, PJ}; pg8::EpiMerge<1> E{gates, merged}; pg8::gemm_phase<pg8::EpiMerge<1>, pg8::StaticOrder, true, true>(lds, g, S, E, tid); }
        { PH_BEGIN; pg8::StaticOrder S; S.init(MT, DM, Gp, bidp); pg8::Gemm g{proj + 1024, (const bf16_t*)WL(W_PC), MT, DM, 512, PJ}; pg8::EpiMerge<2> E{gates, merged}; pg8::gemm_phase<pg8::EpiMerge<2>, pg8::StaticOrder, true, true>(lds, g, S, E, tid); }
#ifdef PROBE_C1
        { PH_BEGIN; pg8::StaticOrder S; S.init(MT, DM, Gp, bidp); pg8::Gemm g{proj + 256, (const bf16_t*)WL(W_PA), MT, DM, 256, PJ}; pg8::EpiMerge<0> E{gates, merged}; pg8::gemm_phase<pg8::EpiMerge<0>, pg8::StaticOrder, true, true>(lds, g, S, E, tid); }
        { PH_BEGIN; pg8::StaticOrder S; S.init(MT, DM, Gp, bidp); pg8::Gemm g{proj + 512, (const bf16_t*)WL(W_PB), MT, DM, 256, PJ}; pg8::EpiMerge<1> E{gates, merged}; pg8::gemm_phase<pg8::EpiMerge<1>, pg8::StaticOrder, true, true>(lds, g, S, E, tid); }
        { PH_BEGIN; pg8::StaticOrder S; S.init(MT, DM, Gp, bidp); pg8::Gemm g{proj + 1024, (const bf16_t*)WL(W_PC), MT, DM, 512, PJ}; pg8::EpiMerge<2> E{gates, merged}; pg8::gemm_phase<pg8::EpiMerge<2>, pg8::StaticOrder, true, true>(lds, g, S, E, tid); }
#endif
#endif
        GRID_BAR();
#ifndef NO_C2
        {
            PH_BEGIN;
            pg8::Gemm g{merged, (const bf16_t*)WL(W_O), MT, DM, DM, DM}; pg8::StaticOrder S; S.init(MT, DM, Gp, bidp);
#ifdef PROBE_C24
            { pg8::EpiResid E0{(l == 0) ? kin(0) : out, (float*)gates, xb2, ssqB}; pg8::gemm_phase<pg8::EpiResid, pg8::StaticOrder, true, true>(lds, g, S, E0, tid); }
#endif
            pg8::EpiResid E{(l == 0) ? kin(0) : out, out, xb2, ssqB};
            pg8::gemm_phase<pg8::EpiResid, pg8::StaticOrder, true, true>(lds, g, S, E, tid);
        }
#endif
        GRID_BAR();
#ifndef NO_C3
        {
            PH_BEGIN;
            pg8::Gemm g{xb2, (const bf16_t*)WL(W_FF), MT, 2 * FF, DM, DM}; pg8::StaticOrder S; S.init(MT, 2 * FF, Gp, bidp);
            pg8::EpiFfn1 E{hid, ssqB};
            pg8::gemm_phase<pg8::EpiFfn1, pg8::StaticOrder, true, true>(lds, g, S, E, tid);
#ifdef PROBE_C3
            pg8::gemm_phase<pg8::EpiFfn1, pg8::StaticOrder, true, true>(lds, g, S, E, tid);
#endif
        }
#endif
        GRID_BAR();
#ifndef NO_C4
        {
            PH_BEGIN;
            pg8::Gemm g{hid, (const bf16_t*)WL(W_DN), MT, DM, FF, FF}; pg8::StaticOrder S; S.init(MT, DM, Gp, bidp);
#ifdef PROBE_C24
            { pg8::EpiResid E0{out, (float*)proj, xb, ssqA}; pg8::gemm_phase<pg8::EpiResid, pg8::StaticOrder, true, true>(lds, g, S, E0, tid); }
#endif
            pg8::EpiResid E{out, out, xb, ssqA};
            pg8::gemm_phase<pg8::EpiResid, pg8::StaticOrder, true, true>(lds, g, S, E, tid);
        }
#endif
        if (l + 1 < NL) GRID_BAR();
    }
}
#undef WL
#undef GRID_BAR
#undef IS_T0
#undef PH_BEGIN
#undef ws
#undef out
#undef hid
#undef gates
#undef vt
#undef xb2
#undef proj
#undef merged
#undef xb
#undef sm
#undef agg
#undef ssqB
#undef ssqA
extern "C" void kernel_launch(void* const* d_in, const int* in_sizes, int n_in, void* d_out, int out_size, void* d_ws, size_t ws_size, hipStream_t stream) {
    static int grid = 0;
    if (grid == 0) {
        if (n_in != 31 || out_size != MT * DM || ws_size < WS_END) { fprintf(stderr, "kernel_launch: unexpected shapes (n_in %d out %d ws %zu)\n", n_in, out_size, ws_size); grid = -1; return; }
        int dev = 0, cus = 0, per_cu = 0;
        hipGetDevice(&dev); hipDeviceGetAttribute(&cus, hipDeviceAttributeMultiprocessorCount, dev);
        if (hipFuncSetAttribute((const void*)mega_fwd, hipFuncAttributeMaxDynamicSharedMemorySize, LDS_BYTES) != hipSuccess) { fprintf(stderr, "kernel_launch: hipFuncSetAttribute failed\n"); grid = -1; return; }
        if (hipOccupancyMaxActiveBlocksPerMultiprocessor(&per_cu, (const void*)mega_fwd, 512, LDS_BYTES) != hipSuccess || per_cu < 1) { fprintf(stderr, "kernel_launch: occupancy query says %d\n", per_cu); per_cu = 1; }
        (void)hipGetLastError();
        grid = cus;
    }
    if (grid < 0) return;
    if (hipMemsetAsync(d_ws, 0, CTL_ZERO_BYTES, stream) != hipSuccess) { fprintf(stderr, "kernel_launch: memset failed\n"); return; }
    Args a{};
    for (int i = 0; i < 31; ++i) a.in[i] = (const float*)d_in[i];
    a.out = (float*)d_out; a.ws = (unsigned char*)d_ws;
    void* args[] = {&a};
    hipError_t e = hipLaunchCooperativeKernel((const void*)mega_fwd, dim3(grid), dim3(512), args, LDS_BYTES, stream);
    if (e != hipSuccess) fprintf(stderr, "cooperative launch failed: %s (grid %d)\n", hipGetErrorString(e), grid);
}
```

```cpp
#include <hip/hip_runtime.h>
#include <hip/hip_cooperative_groups.h>
#include <hip/hip_bf16.h>
#include <cstdio>
#include <cstdint>
#include <cmath>
namespace cg = cooperative_groups;
namespace pg8 {
#define PG8_LAS __attribute__((address_space(3)))
typedef unsigned short bf16_t;
typedef short bf16x8 __attribute__((ext_vector_type(8)));
typedef float f32x4 __attribute__((ext_vector_type(4)));
typedef unsigned u32x4 __attribute__((ext_vector_type(4)));
constexpr int BM = 256, BK = 64, HALF = 128, HTB = HALF * BK * 2  , STAGE_BYTES = 8 * HTB, NXCD = 8, WGM = 4;

__host__ __device__ __forceinline__ int lds_byte(int r, int c) { const int st = (r >> 4) * 2 + (c >> 5), rr = r & 15, cc = c & 31, ob = rr * 64 + cc * 2; return st * 1024 + (ob ^ (((ob >> 9) & 1) << 5)); }
__host__ __device__ __forceinline__ void stage_rc(int b, int& R, int& C) { const int st = b / 1024, sb = b % 1024, swz = sb ^ (((sb >> 9) & 1) << 5); R = (st >> 1) * 16 + swz / 64; C = (st & 1) * 32 + (swz % 64) / 2; }
__host__ __device__ __forceinline__ int perm32(int rho) { const int n = rho >> 4, i = rho & 15; return 8 * (i >> 2) + 4 * n + (i & 3); }

struct Unit { int pm, pn; };
struct Gemm { const bf16_t* A; const bf16_t* Bt; int M, N, K, lda; };

struct StaticOrder {
    int nM, nN, nwg, G, c;
    __host__ __device__ void init(int M, int N, int G_, int c_) { nM = M / BM; nN = N / BM; nwg = nM * nN; G = G_; c = c_; }
    __host__ __device__ bool next(int i, Unit& u) const {
        const long L = (long)i * G + c; if (L >= nwg) return false;
        int wgid = (int)L; { const int q = nwg / NXCD, r = nwg % NXCD, xcd = wgid % NXCD, off = wgid / NXCD; wgid = (xcd < r ? xcd * (q + 1) : r * (q + 1) + (xcd - r) * q) + off; }
        const int nig = WGM * nN, gid = wgid / nig, fm = gid * WGM, gsz = (nM - fm) < WGM ? (nM - fm) : WGM;
        u.pm = fm + ((wgid % nig) % gsz); u.pn = (wgid % nig) / gsz; return true;
    }
    __device__ __forceinline__ void a_ready(const Unit&) const {}
    __device__ __forceinline__ void done(const Unit&) const {}
};

template <class Epi, class Sched, bool ALIGN_EPI = false, bool SP2 = false>
__device__ __forceinline__ void gemm_phase(PG8_LAS unsigned char* lds, const Gemm g, const Sched& S, const Epi& E, const int tid) {
    const int wid = __builtin_amdgcn_readfirstlane(tid >> 6), lane = tid & 63, wr = wid >> 2, wc = wid & 3, fr = lane & 15, fq = lane >> 4;
    const int K = g.K, nt = K / BK;
    unsigned voffA[2], voffB[2];
#pragma unroll
    for (int i = 0; i < 2; ++i) { int R, C; stage_rc(tid * 16 + i * 8192, R, C); const int Rb = Epi::PERM ? ((R & ~31) + perm32(R & 31)) : R;
        voffA[i] = (unsigned)(R * g.lda + C) * 2u; voffB[i] = (unsigned)(Rb * K + C) * 2u; }
    const size_t kstep = (size_t)(BK * 2);
    const size_t hstepA = (size_t)HALF * g.lda * 2, hstepB = (size_t)HALF * K * 2;
    const size_t tstepA = 2 * hstepA, tstepB = 2 * hstepB;
    const unsigned ldsw = (unsigned)wid * 1024u;
    const int aoff = lds_byte(wr * 64 + fr, fq * 8), boff = lds_byte(wc * 32 + fr, fq * 8);
#define PG8_SA(b, h) (((b) * 2 + (h)) * HTB)
#define PG8_SB(b, h) ((4 + (b) * 2 + (h)) * HTB)
#define PG8_STAGE(bufoff, gbase, voff) do { _Pragma("unroll") for (int _i = 0; _i < 2; ++_i) \
        __builtin_amdgcn_global_load_lds((const unsigned*)((const char*)(gbase) + (voff)[_i]), (PG8_LAS unsigned*)(lds + (bufoff) + ldsw + _i * 8192), 16, 0, 0); } while (0)
#define PG8_LDA(dst, b, h) do { _Pragma("unroll") for (int m = 0; m < 4; ++m) _Pragma("unroll") for (int k = 0; k < 2; ++k) dst[m][k] = *(const PG8_LAS bf16x8*)(lds + PG8_SA(b, h) + aoff + m * 2048 + k * 1024); } while (0)
#define PG8_LDB(dst, b, h) do { _Pragma("unroll") for (int n = 0; n < 2; ++n) _Pragma("unroll") for (int k = 0; k < 2; ++k) dst[n][k] = *(const PG8_LAS bf16x8*)(lds + PG8_SB(b, h) + boff + n * 2048 + k * 1024); } while (0)
#define PG8_MMA(ai, bj, At, Bt) do { __builtin_amdgcn_s_setprio(1); _Pragma("unroll") for (int m = 0; m < 4; ++m) _Pragma("unroll") for (int n = 0; n < 2; ++n) _Pragma("unroll") for (int k = 0; k < 2; ++k) \
        acc[ai][bj][m][n] = __builtin_amdgcn_mfma_f32_16x16x32_bf16(Bt[n][k], At[m][k], acc[ai][bj][m][n], 0, 0, 0); __builtin_amdgcn_s_setprio(0); } while (0)
#define PG8_WAIT_V(n) asm volatile("s_waitcnt vmcnt(" #n ")" ::: "memory")
#define PG8_WAIT_L(n) asm volatile("s_waitcnt lgkmcnt(" #n ")" ::: "memory")
#define PG8_BAR __builtin_amdgcn_s_barrier()
#define PG8_SCHED __builtin_amdgcn_sched_barrier(0)
    Unit cur, nxt; int ui = 0;
    if (!S.next(0, cur)) return;
    f32x4 acc[2][2][4][2];
#pragma unroll
    for (int a = 0; a < 2; ++a)
#pragma unroll
        for (int b = 0; b < 2; ++b)
#pragma unroll
            for (int m = 0; m < 4; ++m)
#pragma unroll
                for (int n = 0; n < 2; ++n) acc[a][b][m][n] = (f32x4){0.f, 0.f, 0.f, 0.f};
    bf16x8 At[4][2], B0[2][2], B1[2][2];
    const char* cA = (const char*)g.A + (size_t)cur.pm * tstepA; const char* cB = (const char*)g.Bt + (size_t)cur.pn * tstepB;
    S.a_ready(cur);
    if constexpr (SP2) {
        PG8_STAGE(PG8_SB(0, 0), cB, voffB); PG8_STAGE(PG8_SB(0, 1), cB + hstepB, voffB); PG8_STAGE(PG8_SA(0, 0), cA, voffA); PG8_STAGE(PG8_SA(0, 1), cA + hstepA, voffA);
        if (wr == 1) PG8_BAR;
        PG8_WAIT_V(2); PG8_BAR;
        PG8_STAGE(PG8_SB(1, 0), cB + kstep, voffB); PG8_STAGE(PG8_SA(1, 0), cA + kstep, voffA); PG8_STAGE(PG8_SB(1, 1), cB + hstepB + kstep, voffB);
        PG8_WAIT_V(6); PG8_BAR;
    } else {
        PG8_STAGE(PG8_SB(0, 0), cB, voffB); PG8_STAGE(PG8_SA(0, 0), cA, voffA); PG8_STAGE(PG8_SB(0, 1), cB + hstepB, voffB); PG8_STAGE(PG8_SA(0, 1), cA + hstepA, voffA);
        if (wr == 1) PG8_BAR;
        PG8_WAIT_V(4); PG8_BAR;
        PG8_STAGE(PG8_SB(1, 0), cB + kstep, voffB); PG8_STAGE(PG8_SA(1, 0), cA + kstep, voffA); PG8_STAGE(PG8_SB(1, 1), cB + hstepB + kstep, voffB);
        PG8_WAIT_V(6); PG8_BAR;
    }
    asm volatile(".p2align 8" ::: "memory");
    for (;;) {
        const bool has_next = S.next(ui + 1, nxt);
        const char* nA = has_next ? (const char*)g.A + (size_t)nxt.pm * tstepA : cA; const char* nB = has_next ? (const char*)g.Bt + (size_t)nxt.pn * tstepB : cB;
        for (int t = 0; t < nt; t += 2) {
            const bool last = (t == nt - 2);
            const char* a1 = cA + (size_t)(t + 1) * kstep;
            const char* a2 = last ? nA : cA + (size_t)(t + 2) * kstep; const char* b2 = last ? nB : cB + (size_t)(t + 2) * kstep;
            const char* a3 = a2 + kstep; const char* b3 = b2 + kstep;
            if (last && has_next) S.a_ready(nxt);
            if constexpr (SP2) {
            PG8_LDB(B0, 0, 0); PG8_LDB(B1, 0, 1); PG8_SCHED; PG8_LDA(At, 0, 0); PG8_STAGE(PG8_SA(1, 1), a1 + hstepA, voffA);
            PG8_WAIT_V(8); PG8_WAIT_L(0); PG8_BAR; PG8_MMA(0, 0, At, B0); PG8_MMA(0, 1, At, B1); PG8_BAR; PG8_SCHED;
            PG8_LDA(At, 0, 1); PG8_STAGE(PG8_SB(0, 0), b2, voffB); PG8_STAGE(PG8_SB(0, 1), b2 + hstepB, voffB); PG8_STAGE(PG8_SA(0, 0), a2, voffA);
            PG8_WAIT_V(8); PG8_WAIT_L(0); PG8_BAR; PG8_MMA(1, 0, At, B0); PG8_MMA(1, 1, At, B1); PG8_BAR; PG8_SCHED;
            PG8_LDB(B0, 1, 0); PG8_LDB(B1, 1, 1); PG8_SCHED; PG8_LDA(At, 1, 0); PG8_STAGE(PG8_SA(0, 1), a2 + hstepA, voffA);
            PG8_WAIT_V(8); PG8_WAIT_L(0); PG8_BAR; PG8_MMA(0, 0, At, B0); PG8_MMA(0, 1, At, B1); PG8_BAR; PG8_SCHED;
            PG8_LDA(At, 1, 1); PG8_STAGE(PG8_SB(1, 0), b3, voffB); PG8_STAGE(PG8_SB(1, 1), b3 + hstepB, voffB); PG8_STAGE(PG8_SA(1, 0), a3, voffA);
            PG8_WAIT_V(8); PG8_WAIT_L(0); PG8_BAR; PG8_MMA(1, 0, At, B0); PG8_MMA(1, 1, At, B1); PG8_BAR; PG8_SCHED;
            } else {
            PG8_LDB(B0, 0, 0); PG8_SCHED; PG8_LDA(At, 0, 0); PG8_STAGE(PG8_SA(1, 1), a1 + hstepA, voffA);
            PG8_WAIT_L(8); PG8_BAR; PG8_WAIT_L(0); PG8_MMA(0, 0, At, B0); PG8_BAR; PG8_SCHED;
            PG8_LDB(B1, 0, 1); PG8_STAGE(PG8_SB(0, 0), b2, voffB);
            PG8_BAR; PG8_WAIT_L(0); PG8_MMA(0, 1, At, B1); PG8_BAR;
            PG8_LDA(At, 0, 1); PG8_STAGE(PG8_SA(0, 0), a2, voffA);
            PG8_BAR; PG8_WAIT_L(0); PG8_MMA(1, 0, At, B0); PG8_BAR; PG8_SCHED;
            PG8_STAGE(PG8_SB(0, 1), b2 + hstepB, voffB);
            PG8_WAIT_V(6); PG8_BAR; PG8_MMA(1, 1, At, B1); PG8_BAR;
            PG8_LDB(B0, 1, 0); PG8_SCHED; PG8_LDA(At, 1, 0); PG8_STAGE(PG8_SA(0, 1), a2 + hstepA, voffA);
            PG8_WAIT_L(8); PG8_BAR; PG8_WAIT_L(0); PG8_MMA(0, 0, At, B0); PG8_BAR; PG8_SCHED;
            PG8_LDB(B1, 1, 1); PG8_STAGE(PG8_SB(1, 0), b3, voffB);
            PG8_BAR; PG8_WAIT_L(0); PG8_MMA(0, 1, At, B1); PG8_BAR;
            PG8_LDA(At, 1, 1); PG8_STAGE(PG8_SA(1, 0), a3, voffA);
            PG8_BAR; PG8_WAIT_L(0); PG8_MMA(1, 0, At, B0); PG8_BAR; PG8_SCHED;
            PG8_STAGE(PG8_SB(1, 1), b3 + hstepB, voffB);
            PG8_WAIT_V(6); PG8_BAR; PG8_MMA(1, 1, At, B1); PG8_BAR;
            }
        }
        if constexpr (ALIGN_EPI) { if (wr == 0) PG8_BAR; }
        if constexpr (!Epi::AFTER_DRAIN) { int l2_; asm volatile("v_mbcnt_lo_u32_b32 %0, -1, 0\n\tv_mbcnt_hi_u32_b32 %0, -1, %0" : "=v"(l2_)); E(acc, cur, wr, wc, l2_ & 15, l2_ >> 4); S.done(cur); }
        if (!has_next) break;
#pragma unroll
        for (int a = 0; a < 2; ++a)
#pragma unroll
            for (int b = 0; b < 2; ++b)
#pragma unroll
                for (int m = 0; m < 4; ++m)
#pragma unroll
                    for (int n = 0; n < 2; ++n) acc[a][b][m][n] = (f32x4){0.f, 0.f, 0.f, 0.f};
        cur = nxt; cA = nA; cB = nB; ++ui;
        if constexpr (ALIGN_EPI) { if (wr == 1) PG8_BAR; }
    }
    PG8_WAIT_V(0);
    if constexpr (!ALIGN_EPI) { if (wr == 0) PG8_BAR; }
    PG8_BAR;
    if constexpr (Epi::AFTER_DRAIN) { E.fused(acc, cur, wr, wc, fr, fq, lds, wid, lane); S.done(cur); }
#undef PG8_SA
#undef PG8_SB
#undef PG8_STAGE
#undef PG8_LDA
#undef PG8_LDB
#undef PG8_MMA
#undef PG8_WAIT_V
#undef PG8_WAIT_L
#undef PG8_BAR
#undef PG8_SCHED
}
}

#define LAS __attribute__((address_space(3)))
typedef unsigned short bf16_t;
typedef short bf16x8 __attribute__((ext_vector_type(8)));
typedef float f32x4 __attribute__((ext_vector_type(4)));
typedef float f32x2 __attribute__((ext_vector_type(2)));
typedef float f32x16 __attribute__((ext_vector_type(16)));
typedef unsigned u32x4 __attribute__((ext_vector_type(4)));
typedef unsigned u32x2 __attribute__((ext_vector_type(2)));
typedef __bf16 bf16x2_t __attribute__((ext_vector_type(2)));

constexpr int NB = 2, SEQ = 16384, DM = 1024, NL = 4, MT = NB * SEQ;
constexpr int INC = 5632, PJ = 2048, GP = 3072, FF = 2816;
constexpr float EPS = 1e-6f, LOG2E = 1.4426950408889634f;
constexpr size_t MiB = 1u << 20;
constexpr size_t WS_SSQA = 1 * MiB, WS_SSQB = 3 * MiB, WS_AGG = 5 * MiB, WS_SMALL = 6 * MiB;
constexpr size_t WS_W0 = 8 * MiB, WS_WSZ = 32 * MiB;
constexpr size_t WS_XB = 72 * MiB, WS_PROJ = 136 * MiB, WS_VT = 264 * MiB, WS_GATES = 296 * MiB, WS_END = 488 * MiB;
constexpr size_t W_IN = 0, W_PA = 11 * MiB, W_PB = W_PA + MiB / 2, W_PC = 12 * MiB, W_O = 13 * MiB, W_FF = 15 * MiB, W_DN = 26 * MiB;
constexpr int SMALL_PER_LAYER = 16384 + 16384 + 65536;
constexpr int LDS_BYTES = 147456, MISC_OFF = 131072 + 320;
constexpr int CW_BAR = 4096; constexpr size_t CTL_ZERO_BYTES = 65536;

__device__ __forceinline__ unsigned pk2(float lo, float hi) { f32x2 v = {lo, hi}; bf16x2_t b = __builtin_convertvector(v, bf16x2_t); return __builtin_bit_cast(unsigned, b); }
__device__ __forceinline__ bf16_t f2bf(float f) { unsigned u = __builtin_bit_cast(unsigned, f); return (bf16_t)((u + 0x7fffu + ((u >> 16) & 1u)) >> 16); }
__device__ __forceinline__ float bf2f(bf16_t b) { return __builtin_bit_cast(float, (unsigned)b << 16); }
__device__ __forceinline__ float bflo(unsigned w) { return __builtin_bit_cast(float, w << 16); }
__device__ __forceinline__ float bfhi(unsigned w) { return __builtin_bit_cast(float, w & 0xffff0000u); }
__device__ __forceinline__ float fsigmoid(float x) { return __builtin_amdgcn_rcpf(1.f + __builtin_amdgcn_exp2f(-x * LOG2E)); }
__device__ __forceinline__ float shx(float v, int mask, int lane) { return __builtin_bit_cast(float, __builtin_amdgcn_ds_bpermute((lane ^ mask) << 2, __builtin_bit_cast(int, v))); }
__device__ __forceinline__ float wave_sum(float v, int lane) {
#pragma unroll
    for (int o = 1; o < 64; o <<= 1) v += shx(v, o, lane);
    return v;
}
__device__ __forceinline__ int crow(int r, int hi) { return (r & 3) + 8 * (r >> 2) + 4 * hi; }
#define MFMA32(a, b, c) __builtin_amdgcn_mfma_f32_32x32x16_bf16((a), (b), (c), 0, 0, 0)
__device__ __forceinline__ bf16x8 pack8(float a0, float a1, float a2, float a3, float a4, float a5, float a6, float a7) {
    u32x4 p; p.x = pk2(a0, a1); p.y = pk2(a2, a3); p.z = pk2(a4, a5); p.w = pk2(a6, a7); return __builtin_bit_cast(bf16x8, p);
}

namespace pg8 {
__device__ __forceinline__ float row_rstd(const float* ssq, int r) {
    const f32x4* p = (const f32x4*)(ssq + (size_t)r * 16);
    const f32x4 a = p[0], b = p[1], c = p[2], d = p[3];
    const float s = ((a[0] + a[1]) + (a[2] + a[3])) + ((b[0] + b[1]) + (b[2] + b[3])) + ((c[0] + c[1]) + (c[2] + c[3])) + ((d[0] + d[1]) + (d[2] + d[3]));
    return __builtin_amdgcn_rsqf(s * (1.f / 1024.f) + EPS);
}
__device__ __forceinline__ u32x4 pack_f8(const f32x4 v0, const f32x4 v1) { u32x4 w; w.x = pk2(v0[0], v0[1]); w.y = pk2(v0[2], v0[3]); w.z = pk2(v1[0], v1[1]); w.w = pk2(v1[2], v1[3]); return w; }

struct EpiInProj {
    static constexpr bool PERM = true, AFTER_DRAIN = false;
    bf16_t* proj; bf16_t* vt; bf16_t* gates; const float* ssq; const float* bgate; const float* qg; const float* kg;
    __device__ __forceinline__ void operator()(const f32x4 (&acc)[2][2][4][2], const Unit& u, int wr, int wc, int fr, int fq) const {
        const int row0 = u.pm * BM + wr * 64 + fr, cin = wc * 32 + 8 * fq;
        if (u.pn >= 4 && u.pn < 8) {
            const int G = 4 * (u.pn - 4) + wc, ln_ = fr | (fq << 4); const bool isq = u.pn < 6;
            const float* gp = (isq ? qg : kg) + 8 * fq; const float gs = isq ? (0.125f * LOG2E) : 1.f;
            const f32x4 g00 = *(const f32x4*)gp * gs, g01 = *(const f32x4*)(gp + 4) * gs, g10 = *(const f32x4*)(gp + 32) * gs, g11 = *(const f32x4*)(gp + 36) * gs;
#pragma unroll
            for (int ai = 0; ai < 2; ++ai)
#pragma unroll
                for (int m = 0; m < 4; ++m) { const int r = row0 + ai * HALF + m * 16; const float rs = row_rstd(ssq, r); bf16_t* rowp = proj + (size_t)r * PJ + 1024 + 64 * G + 8 * fq;
                    f32x4 a0 = acc[ai][0][m][0] * rs, a1 = acc[ai][0][m][1] * rs, b0 = acc[ai][1][m][0] * rs, b1 = acc[ai][1][m][1] * rs;
                    float ss = (a0[0] * a0[0] + a0[1] * a0[1]) + (a0[2] * a0[2] + a0[3] * a0[3]) + (a1[0] * a1[0] + a1[1] * a1[1]) + (a1[2] * a1[2] + a1[3] * a1[3])
                             + (b0[0] * b0[0] + b0[1] * b0[1]) + (b0[2] * b0[2] + b0[3] * b0[3]) + (b1[0] * b1[0] + b1[1] * b1[1]) + (b1[2] * b1[2] + b1[3] * b1[3]);
                    ss += shx(ss, 16, ln_); ss += shx(ss, 32, ln_);
                    const float rq = __builtin_amdgcn_rsqf(ss * (1.f / 64.f) + EPS);
                    *(u32x4*)rowp = pack_f8(a0 * (g00 * rq), a1 * (g01 * rq)); *(u32x4*)(rowp + 32) = pack_f8(b0 * (g10 * rq), b1 * (g11 * rq)); }
        } else if (u.pn < 8) {
#pragma unroll
            for (int ai = 0; ai < 2; ++ai)
#pragma unroll
                for (int m = 0; m < 4; ++m) { const int r = row0 + ai * HALF + m * 16; const float rs = row_rstd(ssq, r); bf16_t* rowp = proj + (size_t)r * PJ + u.pn * BM + cin;
#pragma unroll
                    for (int bj = 0; bj < 2; ++bj) *(u32x4*)(rowp + bj * HALF) = pack_f8(acc[ai][bj][m][0] * rs, acc[ai][bj][m][1] * rs); }
        } else if (u.pn < 10) {
#pragma unroll
            for (int ai = 0; ai < 2; ++ai)
#pragma unroll
                for (int m = 0; m < 4; ++m) { const int r = row0 + ai * HALF + m * 16; const float rs = row_rstd(ssq, r);
                    const int b = r >> 14, s = r & (SEQ - 1), ko = s & 15, gq = ko >> 2, sg = (gq == 1) ? 2 : ((gq == 2) ? 1 : gq), slot = (s & ~15) | (sg * 4 + (ko & 3));
#pragma unroll
                    for (int bj = 0; bj < 2; ++bj) { const int head = (u.pn - 8) * 2 + bj; bf16_t* base = vt + ((size_t)((b * 4 + head) * 128 + cin)) * SEQ + slot;
                        const f32x4 v0 = acc[ai][bj][m][0] * rs, v1 = acc[ai][bj][m][1] * rs;
                        base[0] = f2bf(v0[0]); base[(size_t)SEQ] = f2bf(v0[1]); base[(size_t)2 * SEQ] = f2bf(v0[2]); base[(size_t)3 * SEQ] = f2bf(v0[3]);
                        base[(size_t)4 * SEQ] = f2bf(v1[0]); base[(size_t)5 * SEQ] = f2bf(v1[1]); base[(size_t)6 * SEQ] = f2bf(v1[2]); base[(size_t)7 * SEQ] = f2bf(v1[3]); } }
        } else {
            const int colg = (u.pn - 10) * BM + cin;
            f32x4 bv[2][2];
#pragma unroll
            for (int bj = 0; bj < 2; ++bj) { bv[bj][0] = *(const f32x4*)(bgate + colg + bj * HALF); bv[bj][1] = *(const f32x4*)(bgate + colg + bj * HALF + 4); }
#pragma unroll
            for (int ai = 0; ai < 2; ++ai)
#pragma unroll
                for (int m = 0; m < 4; ++m) { const int r = row0 + ai * HALF + m * 16; const float rs = row_rstd(ssq, r); unsigned char* rowp = (unsigned char*)gates + (size_t)r * GP + colg;
#pragma unroll
                    for (int bj = 0; bj < 2; ++bj) { const f32x4 v0 = acc[ai][bj][m][0] * rs + bv[bj][0], v1 = acc[ai][bj][m][1] * rs + bv[bj][1];
                        unsigned w0 = 0u, w1 = 0u;
#pragma unroll
                        for (int e = 0; e < 4; ++e) { w0 |= (unsigned)(fsigmoid(v0[e]) * 255.f + 0.5f) << (8 * e); w1 |= (unsigned)(fsigmoid(v1[e]) * 255.f + 0.5f) << (8 * e); }
                        u32x2 w; w.x = w0; w.y = w1; *(u32x2*)(rowp + bj * HALF) = w; } }
        }
    }
};
template <int BR> struct EpiMerge {
    static constexpr bool PERM = true, AFTER_DRAIN = false;
    const bf16_t* gates; bf16_t* merged;
    __device__ __forceinline__ void operator()(const f32x4 (&acc)[2][2][4][2], const Unit& u, int wr, int wc, int fr, int fq) const {
        const int row0 = u.pm * BM + wr * 64 + fr, cin = wc * 32 + 8 * fq;
#pragma unroll
        for (int ai = 0; ai < 2; ++ai) {
            u32x2 gv[4][2]; u32x4 pv[4][2];
#pragma unroll
            for (int m = 0; m < 4; ++m)
#pragma unroll
                for (int bj = 0; bj < 2; ++bj) { const int r = row0 + ai * HALF + m * 16, col = u.pn * BM + bj * HALF + cin;
                    gv[m][bj] = *(const u32x2*)((const unsigned char*)gates + (size_t)r * GP + BR * 1024 + col);
                    if (BR > 0) pv[m][bj] = *(const u32x4*)(merged + (size_t)r * DM + col); }
#pragma unroll
            for (int m = 0; m < 4; ++m)
#pragma unroll
                for (int bj = 0; bj < 2; ++bj) { const int r = row0 + ai * HALF + m * 16, col = u.pn * BM + bj * HALF + cin;
                    const u32x2 g = gv[m][bj];
                    f32x4 o0 = {0.f, 0.f, 0.f, 0.f}, o1 = {0.f, 0.f, 0.f, 0.f};
                    if (BR > 0) { const u32x4 p = pv[m][bj]; o0 = (f32x4){bflo(p.x), bfhi(p.x), bflo(p.y), bfhi(p.y)}; o1 = (f32x4){bflo(p.z), bfhi(p.z), bflo(p.w), bfhi(p.w)}; }
                    const float k255 = 1.f / 255.f;
                    const f32x4 g0 = {(float)(g.x & 255u) * k255, (float)((g.x >> 8) & 255u) * k255, (float)((g.x >> 16) & 255u) * k255, (float)(g.x >> 24) * k255};
                    const f32x4 g1 = {(float)(g.y & 255u) * k255, (float)((g.y >> 8) & 255u) * k255, (float)((g.y >> 16) & 255u) * k255, (float)(g.y >> 24) * k255};
                    o0 += g0 * acc[ai][bj][m][0]; o1 += g1 * acc[ai][bj][m][1];
                    *(u32x4*)(merged + (size_t)r * DM + col) = pack_f8(o0, o1); }
            asm volatile("" ::: "memory"); }
    }
};
struct EpiResid {
    static constexpr bool PERM = true, AFTER_DRAIN = false;
    const float* x32; const bf16_t* x16; float* o32; bf16_t* oa; bf16_t* ob; float* ssq;
    __device__ __forceinline__ void operator()(const f32x4 (&acc)[2][2][4][2], const Unit& u, int wr, int wc, int fr, int fq) const {
        const int row0 = u.pm * BM + wr * 64 + fr, cin = wc * 32 + 8 * fq;
#pragma unroll
        for (int ai = 0; ai < 2; ++ai)
#pragma unroll
            for (int m = 0; m < 4; ++m) { const int r = row0 + ai * HALF + m * 16; float ss = 0.f;
#pragma unroll
                for (int bj = 0; bj < 2; ++bj) { const size_t off = (size_t)r * DM + u.pn * BM + bj * HALF + cin;
                    f32x4 x0, x1;
                    if (x32) { x0 = *(const f32x4*)(x32 + off); x1 = *(const f32x4*)(x32 + off + 4); }
                    else { const u32x4 p = *(const u32x4*)(x16 + off); x0 = (f32x4){bflo(p.x), bfhi(p.x), bflo(p.y), bfhi(p.y)}; x1 = (f32x4){bflo(p.z), bfhi(p.z), bflo(p.w), bfhi(p.w)}; }
                    x0 += acc[ai][bj][m][0]; x1 += acc[ai][bj][m][1];
                    if (o32) { *(f32x4*)(o32 + off) = x0; *(f32x4*)(o32 + off + 4) = x1; }
                    const u32x4 pk = pack_f8(x0, x1);
                    if (oa) *(u32x4*)(oa + off) = pk;
                    if (ob) *(u32x4*)(ob + off) = pk;
                    ss += (x0[0] * x0[0] + x0[1] * x0[1]) + (x0[2] * x0[2] + x0[3] * x0[3]) + (x1[0] * x1[0] + x1[1] * x1[1]) + (x1[2] * x1[2] + x1[3] * x1[3]); }
                { const int ln_ = fr | (fq << 4); ss += shx(ss, 16, ln_); ss += shx(ss, 32, ln_); }
                if (fq == 0) ssq[(size_t)r * 16 + u.pn * 4 + wc] = ss;
                asm volatile("" ::: "memory"); }
    }
};
struct EpiFfn1 {
    static constexpr bool PERM = true, AFTER_DRAIN = false;
    bf16_t* hid; const float* ssq;
    __device__ __forceinline__ void operator()(const f32x4 (&acc)[2][2][4][2], const Unit& u, int wr, int wc, int fr, int fq) const {
        const int row0 = u.pm * BM + wr * 64 + fr, cin = wc * 32 + 8 * fq;
#pragma unroll
        for (int ai = 0; ai < 2; ++ai)
#pragma unroll
            for (int m = 0; m < 4; ++m) { const int r = row0 + ai * HALF + m * 16; const float rs = row_rstd(ssq, r);
                f32x4 o[2];
#pragma unroll
                for (int n = 0; n < 2; ++n) { const f32x4 g = acc[ai][0][m][n] * rs, up = acc[ai][1][m][n] * rs;
#pragma unroll
                    for (int e = 0; e < 4; ++e) o[n][e] = g[e] * fsigmoid(g[e]) * up[e]; }
                *(u32x4*)(hid + (size_t)r * FF + u.pn * HALF + cin) = pack_f8(o[0], o[1]);
                asm volatile("" ::: "memory"); }
    }
};
}

#define XB_TMO      128
#define XB_XCNT(j)  (256  + 64 * (j))
#define XB_XSUB(j)  (1280 + 64 * (j))
#define XB_XGEN(j)  (2304 + 64 * (j))
#define XB_TOP      3328
#define XB_TOPGEN   3392
#define XCD_BAR_WORDS 3456
#define XB_SPIN_CAP (1u << 18)

__device__ __forceinline__ unsigned xb_ld(unsigned* p)              { return __hip_atomic_load(p, __ATOMIC_RELAXED, __HIP_MEMORY_SCOPE_AGENT); }
__device__ __forceinline__ unsigned xb_add(unsigned* p, unsigned v) { return __hip_atomic_fetch_add(p, v, __ATOMIC_RELAXED, __HIP_MEMORY_SCOPE_AGENT); }
__device__ __forceinline__ unsigned xb_xcc_id() { return (unsigned)__builtin_amdgcn_s_getreg((3 << 11) | 20) & 0xFu; }
#define XB_SPIN(cond, bar) do { unsigned _sp = 0; while (cond) { __builtin_amdgcn_s_sleep(1); \
    if ((++_sp & 255u) == 0u) { if (xb_ld(&(bar)[XB_TMO])) break; if (_sp > XB_SPIN_CAP) { atomicAdd(&(bar)[XB_TMO], 1u); break; } } } } while (0)

struct XcdBarrier {
    unsigned* bar; unsigned x;
    volatile LAS unsigned* st;
};

__device__ __forceinline__ XcdBarrier xcd_barrier_post(unsigned* bar, volatile LAS unsigned* st, bool is0) {
    XcdBarrier b; b.bar = bar; b.x = xb_xcc_id(); b.st = st;
    if (is0) (void)xb_add(&bar[XB_XCNT(b.x)], 1u);
    return b;
}
__device__ __forceinline__ void xcd_barrier_complete(unsigned* bar, unsigned x, unsigned& nloc, unsigned& nx) {
    const unsigned G = gridDim.x * gridDim.y * gridDim.z;
    unsigned sum, cnt, mine, sp = 0u;
    for (;;) {
        sum = 0u; cnt = 0u; mine = 0u;
#pragma unroll
        for (unsigned j = 0; j < 16; ++j) { const unsigned c = xb_ld(&bar[XB_XCNT(j)]); sum += c; cnt += (c > 0u) ? 1u : 0u; mine = (j == x) ? c : mine; }
        if (sum == G) break;
        __builtin_amdgcn_s_sleep(1);
        if ((++sp & 255u) == 0u) { if (xb_ld(&bar[XB_TMO])) break; if (sp > XB_SPIN_CAP) { atomicAdd(&bar[XB_TMO], 1u); break; } }
    }
    nloc = mine > 0u ? mine : 1u; nx = cnt > 0u ? cnt : 1u;
}

__device__ __forceinline__ void xcd_barrier(const XcdBarrier& b, bool is0) {
    asm volatile("s_waitcnt vmcnt(0)" ::: "memory");
    __syncthreads();
    if (is0) {
        unsigned* bar = b.bar;
        __builtin_amdgcn_s_waitcnt(0);
        unsigned nloc = b.st[0], nx = b.st[1];
        if (nloc == 0u) { xcd_barrier_complete(bar, b.x, nloc, nx); b.st[0] = nloc; b.st[1] = nx; }
        const unsigned old = xb_add(&bar[XB_XSUB(b.x)], 1u);
        const unsigned gen = old / nloc;
        if (old + 1u == (gen + 1u) * nloc) {
            __builtin_amdgcn_fence(__ATOMIC_RELEASE, "agent");
            asm volatile("s_waitcnt vmcnt(0)" ::: "memory");
            const unsigned og = xb_add(&bar[XB_TOP], 1u);
            const unsigned tg = og / nx;
            if (og + 1u == (tg + 1u) * nx) xb_add(&bar[XB_TOPGEN], 1u);
            else XB_SPIN(xb_ld(&bar[XB_TOPGEN]) == tg, bar);
            __builtin_amdgcn_fence(__ATOMIC_ACQUIRE, "agent");
            xb_add(&bar[XB_XGEN(b.x)], 1u);
            asm volatile("s_waitcnt vmcnt(0)" ::: "memory");
        } else {
            XB_SPIN(xb_ld(&bar[XB_XGEN(b.x)]) == gen, bar);
            __builtin_amdgcn_fence(__ATOMIC_ACQUIRE, "agent");
            asm volatile("s_waitcnt vmcnt(0)" ::: "memory");
        }
    }
    __syncthreads();
}


struct Args { const float* in[31]; float* out; unsigned char* ws; };
typedef const float* cfptr_t;
__device__ __forceinline__ cfptr_t kin(int i) { const volatile __attribute__((address_space(4))) cfptr_t* p = (const volatile __attribute__((address_space(4))) cfptr_t*)__builtin_amdgcn_kernarg_segment_ptr(); return p[i]; }

struct ConvD { const float* W; const float* gain; bf16_t* dst; int N, k0, n0, ldk, split; };
__device__ __forceinline__ void conv_load(const ConvD& d, LAS float* scr, int tid) {
    const int n4 = tid & 15, kk = tid >> 4;
#pragma unroll
    for (int i = 0; i < 2; ++i) { const int k = kk + 32 * i; f32x4 v = *(const f32x4*)(d.W + (size_t)(d.k0 + k) * d.N + d.n0 + 4 * n4); if (d.gain) v *= d.gain[d.k0 + k];
        LAS float* s = scr + k * 65 + 4 * n4; s[0] = v[0]; s[1] = v[1]; s[2] = v[2]; s[3] = v[3]; }
}
__device__ __forceinline__ void conv_store(const ConvD& d, const LAS float* scr, int tid) {
    const int nn = tid >> 3, c = tid & 7;
    const LAS float* s = scr + (8 * c) * 65 + nn;
    u32x4 o; o.x = pk2(s[0], s[65]); o.y = pk2(s[130], s[195]); o.z = pk2(s[260], s[325]); o.w = pk2(s[390], s[455]);
    *(u32x4*)(d.dst + (size_t)((d.split && nn >= 32) ? nn + 96 : nn) * d.ldk + d.k0 + 8 * c) = o;
}
__device__ __forceinline__ ConvD conv_desc(int it, int l, unsigned char* Wb) {
    ConvD d; d.gain = nullptr; d.split = 0; int r = it;
    if (r < 1408) { const int kb = r / 88, nb = r % 88; const bool qk = (nb >= 16 && nb < 32); const int brow = qk ? (256 * (4 + ((nb - 16) >> 2)) + 32 * ((nb - 16) & 3)) : nb * 64;
        d.W = kin(2) + (size_t)l * DM * INC; d.N = INC; d.k0 = kb * 64; d.n0 = nb * 64; d.dst = (bf16_t*)(Wb + W_IN) + (size_t)brow * DM; d.ldk = DM; d.gain = kin(1) + l * DM; d.split = qk; return d; } r -= 1408;
    if (r < 64) { const int kb = r / 16, nb = r % 16; d.W = kin(23) + (size_t)l * 256 * DM; d.N = DM; d.k0 = kb * 64; d.n0 = nb * 64; d.dst = (bf16_t*)(Wb + W_PA) + (size_t)nb * 64 * 256; d.ldk = 256; return d; } r -= 64;
    if (r < 64) { const int kb = r / 16, nb = r % 16; d.W = kin(24) + (size_t)l * 256 * DM; d.N = DM; d.k0 = kb * 64; d.n0 = nb * 64; d.dst = (bf16_t*)(Wb + W_PB) + (size_t)nb * 64 * 256; d.ldk = 256; return d; } r -= 64;
    if (r < 128) { const int kb = r / 16, nb = r % 16; d.W = kin(25) + (size_t)l * 512 * DM; d.N = DM; d.k0 = kb * 64; d.n0 = nb * 64; d.dst = (bf16_t*)(Wb + W_PC) + (size_t)nb * 64 * 512; d.ldk = 512; return d; } r -= 128;
    if (r < 256) { const int kb = r / 16, nb = r % 16; d.W = kin(26) + (size_t)l * DM * DM; d.N = DM; d.k0 = kb * 64; d.n0 = nb * 64; d.dst = (bf16_t*)(Wb + W_O) + (size_t)nb * 64 * DM; d.ldk = DM; return d; } r -= 256;
    if (r < 704) { const int kb = r / 44, nb = r % 44; d.W = kin(28) + (size_t)l * DM * FF; d.N = FF; d.k0 = kb * 64; d.n0 = nb * 64; d.dst = (bf16_t*)(Wb + W_FF) + (size_t)(256 * (nb >> 1) + 64 * (nb & 1)) * DM; d.ldk = DM; d.gain = kin(27) + l * DM; return d; } r -= 704;
    if (r < 704) { const int kb = r / 44, nb = r % 44; d.W = kin(29) + (size_t)l * DM * FF; d.N = FF; d.k0 = kb * 64; d.n0 = nb * 64; d.dst = (bf16_t*)(Wb + W_FF) + (size_t)(256 * (nb >> 1) + 128 + 64 * (nb & 1)) * DM; d.ldk = DM; d.gain = kin(27) + l * DM; return d; } r -= 704;
    { const int kb = r / 16, nb = r % 16; d.W = kin(30) + (size_t)l * FF * DM; d.N = DM; d.k0 = kb * 64; d.n0 = nb * 64; d.dst = (bf16_t*)(Wb + W_DN) + (size_t)nb * 64 * FF; d.ldk = FF; return d; }
}
__device__ __forceinline__ void convert_layer(int l, unsigned char* Wb, LAS float* scr, int tid, int bid, int G) {
    for (int it = bid; it < 4032; it += 6 * G) {
        const ConvD d0 = conv_desc(it, l, Wb);
        const bool v1 = it + G < 4032, v2 = it + 2 * G < 4032, v3 = it + 3 * G < 4032, v4 = it + 4 * G < 4032, v5 = it + 5 * G < 4032;
        const ConvD d1 = conv_desc(v1 ? it + G : it, l, Wb), d2 = conv_desc(v2 ? it + 2 * G : it, l, Wb), d3 = conv_desc(v3 ? it + 3 * G : it, l, Wb), d4 = conv_desc(v4 ? it + 4 * G : it, l, Wb), d5 = conv_desc(v5 ? it + 5 * G : it, l, Wb);
        conv_load(d0, scr, tid); if (v1) conv_load(d1, scr + 4160, tid); if (v2) conv_load(d2, scr + 2 * 4160, tid); if (v3) conv_load(d3, scr + 3 * 4160, tid); if (v4) conv_load(d4, scr + 4 * 4160, tid); if (v5) conv_load(d5, scr + 5 * 4160, tid);
        __syncthreads();
        conv_store(d0, scr, tid); if (v1) conv_store(d1, scr + 4160, tid); if (v2) conv_store(d2, scr + 2 * 4160, tid); if (v3) conv_store(d3, scr + 3 * 4160, tid); if (v4) conv_store(d4, scr + 4 * 4160, tid); if (v5) conv_store(d5, scr + 5 * 4160, tid);
        __syncthreads();
    }
}
__device__ __forceinline__ void convert_small(bf16_t* sm, int tid, int bid, int G) {
    for (int idx = bid * 512 + tid; idx < NL * SMALL_PER_LAYER; idx += G * 512) {
        const int l = idx / SMALL_PER_LAYER, e = idx % SMALL_PER_LAYER; float v;
        if (e < 32768) { const int e2 = e & 16383, hd = e2 >> 12, o = (e2 >> 6) & 63, i = e2 & 63; const float* src = (e < 16384) ? kin(6) : kin(8); v = src[(size_t)((l * 4 + hd) * 64 + i) * 64 + o]; }
        else { const int e2 = e - 32768, t = (e2 >> 7) & 127, s = e2 & 127; v = (s <= t) ? kin(13)[(size_t)l * 65536 + e2] : 0.f; }
        sm[idx] = f2bf(v);
    }
}
__device__ __forceinline__ void x_pass(const float* x, bf16_t* xb, float* ssq, int lane, int gw, int NGW) {
    for (int m0 = gw; m0 < MT; m0 += 4 * NGW) {
        f32x4 v[4][4];
#pragma unroll
        for (int q = 0; q < 4; ++q) { const int m = m0 + q * NGW; const f32x4* xr = (const f32x4*)(x + (size_t)(m < MT ? m : m0) * DM) + lane;
#pragma unroll
            for (int j = 0; j < 4; ++j) v[q][j] = xr[64 * j]; }
#pragma unroll
        for (int q = 0; q < 4; ++q) { const int m = m0 + q * NGW; if (m >= MT) break;
            u32x2* o = (u32x2*)(xb + (size_t)m * DM) + lane; float ss = 0.f;
#pragma unroll
            for (int j = 0; j < 4; ++j) { const f32x4 t = v[q][j]; ss += (t[0] * t[0] + t[1] * t[1]) + (t[2] * t[2] + t[3] * t[3]); u32x2 w; w.x = pk2(t[0], t[1]); w.y = pk2(t[2], t[3]); o[64 * j] = w; }
            ss = wave_sum(ss, lane);
            if (lane < 16) ssq[(size_t)m * 16 + lane] = (lane == 0) ? ss : 0.f; }
    }
}
__device__ __forceinline__ void qk_norm(bf16_t* proj, bf16_t* outp, int opitch, const float* qg, const float* kg, int lane, int gw, int NGW) {
    const int d0 = (lane * 8) & 63; float gq[8], gk[8];
#pragma unroll
    for (int e = 0; e < 8; ++e) { gq[e] = qg[d0 + e] * (0.125f * LOG2E); gk[e] = kg[d0 + e]; }
    for (int m = gw; m < MT; m += NGW) {
        bf16_t* base = proj + (size_t)m * PJ + 1024;
#pragma unroll
        for (int i = 0; i < 2; ++i) { const u32x4* p = (const u32x4*)(base + (lane + 64 * i) * 8); const u32x4 v = *p; u32x4* po = (u32x4*)(outp + (size_t)m * opitch + (lane + 64 * i) * 8);
            float f[8] = {bflo(v.x), bfhi(v.x), bflo(v.y), bfhi(v.y), bflo(v.z), bfhi(v.z), bflo(v.w), bfhi(v.w)};
            float ss = 0.f;
#pragma unroll
            for (int e = 0; e < 8; ++e) ss += f[e] * f[e];
            ss += shx(ss, 1, lane); ss += shx(ss, 2, lane); ss += shx(ss, 4, lane);
            const float rs = __builtin_amdgcn_rsqf(ss * (1.f / 64.f) + EPS);
#pragma unroll
            for (int e = 0; e < 8; ++e) f[e] *= rs * (i == 0 ? gq[e] : gk[e]);
            u32x4 w; w.x = pk2(f[0], f[1]); w.y = pk2(f[2], f[3]); w.z = pk2(f[4], f[5]); w.w = pk2(f[6], f[7]); *po = w; }
    }
}

constexpr int LRU_XA = 0, LRU_XP = 528, LRU_CW = 35392;
struct LruP { const float *cw, *cb, *ba, *bi, *lam; const bf16_t *waT, *wiT; };
template <bool FINAL> __device__ __forceinline__ void lru_unit(LAS unsigned char* lds, bf16_t* proj, bf16_t* outp, int opitch, float* agg, const LruP& P, int b, int chunk, int tid) {
    const int lane = tid & 63, r = lane & 31, h = lane >> 5, w = __builtin_amdgcn_readfirstlane(tid >> 6), hd = w >> 1, cbk = w & 1;
    const size_t Rb = (size_t)b * SEQ; const int t0 = chunk * 64;
    { u32x4 xv[5];
#pragma unroll
      for (int i = 0; i < 5; ++i) { const int c = tid + 512 * i, j = c >> 5, cc = c & 31, tok = t0 - 3 + j; xv[i] = (u32x4){0u, 0u, 0u, 0u};
          if (c < 67 * 32 && tok >= 0) xv[i] = *(const u32x4*)(proj + (Rb + tok) * PJ + cc * 8); }
#pragma unroll
      for (int i = 0; i < 5; ++i) { const int c = tid + 512 * i, j = c >> 5, cc = c & 31; if (c < 67 * 32) *(LAS u32x4*)(lds + LRU_XA + j * LRU_XP + cc * 16) = xv[i]; } }
    LAS float* CWl = (LAS float*)(lds + LRU_CW);
    for (int i = tid; i < 1280; i += 512) CWl[i] = (i < 1024) ? P.cw[i] : P.cb[i - 1024];
    __syncthreads();
    const int oc = hd * 64 + cbk * 32 + r;
    float Hc = 0.f;
    if (FINAL) {
        const int mid = chunk >> 1, lo = h ? mid : 0, hi2 = h ? chunk : mid; float PA = 1.f, PH = 0.f;
        const f32x2* ap = (const f32x2*)agg + ((size_t)b * 256) * 256 + oc;
        int j = lo;
        for (; j + 48 <= hi2; j += 48) { f32x2 qv[48];
#pragma unroll
            for (int i = 0; i < 48; ++i) qv[i] = ap[(size_t)(j + i) * 256];
#pragma unroll
            for (int i = 0; i < 48; ++i) { PH = qv[i].x * PH + qv[i].y; PA *= qv[i].x; } }
        for (; j + 8 <= hi2; j += 8) { f32x2 qv[8];
#pragma unroll
            for (int i = 0; i < 8; ++i) qv[i] = ap[(size_t)(j + i) * 256];
#pragma unroll
            for (int i = 0; i < 8; ++i) { PH = qv[i].x * PH + qv[i].y; PA *= qv[i].x; } }
        for (; j < hi2; ++j) { const f32x2 q = ap[(size_t)j * 256]; PH = q.x * PH + q.y; PA *= q.x; }
        const float oPA = shx(PA, 32, lane), oPH = shx(PH, 32, lane);
        Hc = h ? (PA * oPH + PH) : (oPA * PH + oPH);
        asm volatile("" : "+v"(Hc));
    }
    const float cw0 = CWl[oc], cw1 = CWl[256 + oc], cw2 = CWl[512 + oc], cw3 = CWl[768 + oc], cbv = CWl[1024 + oc];
    const float bav = P.ba[oc], biv = P.bi[oc], elam = __builtin_amdgcn_exp2f(-P.lam[oc] * LOG2E), cl = -8.f * ((elam < 0.03f) ? elam * (1.f - elam * (0.5f - elam * (0.33333334f - elam * 0.25f))) : __builtin_amdgcn_logf(1.f + elam) * 0.6931471805599453f);
    float av[2][16], bv[2][16];
#pragma unroll
    for (int rb = 0; rb < 2; ++rb) { f32x16 acca = (f32x16){}, acci = (f32x16){};
#pragma unroll
        for (int ks = 0; ks < 4; ++ks) { const int ci0 = hd * 64 + 16 * ks + 8 * h;
            const bf16x8 waf = *(const bf16x8*)(P.waT + (size_t)oc * 64 + 16 * ks + 8 * h), wif = *(const bf16x8*)(P.wiT + (size_t)oc * 64 + 16 * ks + 8 * h);
            const f32x4 c0 = *(const LAS f32x4*)(CWl + 1024 + ci0), c1 = *(const LAS f32x4*)(CWl + 1024 + ci0 + 4);
            float xc[8] = {c0[0], c0[1], c0[2], c0[3], c1[0], c1[1], c1[2], c1[3]};
#pragma unroll
            for (int tap = 0; tap < 4; ++tap) { const u32x4 xv = *(const LAS u32x4*)(lds + LRU_XA + (32 * rb + r + tap) * LRU_XP + ci0 * 2);
                const f32x4 w0 = *(const LAS f32x4*)(CWl + tap * 256 + ci0), w1 = *(const LAS f32x4*)(CWl + tap * 256 + ci0 + 4);
                xc[0] += w0[0] * bflo(xv.x); xc[1] += w0[1] * bfhi(xv.x); xc[2] += w0[2] * bflo(xv.y); xc[3] += w0[3] * bfhi(xv.y);
                xc[4] += w1[0] * bflo(xv.z); xc[5] += w1[1] * bfhi(xv.z); xc[6] += w1[2] * bflo(xv.w); xc[7] += w1[3] * bfhi(xv.w); }
            const bf16x8 af = pack8(xc[0], xc[1], xc[2], xc[3], xc[4], xc[5], xc[6], xc[7]);
            acca = MFMA32(af, waf, acca); acci = MFMA32(af, wif, acci); }
#pragma unroll
        for (int i = 0; i < 16; ++i) { const int tok = 32 * rb + crow(i, h);
            const LAS bf16_t* xp = (const LAS bf16_t*)(lds + LRU_XA + tok * LRU_XP + oc * 2);
            const float xc = cbv + cw0 * bf2f(xp[0]) + cw1 * bf2f(xp[LRU_XP / 2]) + cw2 * bf2f(xp[LRU_XP]) + cw3 * bf2f(xp[3 * LRU_XP / 2]);
            const float rg = fsigmoid(acca[i] + bav), ig = fsigmoid(acci[i] + biv), la = cl * rg;
            const float x2 = 2.f * la;
            const float em1 = (x2 > -0.03f) ? x2 * (1.f + x2 * (0.5f + x2 * (0.16666667f + x2 * 0.041666668f))) : (__builtin_amdgcn_exp2f(x2 * LOG2E) - 1.f);
            av[rb][i] = __builtin_amdgcn_exp2f(la * LOG2E); bv[rb][i] = __builtin_amdgcn_sqrtf(-em1) * ig * xc; }
#pragma unroll
        for (int i = 0; i < 16; ++i) asm volatile("" : "+v"(av[rb][i]), "+v"(bv[rb][i]));
    }
    float Ag[8], Bg[8];
#pragma unroll
    for (int k = 0; k < 8; ++k) { const int rb = k >> 2, i0 = 4 * (k & 3);
        Ag[k] = (av[rb][i0] * av[rb][i0 + 1]) * (av[rb][i0 + 2] * av[rb][i0 + 3]);
        Bg[k] = ((bv[rb][i0] * av[rb][i0 + 1] + bv[rb][i0 + 1]) * av[rb][i0 + 2] + bv[rb][i0 + 2]) * av[rb][i0 + 3] + bv[rb][i0 + 3]; }
    float myin[8]; float Pp = 1.f;
#pragma unroll
    for (int k = 0; k < 8; ++k) { const float pA = shx(Ag[k], 32, lane), pB = shx(Bg[k], 32, lane);
        const float A0 = h ? pA : Ag[k], B0 = h ? pB : Bg[k], A1 = h ? Ag[k] : pA, B1 = h ? Bg[k] : pB;
        const float in0 = Hc; Hc = A0 * Hc + B0; const float in1 = Hc; Hc = A1 * Hc + B1; myin[k] = h ? in1 : in0; Pp *= A0 * A1; }
    if (!FINAL) { if (h == 0) { f32x2 q; q.x = Pp; q.y = Hc; ((f32x2*)agg)[((size_t)b * 256 + chunk) * 256 + oc] = q; } }
    else {
        bf16_t gav[8][4];
#pragma unroll
        for (int k = 0; k < 8; ++k)
#pragma unroll
            for (int j = 0; j < 4; ++j) { const int tok = 32 * (k >> 2) + 8 * (k & 3) + 4 * h + j; gav[k][j] = *(const bf16_t*)(proj + (Rb + t0 + tok) * PJ + 256 + oc); }
#pragma unroll
        for (int k = 0; k < 8; ++k) { const int rb = k >> 2, i0 = 4 * (k & 3); float hh = myin[k];
#pragma unroll
            for (int j = 0; j < 4; ++j) { hh = av[rb][i0 + j] * hh + bv[rb][i0 + j]; const int tok = 32 * rb + 8 * (k & 3) + 4 * h + j;
                const float ga = bf2f(gav[k][j]); bf16_t* go = outp + (Rb + t0 + tok) * opitch + oc;
                const float z = 1.5957691216057308f * (ga + 0.044715f * ga * ga * ga);
                *go = f2bf(hh * ga * fsigmoid(z)); } }
    }
    __syncthreads();
}

constexpr int SG_VP = 272;
struct SgP { const float *lng, *lnb, *sgb; const bf16_t* sgw; };
__device__ __forceinline__ void sg_unit(LAS unsigned char* lds, bf16_t* proj, bf16_t* outp, int opitch, const SgP& P, int n, int tid) {
    const int lane = tid & 63, r = lane & 31, h = lane >> 5, w = __builtin_amdgcn_readfirstlane(tid >> 6);
    const size_t R0 = (size_t)n * 128;
    { const f32x4 g4 = *(const f32x4*)(P.lng + lane * 4), b4 = *(const f32x4*)(P.lnb + lane * 4);
      u32x2 raws[16];
#pragma unroll
      for (int rr = 0; rr < 16; ++rr) raws[rr] = *(const u32x2*)(proj + (R0 + w * 16 + rr) * PJ + 768 + lane * 4);
#pragma unroll 4
      for (int rr = 0; rr < 16; ++rr) { const int t = w * 16 + rr; const u32x2 raw = raws[rr];
        float v[4] = {bflo(raw.x), bfhi(raw.x), bflo(raw.y), bfhi(raw.y)};
        const float mean = wave_sum((v[0] + v[1]) + (v[2] + v[3]), lane) * (1.f / 256.f);
#pragma unroll
        for (int e = 0; e < 4; ++e) v[e] -= mean;
        const float var = wave_sum((v[0] * v[0] + v[1] * v[1]) + (v[2] * v[2] + v[3] * v[3]), lane) * (1.f / 256.f);
        const float rs = __builtin_amdgcn_rsqf(var + EPS);
#pragma unroll
        for (int e = 0; e < 4; ++e) *(LAS bf16_t*)(lds + (lane * 4 + e) * SG_VP + t * 2) = f2bf(v[e] * rs * g4[e] + b4[e]); } }
    __syncthreads();
    const int g = w >> 1, cbk = w & 1, c = g * 64 + cbk * 32 + r;
#pragma unroll
    for (int tb = 0; tb < 4; ++tb) { f32x16 acc = (f32x16){};
        const bf16_t* wp = P.sgw + (size_t)(g * 128 + 32 * tb + r) * 128 + 8 * h;
#pragma unroll
        for (int ks = 0; ks < 2 * tb + 2; ++ks) { const bf16x8 af = *(const bf16x8*)(wp + 16 * ks); const bf16x8 bfr = *(const LAS bf16x8*)(lds + c * SG_VP + (16 * ks + 8 * h) * 2); acc = MFMA32(af, bfr, acc); }
#pragma unroll
        for (int i = 0; i < 16; ++i) { const int t = 32 * tb + crow(i, h); const bf16_t* up = proj + (R0 + t) * PJ + 512 + c; outp[(R0 + t) * opitch + c] = f2bf(bf2f(*up) * (acc[i] + P.sgb[g * 128 + t])); } }
    __syncthreads();
}

constexpr int AT_SLOT = 16384, AT_K = 0, AT_V = 4 * AT_SLOT, AT_TAB = 131072 + 1024;
__device__ __forceinline__ void glds16(const void* gsrc, unsigned lds_dst) {
    unsigned keep;
    asm volatile("s_mov_b32 %0, m0\n\ts_mov_b32 m0, %2\n\ts_nop 0\n\tglobal_load_lds_dwordx4 %1, off\n\ts_mov_b32 m0, %0" : "=&s"(keep) : "v"(gsrc), "s"(lds_dst) : "memory");
}
__device__ __forceinline__ void at_qk(f32x16& p0, f32x16& p1, const LAS unsigned char* lk, const int (&koff)[4], const bf16x8 (&qf)[4]) {
    const f32x16 z = (f32x16){};
#pragma unroll
    for (int ks = 0; ks < 4; ++ks) { const bf16x8 a0 = *(const LAS bf16x8*)(lk + koff[ks]), a1 = *(const LAS bf16x8*)(lk + koff[ks] + 8192);
        p0 = MFMA32(a0, qf[ks], ks == 0 ? z : p0); p1 = MFMA32(a1, qf[ks], ks == 0 ? z : p1); }
}
__device__ __forceinline__ void at_bias(f32x16& p0, f32x16& p1, const LAS float* tb) {
#pragma unroll
    for (int i = 0; i < 16; ++i) { const int kk = (i & 3) + 8 * (i >> 2); p0[i] += tb[kk]; p1[i] += tb[32 + kk]; }
}
template <bool DOQK, bool DOEXP, bool DOPV, int VAR> __device__ __forceinline__ void at_fused(f32x16& pn0, f32x16& pn1, f32x16& pc0, f32x16& pc1, bf16x8 (&pfc)[4], const bf16x8 (&pfp)[4], f32x16 (&o)[4], float& lsum,
                                         const LAS unsigned char* lk, const LAS unsigned char* lv, const int (&koff)[4], const int (&voff)[4], const bf16x8 (&qf)[4]) {
    constexpr int PD = 6, NF = PD + 1;
    bf16x8 fr[NF];
#define AT_NEED(g) (((g) < 8) ? DOQK : DOPV)
#define AT_FRAG(g) (((g) < 8) ? *(const LAS bf16x8*)(lk + koff[(g) >> 1] + ((g) & 1) * 8192) : *(const LAS bf16x8*)(lv + voff[((g) - 8) >> 2] + (((g) - 8) & 3) * 4096))
#define AT_EX2(x) ((VAR == 1) ? (x) : __builtin_amdgcn_exp2f(x))
#define AT_EXP(e) do { if ((e) < 16) { pc0[(e)] = AT_EX2(pc0[(e)]); s0 += pc0[(e)]; } else { pc1[(e) - 16] = AT_EX2(pc1[(e) - 16]); s1 += pc1[(e) - 16]; } } while (0)
#pragma unroll
    for (int g = 0; g < PD; ++g) { if (AT_NEED(g)) fr[g % NF] = AT_FRAG(g); else fr[g % NF] = (bf16x8){}; }
    float s0 = 0.f, s1 = 0.f;
    const f32x16 z = (f32x16){};
#pragma unroll
    for (int g = 0; g < 24; ++g) {
        if (g + PD < 24 && AT_NEED(g + PD)) fr[(g + PD) % NF] = AT_FRAG(g + PD);
        if (g < 8) { const int ks = g >> 1;
            if (!DOQK || VAR == 2) {} else if (g & 1) pn1 = MFMA32(fr[g % NF], qf[ks], ks == 0 ? z : pn1); else pn0 = MFMA32(fr[g % NF], qf[ks], ks == 0 ? z : pn0);
        } else if (DOPV && VAR != 2) { const int sp = (g - 8) >> 2, db = (g - 8) & 3; o[db] = MFMA32(fr[g % NF], pfp[sp], o[db]); }
        if (DOEXP) {
            const int e0 = g + (g + 2) / 3, e1 = (g + 1) + (g + 3) / 3;
#pragma unroll
            for (int e = e0; e < e1; ++e) AT_EXP(e);
            asm volatile("" : "+v"(s0), "+v"(s1));
            if (g == 6) pfc[0] = pack8(pc0[0], pc0[1], pc0[2], pc0[3], pc0[4], pc0[5], pc0[6], pc0[7]);
            if (g == 12) pfc[1] = pack8(pc0[8], pc0[9], pc0[10], pc0[11], pc0[12], pc0[13], pc0[14], pc0[15]);
            if (g == 18) pfc[2] = pack8(pc1[0], pc1[1], pc1[2], pc1[3], pc1[4], pc1[5], pc1[6], pc1[7]);
        }
        __builtin_amdgcn_sched_barrier(0);
    }
    if (DOEXP) { pfc[3] = pack8(pc1[8], pc1[9], pc1[10], pc1[11], pc1[12], pc1[13], pc1[14], pc1[15]); lsum += s0 + s1; }
#undef AT_FRAG
#undef AT_NEED
#undef AT_EXP
#undef AT_EX2
}
template <int VAR> __device__ __forceinline__ void attn_unit(LAS unsigned char* lds, const bf16_t* proj, const bf16_t* vt, bf16_t* outp, int opitch, int b, int hd, int qb, float lam, float osc, const float* relb, const float* subg, int tid_in) {
    int tid = tid_in; asm volatile("" : "+v"(tid));
    const int lane = tid & 63, r = lane & 31, h = lane >> 5, w = __builtin_amdgcn_readfirstlane(tid >> 6), mp = w >> 2, rs = w & 3;
    LAS float* tab = (LAS float*)(lds + AT_TAB);
    const size_t Rb = (size_t)b * SEQ, R0 = Rb + (size_t)qb * 128;
    const int NT = 2 * qb + 2;
    const bool deep = NT >= 8;
    const int rk0 = 8 * w + (lane >> 4), rk1 = rk0 + 4, rv0 = 16 * w + (lane >> 3), rv1 = rv0 + 8;
    const bf16_t* ks0 = proj + (Rb + rk0) * PJ + 1536 + hd * 128 + (((lane & 15) ^ (rk0 & 15)) * 8);
    const bf16_t* ks1 = proj + (Rb + rk1) * PJ + 1536 + hd * 128 + (((lane & 15) ^ (rk1 & 15)) * 8);
    const bf16_t* vs0 = vt + ((size_t)((b * 4 + hd) * 128 + rv0)) * SEQ + (((lane & 7) ^ ((rv0 >> 1) & 7)) * 8);
    const bf16_t* vs1 = vt + ((size_t)((b * 4 + hd) * 128 + rv1)) * SEQ + (((lane & 7) ^ ((rv1 >> 1) & 7)) * 8);
    const unsigned ldsb = (unsigned)(uintptr_t)lds, kd = ldsb + AT_K + w * 2048, vd = ldsb + AT_V + w * 2048;
#define AT_ISSUE_K(j) do { const unsigned d_ = (unsigned)__builtin_amdgcn_readfirstlane(kd + ((j) & 3) * AT_SLOT); if (VAR != 3) { glds16(ks0 + (size_t)(j) * 64 * PJ, d_); glds16(ks1 + (size_t)(j) * 64 * PJ, d_ + 1024u); } } while (0)
#define AT_ISSUE_V(j) do { const unsigned d_ = (unsigned)__builtin_amdgcn_readfirstlane(vd + ((j) & 3) * AT_SLOT); if (VAR != 3) { glds16(vs0 + (j) * 64, d_); glds16(vs1 + (j) * 64, d_ + 1024u); } } while (0)
#define AT_WAITBAR(N) asm volatile("s_waitcnt vmcnt(" #N ") lgkmcnt(0)\n\ts_barrier" ::: "memory")
    AT_ISSUE_K(0); AT_ISSUE_K(1);
    if (2 < NT) AT_ISSUE_K(2);
    AT_ISSUE_V(0);
    if (3 < NT) AT_ISSUE_K(3);
    AT_ISSUE_V(1);
    { const float cfar = relb[15 * 4 + hd];
      if (tid < 64) tab[1216 + tid] = -INFINITY;
      for (int idx = tid; idx < 1216; idx += 512) { const int rel = idx - 1151, n = rel < 0 ? -rel : rel; int bk = (n < 8) ? n : (5 + (31 - __builtin_clz(n))); bk = bk > 15 ? 15 : bk; if (rel > 0) bk += 16; tab[idx] = (relb[bk * 4 + hd] - cfar) * LOG2E; } }
    bf16x8 qf[4];
    { const bf16_t* qp = proj + (R0 + 32 * rs + r) * PJ + 1024 + hd * 128 + mp * 64 + 8 * h;
#pragma unroll
      for (int ks = 0; ks < 4; ++ks) qf[ks] = *(const bf16x8*)(qp + 16 * ks); }
    int koff[4], voff[4];
    { const int kx = (mp * 8 + h) ^ (r & 15), vx = h ^ ((r >> 1) & 7);
#pragma unroll
      for (int i = 0; i < 4; ++i) { koff[i] = r * 256 + ((kx ^ (2 * i)) << 4); voff[i] = r * 128 + ((vx ^ (2 * i)) << 4); } }
    if (deep) AT_WAITBAR(8); else AT_WAITBAR(0);
    f32x16 o[4]; o[0] = (f32x16){}; o[1] = (f32x16){}; o[2] = (f32x16){}; o[3] = (f32x16){};
    float lsum = 0.f;
    const int qpos = qb * 128 + 32 * rs + r;
    const LAS float* tb0 = tab + (1151 + 4 * h - qpos);
    f32x16 pa0, pa1, pb0, pb1; bf16x8 pfA[4], pfB[4];
    pb0 = (f32x16){}; pb1 = (f32x16){};
#pragma unroll
    for (int i = 0; i < 4; ++i) { pfA[i] = (bf16x8){}; pfB[i] = (bf16x8){}; }
    at_qk(pa0, pa1, lds + AT_K, koff, qf);
    if (1088 > qb * 128) at_bias(pa0, pa1, tb0);
    asm volatile("s_waitcnt lgkmcnt(0)\n\ts_barrier" ::: "memory");
#define AT_STEP(t, C0, C1, N0, N1, PC, PP, DOPV) do { \
        if ((t) + 4 < NT) AT_ISSUE_K((t) + 4); \
        if ((t) + 2 < NT) AT_ISSUE_V((t) + 2); \
        at_fused<true, true, DOPV, VAR>(N0, N1, C0, C1, PC, PP, o, lsum, lds + AT_K + (((t) + 1) & 3) * AT_SLOT, lds + AT_V + (((t) + 3) & 3) * AT_SLOT, koff, voff, qf); \
        if (((t) + 1) * 64 + 1088 > qb * 128) at_bias(N0, N1, (rs < 2 && (t) + 2 == NT) ? (const LAS float*)(tab + 1216) : tb0 + ((t) + 1) * 64); \
        if ((t) + 4 < NT) AT_WAITBAR(8); else AT_WAITBAR(0); } while (0)
    AT_STEP(0, pa0, pa1, pb0, pb1, pfA, pfB, false);
    asm volatile(".p2align 8" ::: "memory");
    for (int t = 1; t + 1 < NT; t += 2) {
        AT_STEP(t, pb0, pb1, pa0, pa1, pfB, pfA, true);
        AT_STEP(t + 1, pa0, pa1, pb0, pb1, pfA, pfB, true);
    }
    at_fused<false, true, true, VAR>(pa0, pa1, pb0, pb1, pfB, pfA, o, lsum, lds + AT_K, lds + AT_V + ((NT - 2) & 3) * AT_SLOT, koff, voff, qf);
    at_fused<false, false, true, VAR>(pa0, pa1, pb0, pb1, pfA, pfB, o, lsum, lds + AT_K, lds + AT_V + ((NT - 1) & 3) * AT_SLOT, koff, voff, qf);
    __syncthreads();
#undef AT_STEP
#undef AT_ISSUE_K
#undef AT_ISSUE_V
#undef AT_WAITBAR
    int lane_e = tid & 63; asm volatile("" : "+v"(lane_e));
    lsum += shx(lsum, 32, lane_e);
    const float inv = __builtin_amdgcn_rcpf(lsum);
    LAS float* ex = (LAS float*)lds;
    if (mp == 1) {
#pragma unroll
        for (int db = 0; db < 4; ++db)
#pragma unroll
            for (int i = 0; i < 16; ++i) ex[((rs * 4 + db) * 16 + i) * 64 + lane_e] = o[db][i] * inv;
    }
    __syncthreads();
    if (mp == 0) {
        float ss = 0.f;
#pragma unroll
        for (int db = 0; db < 4; ++db)
#pragma unroll
            for (int i = 0; i < 16; ++i) { const float v = o[db][i] * inv - lam * ex[((rs * 4 + db) * 16 + i) * 64 + lane_e]; o[db][i] = v; ss += v * v; }
        ss += shx(ss, 32, lane_e);
        const float rsn = __builtin_amdgcn_rsqf(ss * (1.f / 128.f) + EPS) * osc;
        const int r_e = lane_e & 31, h_e = lane_e >> 5; bf16_t* op = outp + (R0 + 32 * rs + r_e) * opitch + hd * 128;
#pragma unroll
        for (int db = 0; db < 4; ++db)
#pragma unroll
            for (int i4 = 0; i4 < 4; ++i4) { const int d = 32 * db + 8 * i4 + 4 * h_e; const f32x4 g4 = *(const f32x4*)(subg + d);
                u32x2 wv; wv.x = pk2(o[db][4 * i4] * rsn * g4[0], o[db][4 * i4 + 1] * rsn * g4[1]); wv.y = pk2(o[db][4 * i4 + 2] * rsn * g4[2], o[db][4 * i4 + 3] * rsn * g4[3]);
                *(u32x2*)(op + d) = wv; }
    }
    __syncthreads();
}

__global__ void __launch_bounds__(512, 2) mega_fwd(Args a) {
    extern __shared__ __attribute__((aligned(16))) unsigned char lds_raw[];
    cg::grid_group grid = cg::this_grid();
    LAS unsigned char* lds = (LAS unsigned char*)lds_raw;
    const int G = gridDim.x, bid = blockIdx.x;
    const int wave = __builtin_amdgcn_readfirstlane(threadIdx.x >> 6);
#define IS_T0(v) bool v; { int l_; asm volatile("v_mbcnt_lo_u32_b32 %0, -1, 0\n\tv_mbcnt_hi_u32_b32 %0, -1, %0" : "=v"(l_)); v = (wave == 0) && (l_ == 0); }
    { IS_T0(t0_); if (t0_) { ((LAS unsigned*)(lds + MISC_OFF))[8] = 0u; ((LAS unsigned*)(lds + MISC_OFF))[9] = 0u; } __syncthreads();
      (void)xcd_barrier_post((unsigned*)kin(32) + CW_BAR, (volatile LAS unsigned*)(lds + MISC_OFF) + 8, t0_); }
#define GRID_BAR() do { XcdBarrier b_; b_.bar = (unsigned*)kin(32) + CW_BAR; b_.x = xb_xcc_id(); b_.st = (volatile LAS unsigned*)(lds + MISC_OFF) + 8; IS_T0(t0_); xcd_barrier(b_, t0_); } while (0)
#define PH_BEGIN int tid, bidp = bid, Gp = G; { int l_; asm volatile("v_mbcnt_lo_u32_b32 %0, -1, 0\n\tv_mbcnt_hi_u32_b32 %0, -1, %0" : "=v"(l_)); asm volatile("" : "+s"(bidp), "+s"(Gp)); tid = wave * 64 + l_; }
#define WSB(off) ((unsigned char*)kin(32) + (off))
#define ssqA ((float*)WSB(WS_SSQA))
#define ssqB ((float*)WSB(WS_SSQB))
#define agg ((float*)WSB(WS_AGG))
#define sm ((bf16_t*)WSB(WS_SMALL))
#define xb ((bf16_t*)WSB(WS_XB))
#define merged ((bf16_t*)kin(31))
#define proj ((bf16_t*)WSB(WS_PROJ))
#define xb2 ((bf16_t*)WSB(WS_PROJ))
#define vt ((bf16_t*)WSB(WS_VT))
#define gates ((bf16_t*)WSB(WS_GATES))
#define hid ((bf16_t*)WSB(WS_GATES))
#define out ((float*)kin(31))
#define ws WSB(0)

    { PH_BEGIN; convert_layer(0, ws + WS_W0, (LAS float*)lds, tid, bidp, Gp);
      convert_small(sm, tid, bidp, Gp);
      x_pass(kin(0), xb, ssqA, tid & 63, bidp * 8 + wave, Gp * 8); }
    grid.sync();

    for (int l = 0; l < NL; ++l) {
#define WL(off) (ws + WS_W0 + (size_t)(l & 1) * WS_WSZ + (off))
#ifndef NO_A
        {
            PH_BEGIN;
            pg8::Gemm g{xb, (const bf16_t*)WL(W_IN), MT, INC, DM, DM}; pg8::StaticOrder S; S.init(MT, INC, Gp, bidp);
            pg8::EpiInProj E{proj, vt, gates, ssqA, kin(3) + l * 3072, kin(15) + l * 64, kin(16) + l * 64};
            pg8::gemm_phase<pg8::EpiInProj, pg8::StaticOrder, true, true>(lds, g, S, E, tid);
#ifdef PROBE_A
            pg8::gemm_phase<pg8::EpiInProj, pg8::StaticOrder, true, true>(lds, g, S, E, tid);
#endif
        }
#endif
        GRID_BAR();
        {
            PH_BEGIN; const int lane = tid & 63, gw = bidp * 8 + wave, NGW = Gp * 8;
            const bf16_t* sml = sm + (size_t)l * SMALL_PER_LAYER;
#if defined(PROBE_B) && PROBE_B == 3
            { LruP LP{kin(4) + l * 1024, kin(5) + l * 256, kin(7) + l * 256, kin(9) + l * 256, kin(10) + l * 256, sml, sml + 16384};
              for (int u = bidp; u < 512; u += Gp) lru_unit<false>(lds, proj, proj, PJ, agg, LP, u >> 8, u & 255, tid); }
            if (l + 1 < NL) convert_layer(l + 1, ws + WS_W0 + (size_t)((l + 1) & 1) * WS_WSZ, (LAS float*)lds, tid, bidp, Gp);
#elif defined(PROBE_B)
#if PROBE_B == 1
            qk_norm(proj, xb, 1024, kin(15) + l * 64, kin(16) + l * 64, lane, gw, NGW);
#endif
            { LruP LP{kin(4) + l * 1024, kin(5) + l * 256, kin(7) + l * 256, kin(9) + l * 256, kin(10) + l * 256, sml, sml + 16384};
              for (int u = bidp; u < 512; u += Gp) lru_unit<false>(lds, proj, proj, PJ, agg, LP, u >> 8, u & 255, tid); }
            { SgP SP{kin(11) + l * 256, kin(12) + l * 256, kin(14) + l * 512, sml + 32768};
              for (int u = bidp; u < 256; u += Gp) sg_unit(lds, proj, xb, 1024, SP, u, tid); }
#if PROBE_B == 1
            if (l + 1 < NL) convert_layer(l + 1, ws + WS_W0 + (size_t)((l + 1) & 1) * WS_WSZ, (LAS float*)lds, tid, bidp, Gp);
#endif
#endif
            { LruP LP{kin(4) + l * 1024, kin(5) + l * 256, kin(7) + l * 256, kin(9) + l * 256, kin(10) + l * 256, sml, sml + 16384};
              for (int u = bidp; u < 512; u += Gp) lru_unit<false>(lds, proj, proj, PJ, agg, LP, u >> 8, u & 255, tid); }
            { SgP SP{kin(11) + l * 256, kin(12) + l * 256, kin(14) + l * 512, sml + 32768};
              for (int u = bidp; u < 256; u += Gp) sg_unit(lds, proj, proj + 512, PJ, SP, u, tid); }
            if (l + 1 < NL) convert_layer(l + 1, ws + WS_W0 + (size_t)((l + 1) & 1) * WS_WSZ, (LAS float*)lds, tid, bidp, Gp);
        }
        GRID_BAR();
        {
            PH_BEGIN; const int lane = tid & 63;
            float d1 = kin(17)[l * 64 + lane] * kin(18)[l * 64 + lane], d2 = kin(19)[l * 64 + lane] * kin(20)[l * 64 + lane];
            d1 = wave_sum(d1, lane); d2 = wave_sum(d2, lane);
            const float lam_init = 0.8f - 0.6f * __builtin_amdgcn_exp2f(-0.3f * LOG2E * (float)l);
            const float lam = __builtin_amdgcn_exp2f(d1 * LOG2E) - __builtin_amdgcn_exp2f(d2 * LOG2E) + lam_init;
            const float* relb = kin(22); const float* subg = kin(21) + l * 128;
#ifndef NO_ATT
#ifdef PROBE_ATT
            if (Gp == 256) {
                const int vcu = (bidp % 8) * 32 + bidp / 8, bh = vcu >> 5, s = vcu & 31;
#define ATT_OUT xb, 1024
                for (int i = 0; i < 4; ++i) { const int qb = (i == 0) ? 127 - s : (i == 1) ? 95 - s : (i == 2) ? 32 + s : s; attn_unit<PROBE_ATT>(lds, proj, vt, ATT_OUT, bh >> 2, bh & 3, qb, lam, 1.f - lam_init, relb, subg, tid); }
#undef ATT_OUT
            }
#endif
#define ATT_OUT proj + 1024, PJ
            if (Gp == 256) {
                const int vcu = (bidp % 8) * 32 + bidp / 8, bh = vcu >> 5, s = vcu & 31;
                for (int i = 0; i < 4; ++i) { const int qb = (i == 0) ? 127 - s : (i == 1) ? s : (i == 2) ? 95 - s : 32 + s; attn_unit<0>(lds, proj, vt, ATT_OUT, bh >> 2, bh & 3, qb, lam, 1.f - lam_init, relb, subg, tid); }
            } else {
                for (int u = bidp; u < 1024; u += Gp) attn_unit<0>(lds, proj, vt, ATT_OUT, u >> 9, (u >> 7) & 3, u & 127, lam, 1.f - lam_init, relb, subg, tid);
            }
#endif
            { const bf16_t* sml = sm + (size_t)l * SMALL_PER_LAYER;
              LruP LP{kin(4) + l * 1024, kin(5) + l * 256, kin(7) + l * 256, kin(9) + l * 256, kin(10) + l * 256, sml, sml + 16384};
#if defined(PROBE_B) && PROBE_B != 3
              for (int u = bidp; u < 512; u += Gp) lru_unit<true>(lds, proj, xb, 1024, agg, LP, u >> 8, u & 255, tid);
#endif
              for (int u = bidp; u < 512; u += Gp) lru_unit<true>(lds, proj, proj + 256, PJ, agg, LP, u >> 8, (u >> 8) ? 255 - (u & 255) : (u & 255), tid); }
        }
        GRID_BAR();
#ifndef NO_C1
        { PH_BEGIN; pg8::StaticOrder S; S.init(MT, DM, Gp, bidp); pg8::Gemm g{proj + 256, (const bf16_t*)WL(W_PA), MT, DM, 256, PJ}; pg8::EpiMerge<0> E{gates, merged}; pg8::gemm_phase<pg8::EpiMerge<0>, pg8::StaticOrder, true, true>(lds, g, S, E, tid); }
        { PH_BEGIN; pg8::StaticOrder S; S.init(MT, DM, Gp, bidp); pg8::Gemm g{proj + 512, (const bf16_t*)WL(W_PB), MT, DM, 256, PJ}; pg8::EpiMerge<1> E{gates, merged}; pg8::gemm_phase<pg8::EpiMerge<1>, pg8::StaticOrder, true, true>(lds, g, S, E, tid); }
        { PH_BEGIN; pg8::StaticOrder S; S.init(MT, DM, Gp, bidp); pg8::Gemm g{proj + 1024, (const bf16_t*)WL(W_PC), MT, DM, 512, PJ}; pg8::EpiMerge<2> E{gates, merged}; pg8::gemm_phase<pg8::EpiMerge<2>, pg8::StaticOrder, true, true>(lds, g, S, E, tid); }
#ifdef PROBE_C1
        { PH_BEGIN; pg8::StaticOrder S; S.init(MT, DM, Gp, bidp); pg8::Gemm g{proj + 256, (const bf16_t*)WL(W_PA), MT, DM, 256, PJ}; pg8::EpiMerge<0> E{gates, merged}; pg8::gemm_phase<pg8::EpiMerge<0>, pg8::StaticOrder, true, true>(lds, g, S, E, tid); }
        { PH_BEGIN; pg8::StaticOrder S; S.init(MT, DM, Gp, bidp); pg8::Gemm g{proj + 512, (const bf16_t*)WL(W_PB), MT, DM, 256, PJ}; pg8::EpiMerge<1> E{gates, merged}; pg8::gemm_phase<pg8::EpiMerge<1>, pg8::StaticOrder, true, true>(lds, g, S, E, tid); }
        { PH_BEGIN; pg8::StaticOrder S; S.init(MT, DM, Gp, bidp); pg8::Gemm g{proj + 1024, (const bf16_t*)WL(W_PC), MT, DM, 512, PJ}; pg8::EpiMerge<2> E{gates, merged}; pg8::gemm_phase<pg8::EpiMerge<2>, pg8::StaticOrder, true, true>(lds, g, S, E, tid); }
#endif
#endif
        GRID_BAR();
#ifndef NO_C2
        {
            PH_BEGIN;
            pg8::Gemm g{merged, (const bf16_t*)WL(W_O), MT, DM, DM, DM}; pg8::StaticOrder S; S.init(MT, DM, Gp, bidp);
            pg8::EpiResid E{(const float*)nullptr, xb, (float*)nullptr, xb2, (bf16_t*)nullptr, ssqB};
            pg8::gemm_phase<pg8::EpiResid, pg8::StaticOrder, true, true>(lds, g, S, E, tid);
        }
#endif
        GRID_BAR();
#ifndef NO_C3
        {
            PH_BEGIN;
            pg8::Gemm g{xb2, (const bf16_t*)WL(W_FF), MT, 2 * FF, DM, DM}; pg8::StaticOrder S; S.init(MT, 2 * FF, Gp, bidp);
            pg8::EpiFfn1 E{hid, ssqB};
            pg8::gemm_phase<pg8::EpiFfn1, pg8::StaticOrder, true, true>(lds, g, S, E, tid);
#ifdef PROBE_C3
            pg8::gemm_phase<pg8::EpiFfn1, pg8::StaticOrder, true, true>(lds, g, S, E, tid);
#endif
        }
#endif
        GRID_BAR();
#ifndef NO_C4
        {
            PH_BEGIN;
            pg8::Gemm g{hid, (const bf16_t*)WL(W_DN), MT, DM, FF, FF}; pg8::StaticOrder S; S.init(MT, DM, Gp, bidp);
            const bool lastl = (l + 1 == NL);
            pg8::EpiResid E{(const float*)nullptr, xb2, lastl ? out : (float*)nullptr, lastl ? (bf16_t*)nullptr : xb, (bf16_t*)nullptr, ssqA};
            pg8::gemm_phase<pg8::EpiResid, pg8::StaticOrder, true, true>(lds, g, S, E, tid);
        }
#endif
        if (l + 1 < NL) GRID_BAR();
    }
}
#undef WL
#undef GRID_BAR
#undef IS_T0
#undef PH_BEGIN
#undef ws
#undef out
#undef hid
#undef gates
#undef vt
#undef xb2
#undef proj
#undef merged
#undef xb
#undef sm
#undef agg
#undef ssqB
#undef ssqA
extern "C" void kernel_launch(void* const* d_in, const int* in_sizes, int n_in, void* d_out, int out_size, void* d_ws, size_t ws_size, hipStream_t stream) {
    static int grid = 0;
    if (grid == 0) {
        if (n_in != 31 || out_size != MT * DM || ws_size < WS_END) { fprintf(stderr, "kernel_launch: unexpected shapes (n_in %d out %d ws %zu)\n", n_in, out_size, ws_size); grid = -1; return; }
        int dev = 0, cus = 0, per_cu = 0;
        hipGetDevice(&dev); hipDeviceGetAttribute(&cus, hipDeviceAttributeMultiprocessorCount, dev);
        if (hipFuncSetAttribute((const void*)mega_fwd, hipFuncAttributeMaxDynamicSharedMemorySize, LDS_BYTES) != hipSuccess) { fprintf(stderr, "kernel_launch: hipFuncSetAttribute failed\n"); grid = -1; return; }
        if (hipOccupancyMaxActiveBlocksPerMultiprocessor(&per_cu, (const void*)mega_fwd, 512, LDS_BYTES) != hipSuccess || per_cu < 1) { fprintf(stderr, "kernel_launch: occupancy query says %d\n", per_cu); per_cu = 1; }
        (void)hipGetLastError();
        grid = cus;
    }
    if (grid < 0) return;
    if (hipMemsetAsync(d_ws, 0, CTL_ZERO_BYTES, stream) != hipSuccess) { fprintf(stderr, "kernel_launch: memset failed\n"); return; }
    Args a{};
    for (int i = 0; i < 31; ++i) a.in[i] = (const float*)d_in[i];
    a.out = (float*)d_out; a.ws = (unsigned char*)d_ws;
    void* args[] = {&a};
    hipError_t e = hipLaunchCooperativeKernel((const void*)mega_fwd, dim3(grid), dim3(512), args, LDS_BYTES, stream);
    if (e != hipSuccess) fprintf(stderr, "cooperative launch failed: %s (grid %d)\n", hipGetErrorString(e), grid);
}
```

```cpp
#include <hip/hip_runtime.h>
#include <hip/hip_cooperative_groups.h>
#include <hip/hip_bf16.h>
#include <cstdio>
#include <cstdint>
#include <cmath>
namespace cg = cooperative_groups;
namespace pg8 {
#define PG8_LAS __attribute__((address_space(3)))
typedef unsigned short bf16_t;
typedef short bf16x8 __attribute__((ext_vector_type(8)));
typedef float f32x4 __attribute__((ext_vector_type(4)));
typedef unsigned u32x4 __attribute__((ext_vector_type(4)));
constexpr int BM = 256, BK = 64, HALF = 128, HTB = HALF * BK * 2  , STAGE_BYTES = 8 * HTB, NXCD = 8, WGM = 4;

__host__ __device__ __forceinline__ int lds_byte(int r, int c) { const int st = (r >> 4) * 2 + (c >> 5), rr = r & 15, cc = c & 31, ob = rr * 64 + cc * 2; return st * 1024 + (ob ^ (((ob >> 9) & 1) << 5)); }
__host__ __device__ __forceinline__ void stage_rc(int b, int& R, int& C) { const int st = b / 1024, sb = b % 1024, swz = sb ^ (((sb >> 9) & 1) << 5); R = (st >> 1) * 16 + swz / 64; C = (st & 1) * 32 + (swz % 64) / 2; }
__host__ __device__ __forceinline__ int perm32(int rho) { const int n = rho >> 4, i = rho & 15; return 8 * (i >> 2) + 4 * n + (i & 3); }

struct Unit { int pm, pn; };
struct Gemm { const bf16_t* A; const bf16_t* Bt; int M, N, K, lda; };

struct StaticOrder {
    int nM, nN, nwg, G, c;
    __host__ __device__ void init(int M, int N, int G_, int c_) { nM = M / BM; nN = N / BM; nwg = nM * nN; G = G_; c = c_; }
    __host__ __device__ bool next(int i, Unit& u) const {
        const long L = (long)i * G + c; if (L >= nwg) return false;
        int wgid = (int)L; { const int q = nwg / NXCD, r = nwg % NXCD, xcd = wgid % NXCD, off = wgid / NXCD; wgid = (xcd < r ? xcd * (q + 1) : r * (q + 1) + (xcd - r) * q) + off; }
        const int nig = WGM * nN, gid = wgid / nig, fm = gid * WGM, gsz = (nM - fm) < WGM ? (nM - fm) : WGM;
        u.pm = fm + ((wgid % nig) % gsz); u.pn = (wgid % nig) / gsz; return true;
    }
    __device__ __forceinline__ void a_ready(const Unit&) const {}
    __device__ __forceinline__ void done(const Unit&) const {}
};

template <class Epi, class Sched, bool ALIGN_EPI = false, bool SP2 = false>
__device__ __forceinline__ void gemm_phase(PG8_LAS unsigned char* lds, const Gemm g, const Sched& S, const Epi& E, const int tid) {
    const int wid = __builtin_amdgcn_readfirstlane(tid >> 6), lane = tid & 63, wr = wid >> 2, wc = wid & 3, fr = lane & 15, fq = lane >> 4;
    const int K = g.K, nt = K / BK;
    unsigned voffA[2], voffB[2];
#pragma unroll
    for (int i = 0; i < 2; ++i) { int R, C; stage_rc(tid * 16 + i * 8192, R, C); const int Rb = Epi::PERM ? ((R & ~31) + perm32(R & 31)) : R;
        voffA[i] = (unsigned)(R * g.lda + C) * 2u; voffB[i] = (unsigned)(Rb * K + C) * 2u; }
    const size_t kstep = (size_t)(BK * 2);
    const size_t hstepA = (size_t)HALF * g.lda * 2, hstepB = (size_t)HALF * K * 2;
    const size_t tstepA = 2 * hstepA, tstepB = 2 * hstepB;
    const unsigned ldsw = (unsigned)wid * 1024u;
    const int aoff = lds_byte(wr * 64 + fr, fq * 8), boff = lds_byte(wc * 32 + fr, fq * 8);
#define PG8_SA(b, h) (((b) * 2 + (h)) * HTB)
#define PG8_SB(b, h) ((4 + (b) * 2 + (h)) * HTB)
#define PG8_STAGE(bufoff, gbase, voff) do { _Pragma("unroll") for (int _i = 0; _i < 2; ++_i) \
        __builtin_amdgcn_global_load_lds((const unsigned*)((const char*)(gbase) + (voff)[_i]), (PG8_LAS unsigned*)(lds + (bufoff) + ldsw + _i * 8192), 16, 0, 0); } while (0)
#define PG8_LDA(dst, b, h) do { _Pragma("unroll") for (int m = 0; m < 4; ++m) _Pragma("unroll") for (int k = 0; k < 2; ++k) dst[m][k] = *(const PG8_LAS bf16x8*)(lds + PG8_SA(b, h) + aoff + m * 2048 + k * 1024); } while (0)
#define PG8_LDB(dst, b, h) do { _Pragma("unroll") for (int n = 0; n < 2; ++n) _Pragma("unroll") for (int k = 0; k < 2; ++k) dst[n][k] = *(const PG8_LAS bf16x8*)(lds + PG8_SB(b, h) + boff + n * 2048 + k * 1024); } while (0)
#define PG8_MMA(ai, bj, At, Bt) do { __builtin_amdgcn_s_setprio(1); _Pragma("unroll") for (int m = 0; m < 4; ++m) _Pragma("unroll") for (int n = 0; n < 2; ++n) _Pragma("unroll") for (int k = 0; k < 2; ++k) \
        acc[ai][bj][m][n] = __builtin_amdgcn_mfma_f32_16x16x32_bf16(Bt[n][k], At[m][k], acc[ai][bj][m][n], 0, 0, 0); __builtin_amdgcn_s_setprio(0); } while (0)
#define PG8_WAIT_V(n) asm volatile("s_waitcnt vmcnt(" #n ")" ::: "memory")
#define PG8_WAIT_L(n) asm volatile("s_waitcnt lgkmcnt(" #n ")" ::: "memory")
#define PG8_BAR __builtin_amdgcn_s_barrier()
#define PG8_SCHED __builtin_amdgcn_sched_barrier(0)
    Unit cur, nxt; int ui = 0;
    if (!S.next(0, cur)) return;
    f32x4 acc[2][2][4][2];
#pragma unroll
    for (int a = 0; a < 2; ++a)
#pragma unroll
        for (int b = 0; b < 2; ++b)
#pragma unroll
            for (int m = 0; m < 4; ++m)
#pragma unroll
                for (int n = 0; n < 2; ++n) acc[a][b][m][n] = (f32x4){0.f, 0.f, 0.f, 0.f};
    bf16x8 At[4][2], B0[2][2], B1[2][2];
    const char* cA = (const char*)g.A + (size_t)cur.pm * tstepA; const char* cB = (const char*)g.Bt + (size_t)cur.pn * tstepB;
    S.a_ready(cur);
    if constexpr (SP2) {
        PG8_STAGE(PG8_SB(0, 0), cB, voffB); PG8_STAGE(PG8_SB(0, 1), cB + hstepB, voffB); PG8_STAGE(PG8_SA(0, 0), cA, voffA); PG8_STAGE(PG8_SA(0, 1), cA + hstepA, voffA);
        if (wr == 1) PG8_BAR;
        PG8_WAIT_V(2); PG8_BAR;
        PG8_STAGE(PG8_SB(1, 0), cB + kstep, voffB); PG8_STAGE(PG8_SA(1, 0), cA + kstep, voffA); PG8_STAGE(PG8_SB(1, 1), cB + hstepB + kstep, voffB);
        PG8_WAIT_V(6); PG8_BAR;
    } else {
        PG8_STAGE(PG8_SB(0, 0), cB, voffB); PG8_STAGE(PG8_SA(0, 0), cA, voffA); PG8_STAGE(PG8_SB(0, 1), cB + hstepB, voffB); PG8_STAGE(PG8_SA(0, 1), cA + hstepA, voffA);
        if (wr == 1) PG8_BAR;
        PG8_WAIT_V(4); PG8_BAR;
        PG8_STAGE(PG8_SB(1, 0), cB + kstep, voffB); PG8_STAGE(PG8_SA(1, 0), cA + kstep, voffA); PG8_STAGE(PG8_SB(1, 1), cB + hstepB + kstep, voffB);
        PG8_WAIT_V(6); PG8_BAR;
    }
    asm volatile(".p2align 8" ::: "memory");
    for (;;) {
        const bool has_next = S.next(ui + 1, nxt);
        const char* nA = has_next ? (const char*)g.A + (size_t)nxt.pm * tstepA : cA; const char* nB = has_next ? (const char*)g.Bt + (size_t)nxt.pn * tstepB : cB;
        for (int t = 0; t < nt; t += 2) {
            const bool last = (t == nt - 2);
            const char* a1 = cA + (size_t)(t + 1) * kstep;
            const char* a2 = last ? nA : cA + (size_t)(t + 2) * kstep; const char* b2 = last ? nB : cB + (size_t)(t + 2) * kstep;
            const char* a3 = a2 + kstep; const char* b3 = b2 + kstep;
            if (last && has_next) S.a_ready(nxt);
            if constexpr (SP2) {
            PG8_LDB(B0, 0, 0); PG8_LDB(B1, 0, 1); PG8_SCHED; PG8_LDA(At, 0, 0); PG8_STAGE(PG8_SA(1, 1), a1 + hstepA, voffA);
            PG8_WAIT_V(8); PG8_WAIT_L(0); PG8_BAR; PG8_MMA(0, 0, At, B0); PG8_MMA(0, 1, At, B1); PG8_BAR; PG8_SCHED;
            PG8_LDA(At, 0, 1); PG8_STAGE(PG8_SB(0, 0), b2, voffB); PG8_STAGE(PG8_SB(0, 1), b2 + hstepB, voffB); PG8_STAGE(PG8_SA(0, 0), a2, voffA);
            PG8_WAIT_V(8); PG8_WAIT_L(0); PG8_BAR; PG8_MMA(1, 0, At, B0); PG8_MMA(1, 1, At, B1); PG8_BAR; PG8_SCHED;
            PG8_LDB(B0, 1, 0); PG8_LDB(B1, 1, 1); PG8_SCHED; PG8_LDA(At, 1, 0); PG8_STAGE(PG8_SA(0, 1), a2 + hstepA, voffA);
            PG8_WAIT_V(8); PG8_WAIT_L(0); PG8_BAR; PG8_MMA(0, 0, At, B0); PG8_MMA(0, 1, At, B1); PG8_BAR; PG8_SCHED;
            PG8_LDA(At, 1, 1); PG8_STAGE(PG8_SB(1, 0), b3, voffB); PG8_STAGE(PG8_SB(1, 1), b3 + hstepB, voffB); PG8_STAGE(PG8_SA(1, 0), a3, voffA);
            PG8_WAIT_V(8); PG8_WAIT_L(0); PG8_BAR; PG8_MMA(1, 0, At, B0); PG8_MMA(1, 1, At, B1); PG8_BAR; PG8_SCHED;
            } else {
            PG8_LDB(B0, 0, 0); PG8_SCHED; PG8_LDA(At, 0, 0); PG8_STAGE(PG8_SA(1, 1), a1 + hstepA, voffA);
            PG8_WAIT_L(8); PG8_BAR; PG8_WAIT_L(0); PG8_MMA(0, 0, At, B0); PG8_BAR; PG8_SCHED;
            PG8_LDB(B1, 0, 1); PG8_STAGE(PG8_SB(0, 0), b2, voffB);
            PG8_BAR; PG8_WAIT_L(0); PG8_MMA(0, 1, At, B1); PG8_BAR;
            PG8_LDA(At, 0, 1); PG8_STAGE(PG8_SA(0, 0), a2, voffA);
            PG8_BAR; PG8_WAIT_L(0); PG8_MMA(1, 0, At, B0); PG8_BAR; PG8_SCHED;
            PG8_STAGE(PG8_SB(0, 1), b2 + hstepB, voffB);
            PG8_WAIT_V(6); PG8_BAR; PG8_MMA(1, 1, At, B1); PG8_BAR;
            PG8_LDB(B0, 1, 0); PG8_SCHED; PG8_LDA(At, 1, 0); PG8_STAGE(PG8_SA(0, 1), a2 + hstepA, voffA);
            PG8_WAIT_L(8); PG8_BAR; PG8_WAIT_L(0); PG8_MMA(0, 0, At, B0); PG8_BAR; PG8_SCHED;
            PG8_LDB(B1, 1, 1); PG8_STAGE(PG8_SB(1, 0), b3, voffB);
            PG8_BAR; PG8_WAIT_L(0); PG8_MMA(0, 1, At, B1); PG8_BAR;
            PG8_LDA(At, 1, 1); PG8_STAGE(PG8_SA(1, 0), a3, voffA);
            PG8_BAR; PG8_WAIT_L(0); PG8_MMA(1, 0, At, B0); PG8_BAR; PG8_SCHED;
            PG8_STAGE(PG8_SB(1, 1), b3 + hstepB, voffB);
            PG8_WAIT_V(6); PG8_BAR; PG8_MMA(1, 1, At, B1); PG8_BAR;
            }
        }
        if constexpr (ALIGN_EPI) { if (wr == 0) PG8_BAR; }
        if constexpr (!Epi::AFTER_DRAIN) { int l2_; asm volatile("v_mbcnt_lo_u32_b32 %0, -1, 0\n\tv_mbcnt_hi_u32_b32 %0, -1, %0" : "=v"(l2_)); E(acc, cur, wr, wc, l2_ & 15, l2_ >> 4); S.done(cur); }
        if (!has_next) break;
#pragma unroll
        for (int a = 0; a < 2; ++a)
#pragma unroll
            for (int b = 0; b < 2; ++b)
#pragma unroll
                for (int m = 0; m < 4; ++m)
#pragma unroll
                    for (int n = 0; n < 2; ++n) acc[a][b][m][n] = (f32x4){0.f, 0.f, 0.f, 0.f};
        cur = nxt; cA = nA; cB = nB; ++ui;
        if constexpr (ALIGN_EPI) { if (wr == 1) PG8_BAR; }
    }
    PG8_WAIT_V(0);
    if constexpr (!ALIGN_EPI) { if (wr == 0) PG8_BAR; }
    PG8_BAR;
    if constexpr (Epi::AFTER_DRAIN) { E.fused(acc, cur, wr, wc, fr, fq, lds, wid, lane); S.done(cur); }
#undef PG8_SA
#undef PG8_SB
#undef PG8_STAGE
#undef PG8_LDA
#undef PG8_LDB
#undef PG8_MMA
#undef PG8_WAIT_V
#undef PG8_WAIT_L
#undef PG8_BAR
#undef PG8_SCHED
}
}

#define LAS __attribute__((address_space(3)))
typedef unsigned short bf16_t;
typedef short bf16x8 __attribute__((ext_vector_type(8)));
typedef float f32x4 __attribute__((ext_vector_type(4)));
typedef float f32x2 __attribute__((ext_vector_type(2)));
typedef float f32x16 __attribute__((ext_vector_type(16)));
typedef unsigned u32x4 __attribute__((ext_vector_type(4)));
typedef unsigned u32x2 __attribute__((ext_vector_type(2)));
typedef __bf16 bf16x2_t __attribute__((ext_vector_type(2)));

constexpr int NB = 2, SEQ = 16384, DM = 1024, NL = 4, MT = NB * SEQ;
constexpr int INC = 5632, PJ = 2048, GP = 3072, FF = 2816;
constexpr float EPS = 1e-6f, LOG2E = 1.4426950408889634f;
constexpr size_t MiB = 1u << 20;
constexpr size_t WS_SSQA = 1 * MiB, WS_SSQB = 3 * MiB, WS_AGG = 5 * MiB, WS_SMALL = 6 * MiB;
constexpr size_t WS_W0 = 8 * MiB, WS_WSZ = 32 * MiB;
constexpr size_t WS_XB = 72 * MiB, WS_PROJ = 136 * MiB, WS_VT = 264 * MiB, WS_GATES = 296 * MiB, WS_END = 488 * MiB;
constexpr size_t W_IN = 0, W_PA = 11 * MiB, W_PB = W_PA + MiB / 2, W_PC = 12 * MiB, W_O = 13 * MiB, W_FF = 15 * MiB, W_DN = 26 * MiB;
constexpr int SMALL_PER_LAYER = 16384 + 16384 + 65536;
constexpr int LDS_BYTES = 147456, MISC_OFF = 131072 + 320;
constexpr int CW_BAR = 4096; constexpr size_t CTL_ZERO_BYTES = 65536;

__device__ __forceinline__ unsigned pk2(float lo, float hi) { f32x2 v = {lo, hi}; bf16x2_t b = __builtin_convertvector(v, bf16x2_t); return __builtin_bit_cast(unsigned, b); }
__device__ __forceinline__ bf16_t f2bf(float f) { unsigned u = __builtin_bit_cast(unsigned, f); return (bf16_t)((u + 0x7fffu + ((u >> 16) & 1u)) >> 16); }
__device__ __forceinline__ float bf2f(bf16_t b) { return __builtin_bit_cast(float, (unsigned)b << 16); }
__device__ __forceinline__ float bflo(unsigned w) { return __builtin_bit_cast(float, w << 16); }
__device__ __forceinline__ float bfhi(unsigned w) { return __builtin_bit_cast(float, w & 0xffff0000u); }
__device__ __forceinline__ float fsigmoid(float x) { return __builtin_amdgcn_rcpf(1.f + __builtin_amdgcn_exp2f(-x * LOG2E)); }
__device__ __forceinline__ float shx(float v, int mask, int lane) { return __builtin_bit_cast(float, __builtin_amdgcn_ds_bpermute((lane ^ mask) << 2, __builtin_bit_cast(int, v))); }
__device__ __forceinline__ float wave_sum(float v, int lane) {
#pragma unroll
    for (int o = 1; o < 64; o <<= 1) v += shx(v, o, lane);
    return v;
}
__device__ __forceinline__ int crow(int r, int hi) { return (r & 3) + 8 * (r >> 2) + 4 * hi; }
#define MFMA32(a, b, c) __builtin_amdgcn_mfma_f32_32x32x16_bf16((a), (b), (c), 0, 0, 0)
__device__ __forceinline__ bf16x8 pack8(float a0, float a1, float a2, float a3, float a4, float a5, float a6, float a7) {
    u32x4 p; p.x = pk2(a0, a1); p.y = pk2(a2, a3); p.z = pk2(a4, a5); p.w = pk2(a6, a7); return __builtin_bit_cast(bf16x8, p);
}

namespace pg8 {
__device__ __forceinline__ float row_rstd(const float* ssq, int r) {
    const f32x4* p = (const f32x4*)(ssq + (size_t)r * 16);
    const f32x4 a = p[0], b = p[1], c = p[2], d = p[3];
    const float s = ((a[0] + a[1]) + (a[2] + a[3])) + ((b[0] + b[1]) + (b[2] + b[3])) + ((c[0] + c[1]) + (c[2] + c[3])) + ((d[0] + d[1]) + (d[2] + d[3]));
    return __builtin_amdgcn_rsqf(s * (1.f / 1024.f) + EPS);
}
__device__ __forceinline__ u32x4 pack_f8(const f32x4 v0, const f32x4 v1) { u32x4 w; w.x = pk2(v0[0], v0[1]); w.y = pk2(v0[2], v0[3]); w.z = pk2(v1[0], v1[1]); w.w = pk2(v1[2], v1[3]); return w; }

struct EpiInProj {
    static constexpr bool PERM = true, AFTER_DRAIN = false;
    bf16_t* proj; bf16_t* vt; bf16_t* gates; const float* ssq; const float* bgate; const float* qg; const float* kg;
    __device__ __forceinline__ void operator()(const f32x4 (&acc)[2][2][4][2], const Unit& u, int wr, int wc, int fr, int fq) const {
        const int row0 = u.pm * BM + wr * 64 + fr, cin = wc * 32 + 8 * fq;
        if (u.pn >= 4 && u.pn < 8) {
            const int G = 4 * (u.pn - 4) + wc, ln_ = fr | (fq << 4); const bool isq = u.pn < 6;
            const float* gp = (isq ? qg : kg) + 8 * fq; const float gs = isq ? (0.125f * LOG2E) : 1.f;
            const f32x4 g00 = *(const f32x4*)gp * gs, g01 = *(const f32x4*)(gp + 4) * gs, g10 = *(const f32x4*)(gp + 32) * gs, g11 = *(const f32x4*)(gp + 36) * gs;
#pragma unroll
            for (int ai = 0; ai < 2; ++ai)
#pragma unroll
                for (int m = 0; m < 4; ++m) { const int r = row0 + ai * HALF + m * 16; const float rs = row_rstd(ssq, r); bf16_t* rowp = proj + (size_t)r * PJ + 1024 + 64 * G + 8 * fq;
                    f32x4 a0 = acc[ai][0][m][0] * rs, a1 = acc[ai][0][m][1] * rs, b0 = acc[ai][1][m][0] * rs, b1 = acc[ai][1][m][1] * rs;
                    float ss = (a0[0] * a0[0] + a0[1] * a0[1]) + (a0[2] * a0[2] + a0[3] * a0[3]) + (a1[0] * a1[0] + a1[1] * a1[1]) + (a1[2] * a1[2] + a1[3] * a1[3])
                             + (b0[0] * b0[0] + b0[1] * b0[1]) + (b0[2] * b0[2] + b0[3] * b0[3]) + (b1[0] * b1[0] + b1[1] * b1[1]) + (b1[2] * b1[2] + b1[3] * b1[3]);
                    ss += shx(ss, 16, ln_); ss += shx(ss, 32, ln_);
                    const float rq = __builtin_amdgcn_rsqf(ss * (1.f / 64.f) + EPS);
                    *(u32x4*)rowp = pack_f8(a0 * (g00 * rq), a1 * (g01 * rq)); *(u32x4*)(rowp + 32) = pack_f8(b0 * (g10 * rq), b1 * (g11 * rq)); }
        } else if (u.pn < 8) {
#pragma unroll
            for (int ai = 0; ai < 2; ++ai)
#pragma unroll
                for (int m = 0; m < 4; ++m) { const int r = row0 + ai * HALF + m * 16; const float rs = row_rstd(ssq, r); bf16_t* rowp = proj + (size_t)r * PJ + u.pn * BM + cin;
#pragma unroll
                    for (int bj = 0; bj < 2; ++bj) *(u32x4*)(rowp + bj * HALF) = pack_f8(acc[ai][bj][m][0] * rs, acc[ai][bj][m][1] * rs); }
        } else if (u.pn < 10) {
#pragma unroll
            for (int ai = 0; ai < 2; ++ai)
#pragma unroll
                for (int m = 0; m < 4; ++m) { const int r = row0 + ai * HALF + m * 16; const float rs = row_rstd(ssq, r);
                    const int b = r >> 14, s = r & (SEQ - 1), ko = s & 15, gq = ko >> 2, sg = (gq == 1) ? 2 : ((gq == 2) ? 1 : gq), slot = (s & ~15) | (sg * 4 + (ko & 3));
#pragma unroll
                    for (int bj = 0; bj < 2; ++bj) { const int head = (u.pn - 8) * 2 + bj; bf16_t* base = vt + ((size_t)((b * 4 + head) * 128 + cin)) * SEQ + slot;
                        const f32x4 v0 = acc[ai][bj][m][0] * rs, v1 = acc[ai][bj][m][1] * rs;
                        base[0] = f2bf(v0[0]); base[(size_t)SEQ] = f2bf(v0[1]); base[(size_t)2 * SEQ] = f2bf(v0[2]); base[(size_t)3 * SEQ] = f2bf(v0[3]);
                        base[(size_t)4 * SEQ] = f2bf(v1[0]); base[(size_t)5 * SEQ] = f2bf(v1[1]); base[(size_t)6 * SEQ] = f2bf(v1[2]); base[(size_t)7 * SEQ] = f2bf(v1[3]); } }
        } else {
            const int colg = (u.pn - 10) * BM + cin;
            f32x4 bv[2][2];
#pragma unroll
            for (int bj = 0; bj < 2; ++bj) { bv[bj][0] = *(const f32x4*)(bgate + colg + bj * HALF); bv[bj][1] = *(const f32x4*)(bgate + colg + bj * HALF + 4); }
#pragma unroll
            for (int ai = 0; ai < 2; ++ai)
#pragma unroll
                for (int m = 0; m < 4; ++m) { const int r = row0 + ai * HALF + m * 16; const float rs = row_rstd(ssq, r); unsigned char* rowp = (unsigned char*)gates + (size_t)r * GP + colg;
#pragma unroll
                    for (int bj = 0; bj < 2; ++bj) { const f32x4 v0 = acc[ai][bj][m][0] * rs + bv[bj][0], v1 = acc[ai][bj][m][1] * rs + bv[bj][1];
                        unsigned w0 = 0u, w1 = 0u;
#pragma unroll
                        for (int e = 0; e < 4; ++e) { w0 |= (unsigned)(fsigmoid(v0[e]) * 255.f + 0.5f) << (8 * e); w1 |= (unsigned)(fsigmoid(v1[e]) * 255.f + 0.5f) << (8 * e); }
                        u32x2 w; w.x = w0; w.y = w1; *(u32x2*)(rowp + bj * HALF) = w; } }
        }
    }
};
template <int BR> struct EpiMerge {
    static constexpr bool PERM = true, AFTER_DRAIN = false;
    const bf16_t* gates; bf16_t* merged;
    __device__ __forceinline__ void operator()(const f32x4 (&acc)[2][2][4][2], const Unit& u, int wr, int wc, int fr, int fq) const {
        const int row0 = u.pm * BM + wr * 64 + fr, cin = wc * 32 + 8 * fq;
#pragma unroll
        for (int ai = 0; ai < 2; ++ai) {
            u32x2 gv[4][2]; u32x4 pv[4][2];
#pragma unroll
            for (int m = 0; m < 4; ++m)
#pragma unroll
                for (int bj = 0; bj < 2; ++bj) { const int r = row0 + ai * HALF + m * 16, col = u.pn * BM + bj * HALF + cin;
                    gv[m][bj] = *(const u32x2*)((const unsigned char*)gates + (size_t)r * GP + BR * 1024 + col);
                    if (BR > 0) pv[m][bj] = *(const u32x4*)(merged + (size_t)r * DM + col); }
#pragma unroll
            for (int m = 0; m < 4; ++m)
#pragma unroll
                for (int bj = 0; bj < 2; ++bj) { const int r = row0 + ai * HALF + m * 16, col = u.pn * BM + bj * HALF + cin;
                    const u32x2 g = gv[m][bj];
                    f32x4 o0 = {0.f, 0.f, 0.f, 0.f}, o1 = {0.f, 0.f, 0.f, 0.f};
                    if (BR > 0) { const u32x4 p = pv[m][bj]; o0 = (f32x4){bflo(p.x), bfhi(p.x), bflo(p.y), bfhi(p.y)}; o1 = (f32x4){bflo(p.z), bfhi(p.z), bflo(p.w), bfhi(p.w)}; }
                    const float k255 = 1.f / 255.f;
                    const f32x4 g0 = {(float)(g.x & 255u) * k255, (float)((g.x >> 8) & 255u) * k255, (float)((g.x >> 16) & 255u) * k255, (float)(g.x >> 24) * k255};
                    const f32x4 g1 = {(float)(g.y & 255u) * k255, (float)((g.y >> 8) & 255u) * k255, (float)((g.y >> 16) & 255u) * k255, (float)(g.y >> 24) * k255};
                    o0 += g0 * acc[ai][bj][m][0]; o1 += g1 * acc[ai][bj][m][1];
                    *(u32x4*)(merged + (size_t)r * DM + col) = pack_f8(o0, o1); }
            asm volatile("" ::: "memory"); }
    }
};
struct EpiResid {
    static constexpr bool PERM = true, AFTER_DRAIN = false;
    const float* x32; const bf16_t* x16; float* o32; bf16_t* oa; bf16_t* ob; float* ssq;
    __device__ __forceinline__ void operator()(const f32x4 (&acc)[2][2][4][2], const Unit& u, int wr, int wc, int fr, int fq) const {
        const int row0 = u.pm * BM + wr * 64 + fr, cin = wc * 32 + 8 * fq;
#pragma unroll
        for (int ai = 0; ai < 2; ++ai)
#pragma unroll
            for (int m = 0; m < 4; ++m) { const int r = row0 + ai * HALF + m * 16; float ss = 0.f;
#pragma unroll
                for (int bj = 0; bj < 2; ++bj) { const size_t off = (size_t)r * DM + u.pn * BM + bj * HALF + cin;
                    f32x4 x0, x1;
                    if (x32) { x0 = *(const f32x4*)(x32 + off); x1 = *(const f32x4*)(x32 + off + 4); }
                    else { const u32x4 p = *(const u32x4*)(x16 + off); x0 = (f32x4){bflo(p.x), bfhi(p.x), bflo(p.y), bfhi(p.y)}; x1 = (f32x4){bflo(p.z), bfhi(p.z), bflo(p.w), bfhi(p.w)}; }
                    x0 += acc[ai][bj][m][0]; x1 += acc[ai][bj][m][1];
                    if (o32) { *(f32x4*)(o32 + off) = x0; *(f32x4*)(o32 + off + 4) = x1; }
                    const u32x4 pk = pack_f8(x0, x1);
                    if (oa) *(u32x4*)(oa + off) = pk;
                    if (ob) *(u32x4*)(ob + off) = pk;
                    ss += (x0[0] * x0[0] + x0[1] * x0[1]) + (x0[2] * x0[2] + x0[3] * x0[3]) + (x1[0] * x1[0] + x1[1] * x1[1]) + (x1[2] * x1[2] + x1[3] * x1[3]); }
                { const int ln_ = fr | (fq << 4); ss += shx(ss, 16, ln_); ss += shx(ss, 32, ln_); }
                if (fq == 0) ssq[(size_t)r * 16 + u.pn * 4 + wc] = ss;
                asm volatile("" ::: "memory"); }
    }
};
struct EpiFfn1 {
    static constexpr bool PERM = true, AFTER_DRAIN = false;
    bf16_t* hid; const float* ssq;
    __device__ __forceinline__ void operator()(const f32x4 (&acc)[2][2][4][2], const Unit& u, int wr, int wc, int fr, int fq) const {
        const int row0 = u.pm * BM + wr * 64 + fr, cin = wc * 32 + 8 * fq;
#pragma unroll
        for (int ai = 0; ai < 2; ++ai)
#pragma unroll
            for (int m = 0; m < 4; ++m) { const int r = row0 + ai * HALF + m * 16; const float rs = row_rstd(ssq, r);
                f32x4 o[2];
#pragma unroll
                for (int n = 0; n < 2; ++n) { const f32x4 g = acc[ai][0][m][n] * rs, up = acc[ai][1][m][n] * rs;
#pragma unroll
                    for (int e = 0; e < 4; ++e) o[n][e] = g[e] * fsigmoid(g[e]) * up[e]; }
                *(u32x4*)(hid + (size_t)r * FF + u.pn * HALF + cin) = pack_f8(o[0], o[1]);
                asm volatile("" ::: "memory"); }
    }
};
}

#define XB_TMO      128
#define XB_XCNT(j)  (256  + 64 * (j))
#define XB_XSUB(j)  (1280 + 64 * (j))
#define XB_XGEN(j)  (2304 + 64 * (j))
#define XB_TOP      3328
#define XB_TOPGEN   3392
#define XCD_BAR_WORDS 3456
#define XB_SPIN_CAP (1u << 18)

__device__ __forceinline__ unsigned xb_ld(unsigned* p)              { return __hip_atomic_load(p, __ATOMIC_RELAXED, __HIP_MEMORY_SCOPE_AGENT); }
__device__ __forceinline__ unsigned xb_add(unsigned* p, unsigned v) { return __hip_atomic_fetch_add(p, v, __ATOMIC_RELAXED, __HIP_MEMORY_SCOPE_AGENT); }
__device__ __forceinline__ unsigned xb_xcc_id() { return (unsigned)__builtin_amdgcn_s_getreg((3 << 11) | 20) & 0xFu; }
#define XB_SPIN(cond, bar) do { unsigned _sp = 0; while (cond) { __builtin_amdgcn_s_sleep(1); \
    if ((++_sp & 255u) == 0u) { if (xb_ld(&(bar)[XB_TMO])) break; if (_sp > XB_SPIN_CAP) { atomicAdd(&(bar)[XB_TMO], 1u); break; } } } } while (0)

struct XcdBarrier {
    unsigned* bar; unsigned x;
    volatile LAS unsigned* st;
};

__device__ __forceinline__ XcdBarrier xcd_barrier_post(unsigned* bar, volatile LAS unsigned* st, bool is0) {
    XcdBarrier b; b.bar = bar; b.x = xb_xcc_id(); b.st = st;
    if (is0) (void)xb_add(&bar[XB_XCNT(b.x)], 1u);
    return b;
}
__device__ __forceinline__ void xcd_barrier_complete(unsigned* bar, unsigned x, unsigned& nloc, unsigned& nx) {
    const unsigned G = gridDim.x * gridDim.y * gridDim.z;
    unsigned sum, cnt, mine, sp = 0u;
    for (;;) {
        sum = 0u; cnt = 0u; mine = 0u;
#pragma unroll
        for (unsigned j = 0; j < 16; ++j) { const unsigned c = xb_ld(&bar[XB_XCNT(j)]); sum += c; cnt += (c > 0u) ? 1u : 0u; mine = (j == x) ? c : mine; }
        if (sum == G) break;
        __builtin_amdgcn_s_sleep(1);
        if ((++sp & 255u) == 0u) { if (xb_ld(&bar[XB_TMO])) break; if (sp > XB_SPIN_CAP) { atomicAdd(&bar[XB_TMO], 1u); break; } }
    }
    nloc = mine > 0u ? mine : 1u; nx = cnt > 0u ? cnt : 1u;
}

__device__ __forceinline__ void xcd_barrier(const XcdBarrier& b, bool is0) {
    asm volatile("s_waitcnt vmcnt(0)" ::: "memory");
    __syncthreads();
    if (is0) {
        unsigned* bar = b.bar;
        __builtin_amdgcn_s_waitcnt(0);
        unsigned nloc = b.st[0], nx = b.st[1];
        if (nloc == 0u) { xcd_barrier_complete(bar, b.x, nloc, nx); b.st[0] = nloc; b.st[1] = nx; }
        const unsigned old = xb_add(&bar[XB_XSUB(b.x)], 1u);
        const unsigned gen = old / nloc;
        if (old + 1u == (gen + 1u) * nloc) {
            __builtin_amdgcn_fence(__ATOMIC_RELEASE, "agent");
            asm volatile("s_waitcnt vmcnt(0)" ::: "memory");
            const unsigned og = xb_add(&bar[XB_TOP], 1u);
            const unsigned tg = og / nx;
            if (og + 1u == (tg + 1u) * nx) xb_add(&bar[XB_TOPGEN], 1u);
            else XB_SPIN(xb_ld(&bar[XB_TOPGEN]) == tg, bar);
            __builtin_amdgcn_fence(__ATOMIC_ACQUIRE, "agent");
            xb_add(&bar[XB_XGEN(b.x)], 1u);
            asm volatile("s_waitcnt vmcnt(0)" ::: "memory");
        } else {
            XB_SPIN(xb_ld(&bar[XB_XGEN(b.x)]) == gen, bar);
            __builtin_amdgcn_fence(__ATOMIC_ACQUIRE, "agent");
            asm volatile("s_waitcnt vmcnt(0)" ::: "memory");
        }
    }
    __syncthreads();
}


struct Args { const float* in[31]; float* out; unsigned char* ws; };
typedef const float* cfptr_t;
__device__ __forceinline__ cfptr_t kin(int i) { const volatile __attribute__((address_space(4))) cfptr_t* p = (const volatile __attribute__((address_space(4))) cfptr_t*)__builtin_amdgcn_kernarg_segment_ptr(); return p[i]; }

struct ConvD { const float* W; const float* gain; bf16_t* dst; int N, k0, n0, ldk, split; };
__device__ __forceinline__ void conv_load(const ConvD& d, LAS float* scr, int tid) {
    const int n4 = tid & 15, kk = tid >> 4;
#pragma unroll
    for (int i = 0; i < 2; ++i) { const int k = kk + 32 * i; f32x4 v = *(const f32x4*)(d.W + (size_t)(d.k0 + k) * d.N + d.n0 + 4 * n4); if (d.gain) v *= d.gain[d.k0 + k];
        LAS float* s = scr + k * 65 + 4 * n4; s[0] = v[0]; s[1] = v[1]; s[2] = v[2]; s[3] = v[3]; }
}
__device__ __forceinline__ void conv_store(const ConvD& d, const LAS float* scr, int tid) {
    const int nn = tid >> 3, c = tid & 7;
    const LAS float* s = scr + (8 * c) * 65 + nn;
    u32x4 o; o.x = pk2(s[0], s[65]); o.y = pk2(s[130], s[195]); o.z = pk2(s[260], s[325]); o.w = pk2(s[390], s[455]);
    *(u32x4*)(d.dst + (size_t)((d.split && nn >= 32) ? nn + 96 : nn) * d.ldk + d.k0 + 8 * c) = o;
}
__device__ __forceinline__ ConvD conv_desc(int it, int l, unsigned char* Wb) {
    ConvD d; d.gain = nullptr; d.split = 0; int r = it;
    if (r < 1408) { const int kb = r / 88, nb = r % 88; const bool qk = (nb >= 16 && nb < 32); const int brow = qk ? (256 * (4 + ((nb - 16) >> 2)) + 32 * ((nb - 16) & 3)) : nb * 64;
        d.W = kin(2) + (size_t)l * DM * INC; d.N = INC; d.k0 = kb * 64; d.n0 = nb * 64; d.dst = (bf16_t*)(Wb + W_IN) + (size_t)brow * DM; d.ldk = DM; d.gain = kin(1) + l * DM; d.split = qk; return d; } r -= 1408;
    if (r < 64) { const int kb = r / 16, nb = r % 16; d.W = kin(23) + (size_t)l * 256 * DM; d.N = DM; d.k0 = kb * 64; d.n0 = nb * 64; d.dst = (bf16_t*)(Wb + W_PA) + (size_t)nb * 64 * 256; d.ldk = 256; return d; } r -= 64;
    if (r < 64) { const int kb = r / 16, nb = r % 16; d.W = kin(24) + (size_t)l * 256 * DM; d.N = DM; d.k0 = kb * 64; d.n0 = nb * 64; d.dst = (bf16_t*)(Wb + W_PB) + (size_t)nb * 64 * 256; d.ldk = 256; return d; } r -= 64;
    if (r < 128) { const int kb = r / 16, nb = r % 16; d.W = kin(25) + (size_t)l * 512 * DM; d.N = DM; d.k0 = kb * 64; d.n0 = nb * 64; d.dst = (bf16_t*)(Wb + W_PC) + (size_t)nb * 64 * 512; d.ldk = 512; return d; } r -= 128;
    if (r < 256) { const int kb = r / 16, nb = r % 16; d.W = kin(26) + (size_t)l * DM * DM; d.N = DM; d.k0 = kb * 64; d.n0 = nb * 64; d.dst = (bf16_t*)(Wb + W_O) + (size_t)nb * 64 * DM; d.ldk = DM; return d; } r -= 256;
    if (r < 704) { const int kb = r / 44, nb = r % 44; d.W = kin(28) + (size_t)l * DM * FF; d.N = FF; d.k0 = kb * 64; d.n0 = nb * 64; d.dst = (bf16_t*)(Wb + W_FF) + (size_t)(256 * (nb >> 1) + 64 * (nb & 1)) * DM; d.ldk = DM; d.gain = kin(27) + l * DM; return d; } r -= 704;
    if (r < 704) { const int kb = r / 44, nb = r % 44; d.W = kin(29) + (size_t)l * DM * FF; d.N = FF; d.k0 = kb * 64; d.n0 = nb * 64; d.dst = (bf16_t*)(Wb + W_FF) + (size_t)(256 * (nb >> 1) + 128 + 64 * (nb & 1)) * DM; d.ldk = DM; d.gain = kin(27) + l * DM; return d; } r -= 704;
    { const int kb = r / 16, nb = r % 16; d.W = kin(30) + (size_t)l * FF * DM; d.N = DM; d.k0 = kb * 64; d.n0 = nb * 64; d.dst = (bf16_t*)(Wb + W_DN) + (size_t)nb * 64 * FF; d.ldk = FF; return d; }
}
__device__ __forceinline__ void convert_layer(int l, unsigned char* Wb, LAS float* scr, int tid, int bid, int G) {
    for (int it = bid; it < 4032; it += 6 * G) {
        const ConvD d0 = conv_desc(it, l, Wb);
        const bool v1 = it + G < 4032, v2 = it + 2 * G < 4032, v3 = it + 3 * G < 4032, v4 = it + 4 * G < 4032, v5 = it + 5 * G < 4032;
        const ConvD d1 = conv_desc(v1 ? it + G : it, l, Wb), d2 = conv_desc(v2 ? it + 2 * G : it, l, Wb), d3 = conv_desc(v3 ? it + 3 * G : it, l, Wb), d4 = conv_desc(v4 ? it + 4 * G : it, l, Wb), d5 = conv_desc(v5 ? it + 5 * G : it, l, Wb);
        conv_load(d0, scr, tid); if (v1) conv_load(d1, scr + 4160, tid); if (v2) conv_load(d2, scr + 2 * 4160, tid); if (v3) conv_load(d3, scr + 3 * 4160, tid); if (v4) conv_load(d4, scr + 4 * 4160, tid); if (v5) conv_load(d5, scr + 5 * 4160, tid);
        __syncthreads();
        conv_store(d0, scr, tid); if (v1) conv_store(d1, scr + 4160, tid); if (v2) conv_store(d2, scr + 2 * 4160, tid); if (v3) conv_store(d3, scr + 3 * 4160, tid); if (v4) conv_store(d4, scr + 4 * 4160, tid); if (v5) conv_store(d5, scr + 5 * 4160, tid);
        __syncthreads();
    }
}
__device__ __forceinline__ void convert_small(bf16_t* sm, int tid, int bid, int G) {
    for (int idx = bid * 512 + tid; idx < NL * SMALL_PER_LAYER; idx += G * 512) {
        const int l = idx / SMALL_PER_LAYER, e = idx % SMALL_PER_LAYER; float v;
        if (e < 32768) { const int e2 = e & 16383, hd = e2 >> 12, o = (e2 >> 6) & 63, i = e2 & 63; const float* src = (e < 16384) ? kin(6) : kin(8); v = src[(size_t)((l * 4 + hd) * 64 + i) * 64 + o]; }
        else { const int e2 = e - 32768, t = (e2 >> 7) & 127, s = e2 & 127; v = (s <= t) ? kin(13)[(size_t)l * 65536 + e2] : 0.f; }
        sm[idx] = f2bf(v);
    }
}
__device__ __forceinline__ void x_pass(const float* x, bf16_t* xb, float* ssq, int lane, int gw, int NGW) {
    for (int m0 = gw; m0 < MT; m0 += 4 * NGW) {
        f32x4 v[4][4];
#pragma unroll
        for (int q = 0; q < 4; ++q) { const int m = m0 + q * NGW; const f32x4* xr = (const f32x4*)(x + (size_t)(m < MT ? m : m0) * DM) + lane;
#pragma unroll
            for (int j = 0; j < 4; ++j) v[q][j] = xr[64 * j]; }
#pragma unroll
        for (int q = 0; q < 4; ++q) { const int m = m0 + q * NGW; if (m >= MT) break;
            u32x2* o = (u32x2*)(xb + (size_t)m * DM) + lane; float ss = 0.f;
#pragma unroll
            for (int j = 0; j < 4; ++j) { const f32x4 t = v[q][j]; ss += (t[0] * t[0] + t[1] * t[1]) + (t[2] * t[2] + t[3] * t[3]); u32x2 w; w.x = pk2(t[0], t[1]); w.y = pk2(t[2], t[3]); o[64 * j] = w; }
            ss = wave_sum(ss, lane);
            if (lane < 16) ssq[(size_t)m * 16 + lane] = (lane == 0) ? ss : 0.f; }
    }
}
__device__ __forceinline__ void qk_norm(bf16_t* proj, bf16_t* outp, int opitch, const float* qg, const float* kg, int lane, int gw, int NGW) {
    const int d0 = (lane * 8) & 63; float gq[8], gk[8];
#pragma unroll
    for (int e = 0; e < 8; ++e) { gq[e] = qg[d0 + e] * (0.125f * LOG2E); gk[e] = kg[d0 + e]; }
    for (int m = gw; m < MT; m += NGW) {
        bf16_t* base = proj + (size_t)m * PJ + 1024;
#pragma unroll
        for (int i = 0; i < 2; ++i) { const u32x4* p = (const u32x4*)(base + (lane + 64 * i) * 8); const u32x4 v = *p; u32x4* po = (u32x4*)(outp + (size_t)m * opitch + (lane + 64 * i) * 8);
            float f[8] = {bflo(v.x), bfhi(v.x), bflo(v.y), bfhi(v.y), bflo(v.z), bfhi(v.z), bflo(v.w), bfhi(v.w)};
            float ss = 0.f;
#pragma unroll
            for (int e = 0; e < 8; ++e) ss += f[e] * f[e];
            ss += shx(ss, 1, lane); ss += shx(ss, 2, lane); ss += shx(ss, 4, lane);
            const float rs = __builtin_amdgcn_rsqf(ss * (1.f / 64.f) + EPS);
#pragma unroll
            for (int e = 0; e < 8; ++e) f[e] *= rs * (i == 0 ? gq[e] : gk[e]);
            u32x4 w; w.x = pk2(f[0], f[1]); w.y = pk2(f[2], f[3]); w.z = pk2(f[4], f[5]); w.w = pk2(f[6], f[7]); *po = w; }
    }
}

constexpr int LRU_XA = 0, LRU_XP = 528, LRU_CW = 35392;
struct LruP { const float *cw, *cb, *ba, *bi, *lam; const bf16_t *waT, *wiT; };
template <bool FINAL> __device__ __forceinline__ void lru_unit(LAS unsigned char* lds, bf16_t* proj, bf16_t* outp, int opitch, float* agg, const LruP& P, int b, int chunk, int tid) {
    const int lane = tid & 63, r = lane & 31, h = lane >> 5, w = __builtin_amdgcn_readfirstlane(tid >> 6), hd = w >> 1, cbk = w & 1;
    const size_t Rb = (size_t)b * SEQ; const int t0 = chunk * 64;
    { u32x4 xv[5];
#pragma unroll
      for (int i = 0; i < 5; ++i) { const int c = tid + 512 * i, j = c >> 5, cc = c & 31, tok = t0 - 3 + j; xv[i] = (u32x4){0u, 0u, 0u, 0u};
          if (c < 67 * 32 && tok >= 0) xv[i] = *(const u32x4*)(proj + (Rb + tok) * PJ + cc * 8); }
#pragma unroll
      for (int i = 0; i < 5; ++i) { const int c = tid + 512 * i, j = c >> 5, cc = c & 31; if (c < 67 * 32) *(LAS u32x4*)(lds + LRU_XA + j * LRU_XP + cc * 16) = xv[i]; } }
    LAS float* CWl = (LAS float*)(lds + LRU_CW);
    for (int i = tid; i < 1280; i += 512) CWl[i] = (i < 1024) ? P.cw[i] : P.cb[i - 1024];
    __syncthreads();
    const int oc = hd * 64 + cbk * 32 + r;
    float Hc = 0.f;
    if (FINAL) {
        const int mid = chunk >> 1, lo = h ? mid : 0, hi2 = h ? chunk : mid; float PA = 1.f, PH = 0.f;
        const f32x2* ap = (const f32x2*)agg + ((size_t)b * 256) * 256 + oc;
        int j = lo;
        for (; j + 48 <= hi2; j += 48) { f32x2 qv[48];
#pragma unroll
            for (int i = 0; i < 48; ++i) qv[i] = ap[(size_t)(j + i) * 256];
#pragma unroll
            for (int i = 0; i < 48; ++i) { PH = qv[i].x * PH + qv[i].y; PA *= qv[i].x; } }
        for (; j + 8 <= hi2; j += 8) { f32x2 qv[8];
#pragma unroll
            for (int i = 0; i < 8; ++i) qv[i] = ap[(size_t)(j + i) * 256];
#pragma unroll
            for (int i = 0; i < 8; ++i) { PH = qv[i].x * PH + qv[i].y; PA *= qv[i].x; } }
        for (; j < hi2; ++j) { const f32x2 q = ap[(size_t)j * 256]; PH = q.x * PH + q.y; PA *= q.x; }
        const float oPA = shx(PA, 32, lane), oPH = shx(PH, 32, lane);
        Hc = h ? (PA * oPH + PH) : (oPA * PH + oPH);
        asm volatile("" : "+v"(Hc));
    }
    const float cw0 = CWl[oc], cw1 = CWl[256 + oc], cw2 = CWl[512 + oc], cw3 = CWl[768 + oc], cbv = CWl[1024 + oc];
    const float bav = P.ba[oc], biv = P.bi[oc], elam = __builtin_amdgcn_exp2f(-P.lam[oc] * LOG2E), cl = -8.f * ((elam < 0.03f) ? elam * (1.f - elam * (0.5f - elam * (0.33333334f - elam * 0.25f))) : __builtin_amdgcn_logf(1.f + elam) * 0.6931471805599453f);
    float av[2][16], bv[2][16];
#pragma unroll
    for (int rb = 0; rb < 2; ++rb) { f32x16 acca = (f32x16){}, acci = (f32x16){};
#pragma unroll
        for (int ks = 0; ks < 4; ++ks) { const int ci0 = hd * 64 + 16 * ks + 8 * h;
            const bf16x8 waf = *(const bf16x8*)(P.waT + (size_t)oc * 64 + 16 * ks + 8 * h), wif = *(const bf16x8*)(P.wiT + (size_t)oc * 64 + 16 * ks + 8 * h);
            const f32x4 c0 = *(const LAS f32x4*)(CWl + 1024 + ci0), c1 = *(const LAS f32x4*)(CWl + 1024 + ci0 + 4);
            float xc[8] = {c0[0], c0[1], c0[2], c0[3], c1[0], c1[1], c1[2], c1[3]};
#pragma unroll
            for (int tap = 0; tap < 4; ++tap) { const u32x4 xv = *(const LAS u32x4*)(lds + LRU_XA + (32 * rb + r + tap) * LRU_XP + ci0 * 2);
                const f32x4 w0 = *(const LAS f32x4*)(CWl + tap * 256 + ci0), w1 = *(const LAS f32x4*)(CWl + tap * 256 + ci0 + 4);
                xc[0] += w0[0] * bflo(xv.x); xc[1] += w0[1] * bfhi(xv.x); xc[2] += w0[2] * bflo(xv.y); xc[3] += w0[3] * bfhi(xv.y);
                xc[4] += w1[0] * bflo(xv.z); xc[5] += w1[1] * bfhi(xv.z); xc[6] += w1[2] * bflo(xv.w); xc[7] += w1[3] * bfhi(xv.w); }
            const bf16x8 af = pack8(xc[0], xc[1], xc[2], xc[3], xc[4], xc[5], xc[6], xc[7]);
            acca = MFMA32(af, waf, acca); acci = MFMA32(af, wif, acci); }
#pragma unroll
        for (int i = 0; i < 16; ++i) { const int tok = 32 * rb + crow(i, h);
            const LAS bf16_t* xp = (const LAS bf16_t*)(lds + LRU_XA + tok * LRU_XP + oc * 2);
            const float xc = cbv + cw0 * bf2f(xp[0]) + cw1 * bf2f(xp[LRU_XP / 2]) + cw2 * bf2f(xp[LRU_XP]) + cw3 * bf2f(xp[3 * LRU_XP / 2]);
            const float rg = fsigmoid(acca[i] + bav), ig = fsigmoid(acci[i] + biv), la = cl * rg;
            const float x2 = 2.f * la;
            const float em1 = (x2 > -0.03f) ? x2 * (1.f + x2 * (0.5f + x2 * (0.16666667f + x2 * 0.041666668f))) : (__builtin_amdgcn_exp2f(x2 * LOG2E) - 1.f);
            av[rb][i] = __builtin_amdgcn_exp2f(la * LOG2E); bv[rb][i] = __builtin_amdgcn_sqrtf(-em1) * ig * xc; }
#pragma unroll
        for (int i = 0; i < 16; ++i) asm volatile("" : "+v"(av[rb][i]), "+v"(bv[rb][i]));
    }
    float Ag[8], Bg[8];
#pragma unroll
    for (int k = 0; k < 8; ++k) { const int rb = k >> 2, i0 = 4 * (k & 3);
        Ag[k] = (av[rb][i0] * av[rb][i0 + 1]) * (av[rb][i0 + 2] * av[rb][i0 + 3]);
        Bg[k] = ((bv[rb][i0] * av[rb][i0 + 1] + bv[rb][i0 + 1]) * av[rb][i0 + 2] + bv[rb][i0 + 2]) * av[rb][i0 + 3] + bv[rb][i0 + 3]; }
    float myin[8]; float Pp = 1.f;
#pragma unroll
    for (int k = 0; k < 8; ++k) { const float pA = shx(Ag[k], 32, lane), pB = shx(Bg[k], 32, lane);
        const float A0 = h ? pA : Ag[k], B0 = h ? pB : Bg[k], A1 = h ? Ag[k] : pA, B1 = h ? Bg[k] : pB;
        const float in0 = Hc; Hc = A0 * Hc + B0; const float in1 = Hc; Hc = A1 * Hc + B1; myin[k] = h ? in1 : in0; Pp *= A0 * A1; }
    if (!FINAL) { if (h == 0) { f32x2 q; q.x = Pp; q.y = Hc; ((f32x2*)agg)[((size_t)b * 256 + chunk) * 256 + oc] = q; } }
    else {
        bf16_t gav[8][4];
#pragma unroll
        for (int k = 0; k < 8; ++k)
#pragma unroll
            for (int j = 0; j < 4; ++j) { const int tok = 32 * (k >> 2) + 8 * (k & 3) + 4 * h + j; gav[k][j] = *(const bf16_t*)(proj + (Rb + t0 + tok) * PJ + 256 + oc); }
#pragma unroll
        for (int k = 0; k < 8; ++k) { const int rb = k >> 2, i0 = 4 * (k & 3); float hh = myin[k];
#pragma unroll
            for (int j = 0; j < 4; ++j) { hh = av[rb][i0 + j] * hh + bv[rb][i0 + j]; const int tok = 32 * rb + 8 * (k & 3) + 4 * h + j;
                const float ga = bf2f(gav[k][j]); bf16_t* go = outp + (Rb + t0 + tok) * opitch + oc;
                const float z = 1.5957691216057308f * (ga + 0.044715f * ga * ga * ga);
                *go = f2bf(hh * ga * fsigmoid(z)); } }
    }
    __syncthreads();
}

constexpr int SG_VP = 272;
struct SgP { const float *lng, *lnb, *sgb; const bf16_t* sgw; };
__device__ __forceinline__ void sg_unit(LAS unsigned char* lds, bf16_t* proj, bf16_t* outp, int opitch, const SgP& P, int n, int tid) {
    const int lane = tid & 63, r = lane & 31, h = lane >> 5, w = __builtin_amdgcn_readfirstlane(tid >> 6);
    const size_t R0 = (size_t)n * 128;
    { const f32x4 g4 = *(const f32x4*)(P.lng + lane * 4), b4 = *(const f32x4*)(P.lnb + lane * 4);
      u32x2 raws[16];
#pragma unroll
      for (int rr = 0; rr < 16; ++rr) raws[rr] = *(const u32x2*)(proj + (R0 + w * 16 + rr) * PJ + 768 + lane * 4);
#pragma unroll
      for (int rr = 0; rr < 16; ++rr) { const int t = w * 16 + rr; const u32x2 raw = raws[rr];
        float v[4] = {bflo(raw.x), bfhi(raw.x), bflo(raw.y), bfhi(raw.y)};
        const float mean = wave_sum((v[0] + v[1]) + (v[2] + v[3]), lane) * (1.f / 256.f);
#pragma unroll
        for (int e = 0; e < 4; ++e) v[e] -= mean;
        const float var = wave_sum((v[0] * v[0] + v[1] * v[1]) + (v[2] * v[2] + v[3] * v[3]), lane) * (1.f / 256.f);
        const float rs = __builtin_amdgcn_rsqf(var + EPS);
#pragma unroll
        for (int e = 0; e < 4; ++e) *(LAS bf16_t*)(lds + (lane * 4 + e) * SG_VP + t * 2) = f2bf(v[e] * rs * g4[e] + b4[e]); } }
    __syncthreads();
    const int g = w >> 1, cbk = w & 1, c = g * 64 + cbk * 32 + r;
#pragma unroll
    for (int tb = 0; tb < 4; ++tb) { f32x16 acc = (f32x16){};
        const bf16_t* wp = P.sgw + (size_t)(g * 128 + 32 * tb + r) * 128 + 8 * h;
#pragma unroll
        for (int ks = 0; ks < 2 * tb + 2; ++ks) { const bf16x8 af = *(const bf16x8*)(wp + 16 * ks); const bf16x8 bfr = *(const LAS bf16x8*)(lds + c * SG_VP + (16 * ks + 8 * h) * 2); acc = MFMA32(af, bfr, acc); }
#pragma unroll
        for (int i = 0; i < 16; ++i) { const int t = 32 * tb + crow(i, h); const bf16_t* up = proj + (R0 + t) * PJ + 512 + c; outp[(R0 + t) * opitch + c] = f2bf(bf2f(*up) * (acc[i] + P.sgb[g * 128 + t])); } }
    __syncthreads();
}

constexpr int AT_SLOT = 16384, AT_K = 0, AT_V = 4 * AT_SLOT, AT_TAB = 131072 + 1024;
__device__ __forceinline__ void glds16(const void* gsrc, unsigned lds_dst) {
    unsigned keep;
    asm volatile("s_mov_b32 %0, m0\n\ts_mov_b32 m0, %2\n\ts_nop 0\n\tglobal_load_lds_dwordx4 %1, off\n\ts_mov_b32 m0, %0" : "=&s"(keep) : "v"(gsrc), "s"(lds_dst) : "memory");
}
__device__ __forceinline__ void at_qk(f32x16& p0, f32x16& p1, const LAS unsigned char* lk, const int (&koff)[4], const bf16x8 (&qf)[4]) {
    const f32x16 z = (f32x16){};
#pragma unroll
    for (int ks = 0; ks < 4; ++ks) { const bf16x8 a0 = *(const LAS bf16x8*)(lk + koff[ks]), a1 = *(const LAS bf16x8*)(lk + koff[ks] + 8192);
        p0 = MFMA32(a0, qf[ks], ks == 0 ? z : p0); p1 = MFMA32(a1, qf[ks], ks == 0 ? z : p1); }
}
__device__ __forceinline__ void at_bias(f32x16& p0, f32x16& p1, const LAS float* tb) {
#pragma unroll
    for (int i = 0; i < 16; ++i) { const int kk = (i & 3) + 8 * (i >> 2); p0[i] += tb[kk]; p1[i] += tb[32 + kk]; }
}
template <bool DOQK, bool DOEXP, bool DOPV, int VAR> __device__ __forceinline__ void at_fused(f32x16& pn0, f32x16& pn1, f32x16& pc0, f32x16& pc1, bf16x8 (&pfc)[4], const bf16x8 (&pfp)[4], f32x16 (&o)[4], float& lsum,
                                         const LAS unsigned char* lk, const LAS unsigned char* lv, const int (&koff)[4], const int (&voff)[4], const bf16x8 (&qf)[4]) {
    constexpr int PD = 6, NF = PD + 1;
    bf16x8 fr[NF];
#define AT_NEED(g) (((g) < 8) ? DOQK : DOPV)
#define AT_FRAG(g) (((g) < 8) ? *(const LAS bf16x8*)(lk + koff[(g) >> 1] + ((g) & 1) * 8192) : *(const LAS bf16x8*)(lv + voff[((g) - 8) >> 2] + (((g) - 8) & 3) * 4096))
#define AT_EX2(x) ((VAR == 1) ? (x) : __builtin_amdgcn_exp2f(x))
#define AT_EXP(e) do { if ((e) < 16) { pc0[(e)] = AT_EX2(pc0[(e)]); s0 += pc0[(e)]; } else { pc1[(e) - 16] = AT_EX2(pc1[(e) - 16]); s1 += pc1[(e) - 16]; } } while (0)
#pragma unroll
    for (int g = 0; g < PD; ++g) { if (AT_NEED(g)) fr[g % NF] = AT_FRAG(g); else fr[g % NF] = (bf16x8){}; }
    float s0 = 0.f, s1 = 0.f;
    const f32x16 z = (f32x16){};
#pragma unroll
    for (int g = 0; g < 24; ++g) {
        if (g + PD < 24 && AT_NEED(g + PD)) fr[(g + PD) % NF] = AT_FRAG(g + PD);
        if (g < 8) { const int ks = g >> 1;
            if (!DOQK || VAR == 2) {} else if (g & 1) pn1 = MFMA32(fr[g % NF], qf[ks], ks == 0 ? z : pn1); else pn0 = MFMA32(fr[g % NF], qf[ks], ks == 0 ? z : pn0);
        } else if (DOPV && VAR != 2) { const int sp = (g - 8) >> 2, db = (g - 8) & 3; o[db] = MFMA32(fr[g % NF], pfp[sp], o[db]); }
        if (DOEXP) {
            const int e0 = g + (g + 2) / 3, e1 = (g + 1) + (g + 3) / 3;
#pragma unroll
            for (int e = e0; e < e1; ++e) AT_EXP(e);
            asm volatile("" : "+v"(s0), "+v"(s1));
            if (g == 6) pfc[0] = pack8(pc0[0], pc0[1], pc0[2], pc0[3], pc0[4], pc0[5], pc0[6], pc0[7]);
            if (g == 12) pfc[1] = pack8(pc0[8], pc0[9], pc0[10], pc0[11], pc0[12], pc0[13], pc0[14], pc0[15]);
            if (g == 18) pfc[2] = pack8(pc1[0], pc1[1], pc1[2], pc1[3], pc1[4], pc1[5], pc1[6], pc1[7]);
        }
        __builtin_amdgcn_sched_barrier(0);
    }
    if (DOEXP) { pfc[3] = pack8(pc1[8], pc1[9], pc1[10], pc1[11], pc1[12], pc1[13], pc1[14], pc1[15]); lsum += s0 + s1; }
#undef AT_FRAG
#undef AT_NEED
#undef AT_EXP
#undef AT_EX2
}
template <int VAR> __device__ __forceinline__ void attn_unit(LAS unsigned char* lds, const bf16_t* proj, const bf16_t* vt, bf16_t* outp, int opitch, int b, int hd, int qb, float lam, float osc, const float* relb, const float* subg, int tid_in) {
    int tid = tid_in; asm volatile("" : "+v"(tid));
    const int lane = tid & 63, r = lane & 31, h = lane >> 5, w = __builtin_amdgcn_readfirstlane(tid >> 6), mp = w >> 2, rs = w & 3;
    LAS float* tab = (LAS float*)(lds + AT_TAB);
    const size_t Rb = (size_t)b * SEQ, R0 = Rb + (size_t)qb * 128;
    const int NT = 2 * qb + 2;
    const bool deep = NT >= 8;
    const int rk0 = 8 * w + (lane >> 4), rk1 = rk0 + 4, rv0 = 16 * w + (lane >> 3), rv1 = rv0 + 8;
    const bf16_t* ks0 = proj + (Rb + rk0) * PJ + 1536 + hd * 128 + (((lane & 15) ^ (rk0 & 15)) * 8);
    const bf16_t* ks1 = proj + (Rb + rk1) * PJ + 1536 + hd * 128 + (((lane & 15) ^ (rk1 & 15)) * 8);
    const bf16_t* vs0 = vt + ((size_t)((b * 4 + hd) * 128 + rv0)) * SEQ + (((lane & 7) ^ ((rv0 >> 1) & 7)) * 8);
    const bf16_t* vs1 = vt + ((size_t)((b * 4 + hd) * 128 + rv1)) * SEQ + (((lane & 7) ^ ((rv1 >> 1) & 7)) * 8);
    const unsigned ldsb = (unsigned)(uintptr_t)lds, kd = ldsb + AT_K + w * 2048, vd = ldsb + AT_V + w * 2048;
#define AT_ISSUE_K(j) do { const unsigned d_ = (unsigned)__builtin_amdgcn_readfirstlane(kd + ((j) & 3) * AT_SLOT); if (VAR != 3) { glds16(ks0 + (size_t)(j) * 64 * PJ, d_); glds16(ks1 + (size_t)(j) * 64 * PJ, d_ + 1024u); } } while (0)
#define AT_ISSUE_V(j) do { const unsigned d_ = (unsigned)__builtin_amdgcn_readfirstlane(vd + ((j) & 3) * AT_SLOT); if (VAR != 3) { glds16(vs0 + (j) * 64, d_); glds16(vs1 + (j) * 64, d_ + 1024u); } } while (0)
#define AT_WAITBAR(N) asm volatile("s_waitcnt vmcnt(" #N ") lgkmcnt(0)\n\ts_barrier" ::: "memory")
    AT_ISSUE_K(0); AT_ISSUE_K(1);
    if (2 < NT) AT_ISSUE_K(2);
    AT_ISSUE_V(0);
    if (3 < NT) AT_ISSUE_K(3);
    AT_ISSUE_V(1);
    { const float cfar = relb[15 * 4 + hd];
      if (tid < 64) tab[1216 + tid] = -INFINITY;
      for (int idx = tid; idx < 1216; idx += 512) { const int rel = idx - 1151, n = rel < 0 ? -rel : rel; int bk = (n < 8) ? n : (5 + (31 - __builtin_clz(n))); bk = bk > 15 ? 15 : bk; if (rel > 0) bk += 16; tab[idx] = (relb[bk * 4 + hd] - cfar) * LOG2E; } }
    bf16x8 qf[4];
    { const bf16_t* qp = proj + (R0 + 32 * rs + r) * PJ + 1024 + hd * 128 + mp * 64 + 8 * h;
#pragma unroll
      for (int ks = 0; ks < 4; ++ks) qf[ks] = *(const bf16x8*)(qp + 16 * ks); }
    int koff[4], voff[4];
    { const int kx = (mp * 8 + h) ^ (r & 15), vx = h ^ ((r >> 1) & 7);
#pragma unroll
      for (int i = 0; i < 4; ++i) { koff[i] = r * 256 + ((kx ^ (2 * i)) << 4); voff[i] = r * 128 + ((vx ^ (2 * i)) << 4); } }
    if (deep) AT_WAITBAR(8); else AT_WAITBAR(0);
    f32x16 o[4]; o[0] = (f32x16){}; o[1] = (f32x16){}; o[2] = (f32x16){}; o[3] = (f32x16){};
    float lsum = 0.f;
    const int qpos = qb * 128 + 32 * rs + r;
    const LAS float* tb0 = tab + (1151 + 4 * h - qpos);
    f32x16 pa0, pa1, pb0, pb1; bf16x8 pfA[4], pfB[4];
    pb0 = (f32x16){}; pb1 = (f32x16){};
#pragma unroll
    for (int i = 0; i < 4; ++i) { pfA[i] = (bf16x8){}; pfB[i] = (bf16x8){}; }
    at_qk(pa0, pa1, lds + AT_K, koff, qf);
    if (1088 > qb * 128) at_bias(pa0, pa1, tb0);
    asm volatile("s_waitcnt lgkmcnt(0)\n\ts_barrier" ::: "memory");
#define AT_STEP(t, C0, C1, N0, N1, PC, PP, DOPV) do { \
        if ((t) + 4 < NT) AT_ISSUE_K((t) + 4); \
        if ((t) + 2 < NT) AT_ISSUE_V((t) + 2); \
        at_fused<true, true, DOPV, VAR>(N0, N1, C0, C1, PC, PP, o, lsum, lds + AT_K + (((t) + 1) & 3) * AT_SLOT, lds + AT_V + (((t) + 3) & 3) * AT_SLOT, koff, voff, qf); \
        if (((t) + 1) * 64 + 1088 > qb * 128) at_bias(N0, N1, (rs < 2 && (t) + 2 == NT) ? (const LAS float*)(tab + 1216) : tb0 + ((t) + 1) * 64); \
        if ((t) + 4 < NT) AT_WAITBAR(8); else AT_WAITBAR(0); } while (0)
    AT_STEP(0, pa0, pa1, pb0, pb1, pfA, pfB, false);
    asm volatile(".p2align 8" ::: "memory");
    for (int t = 1; t + 1 < NT; t += 2) {
        AT_STEP(t, pb0, pb1, pa0, pa1, pfB, pfA, true);
        AT_STEP(t + 1, pa0, pa1, pb0, pb1, pfA, pfB, true);
    }
    at_fused<false, true, true, VAR>(pa0, pa1, pb0, pb1, pfB, pfA, o, lsum, lds + AT_K, lds + AT_V + ((NT - 2) & 3) * AT_SLOT, koff, voff, qf);
    at_fused<false, false, true, VAR>(pa0, pa1, pb0, pb1, pfA, pfB, o, lsum, lds + AT_K, lds + AT_V + ((NT - 1) & 3) * AT_SLOT, koff, voff, qf);
    __syncthreads();
#undef AT_STEP
#undef AT_ISSUE_K
#undef AT_ISSUE_V
#undef AT_WAITBAR
    int lane_e = tid & 63; asm volatile("" : "+v"(lane_e));
    lsum += shx(lsum, 32, lane_e);
    const float inv = __builtin_amdgcn_rcpf(lsum);
    LAS float* ex = (LAS float*)lds;
    if (mp == 1) {
#pragma unroll
        for (int db = 0; db < 4; ++db)
#pragma unroll
            for (int i = 0; i < 16; ++i) ex[((rs * 4 + db) * 16 + i) * 64 + lane_e] = o[db][i] * inv;
    }
    __syncthreads();
    if (mp == 0) {
        float ss = 0.f;
#pragma unroll
        for (int db = 0; db < 4; ++db)
#pragma unroll
            for (int i = 0; i < 16; ++i) { const float v = o[db][i] * inv - lam * ex[((rs * 4 + db) * 16 + i) * 64 + lane_e]; o[db][i] = v; ss += v * v; }
        ss += shx(ss, 32, lane_e);
        const float rsn = __builtin_amdgcn_rsqf(ss * (1.f / 128.f) + EPS) * osc;
        const int r_e = lane_e & 31, h_e = lane_e >> 5; bf16_t* op = outp + (R0 + 32 * rs + r_e) * opitch + hd * 128;
#pragma unroll
        for (int db = 0; db < 4; ++db)
#pragma unroll
            for (int i4 = 0; i4 < 4; ++i4) { const int d = 32 * db + 8 * i4 + 4 * h_e; const f32x4 g4 = *(const f32x4*)(subg + d);
                u32x2 wv; wv.x = pk2(o[db][4 * i4] * rsn * g4[0], o[db][4 * i4 + 1] * rsn * g4[1]); wv.y = pk2(o[db][4 * i4 + 2] * rsn * g4[2], o[db][4 * i4 + 3] * rsn * g4[3]);
                *(u32x2*)(op + d) = wv; }
    }
    __syncthreads();
}

__global__ void __launch_bounds__(512, 2) mega_fwd(Args a) {
    extern __shared__ __attribute__((aligned(16))) unsigned char lds_raw[];
    cg::grid_group grid = cg::this_grid();
    LAS unsigned char* lds = (LAS unsigned char*)lds_raw;
    const int G = gridDim.x, bid = blockIdx.x;
    const int wave = __builtin_amdgcn_readfirstlane(threadIdx.x >> 6);
#define IS_T0(v) bool v; { int l_; asm volatile("v_mbcnt_lo_u32_b32 %0, -1, 0\n\tv_mbcnt_hi_u32_b32 %0, -1, %0" : "=v"(l_)); v = (wave == 0) && (l_ == 0); }
    { IS_T0(t0_); if (t0_) { ((LAS unsigned*)(lds + MISC_OFF))[8] = 0u; ((LAS unsigned*)(lds + MISC_OFF))[9] = 0u; } __syncthreads();
      (void)xcd_barrier_post((unsigned*)kin(32) + CW_BAR, (volatile LAS unsigned*)(lds + MISC_OFF) + 8, t0_); }
#define GRID_BAR() do { XcdBarrier b_; b_.bar = (unsigned*)kin(32) + CW_BAR; b_.x = xb_xcc_id(); b_.st = (volatile LAS unsigned*)(lds + MISC_OFF) + 8; IS_T0(t0_); xcd_barrier(b_, t0_); } while (0)
#define PH_BEGIN int tid, bidp = bid, Gp = G; { int l_; asm volatile("v_mbcnt_lo_u32_b32 %0, -1, 0\n\tv_mbcnt_hi_u32_b32 %0, -1, %0" : "=v"(l_)); asm volatile("" : "+s"(bidp), "+s"(Gp)); tid = wave * 64 + l_; }
#define WSB(off) ((unsigned char*)kin(32) + (off))
#define ssqA ((float*)WSB(WS_SSQA))
#define ssqB ((float*)WSB(WS_SSQB))
#define agg ((float*)WSB(WS_AGG))
#define sm ((bf16_t*)WSB(WS_SMALL))
#define xb ((bf16_t*)WSB(WS_XB))
#define merged ((bf16_t*)kin(31))
#define proj ((bf16_t*)WSB(WS_PROJ))
#define xb2 ((bf16_t*)WSB(WS_PROJ))
#define vt ((bf16_t*)WSB(WS_VT))
#define gates ((bf16_t*)WSB(WS_GATES))
#define hid ((bf16_t*)WSB(WS_GATES))
#define out ((float*)kin(31))
#define ws WSB(0)

    { PH_BEGIN; convert_layer(0, ws + WS_W0, (LAS float*)lds, tid, bidp, Gp);
      convert_small(sm, tid, bidp, Gp);
      x_pass(kin(0), xb, ssqA, tid & 63, bidp * 8 + wave, Gp * 8); }
    grid.sync();

    for (int l = 0; l < NL; ++l) {
#define WL(off) (ws + WS_W0 + (size_t)(l & 1) * WS_WSZ + (off))
#ifndef NO_A
        {
            PH_BEGIN;
            pg8::Gemm g{xb, (const bf16_t*)WL(W_IN), MT, INC, DM, DM}; pg8::StaticOrder S; S.init(MT, INC, Gp, bidp);
            pg8::EpiInProj E{proj, vt, gates, ssqA, kin(3) + l * 3072, kin(15) + l * 64, kin(16) + l * 64};
            pg8::gemm_phase<pg8::EpiInProj, pg8::StaticOrder, true, true>(lds, g, S, E, tid);
#ifdef PROBE_A
            pg8::gemm_phase<pg8::EpiInProj, pg8::StaticOrder, true, true>(lds, g, S, E, tid);
#endif
        }
#endif
        GRID_BAR();
        {
            PH_BEGIN; const int lane = tid & 63, gw = bidp * 8 + wave, NGW = Gp * 8;
            const bf16_t* sml = sm + (size_t)l * SMALL_PER_LAYER;
#if defined(PROBE_B) && PROBE_B == 3
            { LruP LP{kin(4) + l * 1024, kin(5) + l * 256, kin(7) + l * 256, kin(9) + l * 256, kin(10) + l * 256, sml, sml + 16384};
              for (int u = bidp; u < 512; u += Gp) lru_unit<false>(lds, proj, proj, PJ, agg, LP, u >> 8, u & 255, tid); }
            if (l + 1 < NL) convert_layer(l + 1, ws + WS_W0 + (size_t)((l + 1) & 1) * WS_WSZ, (LAS float*)lds, tid, bidp, Gp);
#elif defined(PROBE_B)
#if PROBE_B == 1
            qk_norm(proj, xb, 1024, kin(15) + l * 64, kin(16) + l * 64, lane, gw, NGW);
#endif
            { LruP LP{kin(4) + l * 1024, kin(5) + l * 256, kin(7) + l * 256, kin(9) + l * 256, kin(10) + l * 256, sml, sml + 16384};
              for (int u = bidp; u < 512; u += Gp) lru_unit<false>(lds, proj, proj, PJ, agg, LP, u >> 8, u & 255, tid); }
            { SgP SP{kin(11) + l * 256, kin(12) + l * 256, kin(14) + l * 512, sml + 32768};
              for (int u = bidp; u < 256; u += Gp) sg_unit(lds, proj, xb, 1024, SP, u, tid); }
#if PROBE_B == 1
            if (l + 1 < NL) convert_layer(l + 1, ws + WS_W0 + (size_t)((l + 1) & 1) * WS_WSZ, (LAS float*)lds, tid, bidp, Gp);
#endif
#endif
            { LruP LP{kin(4) + l * 1024, kin(5) + l * 256, kin(7) + l * 256, kin(9) + l * 256, kin(10) + l * 256, sml, sml + 16384};
              for (int u = bidp; u < 512; u += Gp) lru_unit<false>(lds, proj, proj, PJ, agg, LP, u >> 8, u & 255, tid); }
            { SgP SP{kin(11) + l * 256, kin(12) + l * 256, kin(14) + l * 512, sml + 32768};
              for (int u = bidp; u < 256; u += Gp) sg_unit(lds, proj, proj + 512, PJ, SP, u, tid); }
            if (l + 1 < NL) convert_layer(l + 1, ws + WS_W0 + (size_t)((l + 1) & 1) * WS_WSZ, (LAS float*)lds, tid, bidp, Gp);
        }
        GRID_BAR();
        {
            PH_BEGIN; const int lane = tid & 63;
            float d1 = kin(17)[l * 64 + lane] * kin(18)[l * 64 + lane], d2 = kin(19)[l * 64 + lane] * kin(20)[l * 64 + lane];
            d1 = wave_sum(d1, lane); d2 = wave_sum(d2, lane);
            const float lam_init = 0.8f - 0.6f * __builtin_amdgcn_exp2f(-0.3f * LOG2E * (float)l);
            const float lam = __builtin_amdgcn_exp2f(d1 * LOG2E) - __builtin_amdgcn_exp2f(d2 * LOG2E) + lam_init;
            const float* relb = kin(22); const float* subg = kin(21) + l * 128;
#ifndef NO_ATT
#ifdef PROBE_ATT
            if (Gp == 256) {
                const int vcu = (bidp % 8) * 32 + bidp / 8, bh = vcu >> 5, s = vcu & 31;
#define ATT_OUT xb, 1024
                for (int i = 0; i < 4; ++i) { const int qb = (i == 0) ? 127 - s : (i == 1) ? 95 - s : (i == 2) ? 32 + s : s; attn_unit<PROBE_ATT>(lds, proj, vt, ATT_OUT, bh >> 2, bh & 3, qb, lam, 1.f - lam_init, relb, subg, tid); }
#undef ATT_OUT
            }
#endif
#define ATT_OUT proj + 1024, PJ
            if (Gp == 256) {
                const int vcu = (bidp % 8) * 32 + bidp / 8, bh = vcu >> 5, s = vcu & 31;
                for (int i = 0; i < 4; ++i) { const int qb = (i == 0) ? 127 - s : (i == 1) ? s : (i == 2) ? 95 - s : 32 + s; attn_unit<0>(lds, proj, vt, ATT_OUT, bh >> 2, bh & 3, qb, lam, 1.f - lam_init, relb, subg, tid); }
            } else {
                for (int u = bidp; u < 1024; u += Gp) attn_unit<0>(lds, proj, vt, ATT_OUT, u >> 9, (u >> 7) & 3, u & 127, lam, 1.f - lam_init, relb, subg, tid);
            }
#endif
            { const bf16_t* sml = sm + (size_t)l * SMALL_PER_LAYER;
              LruP LP{kin(4) + l * 1024, kin(5) + l * 256, kin(7) + l * 256, kin(9) + l * 256, kin(10) + l * 256, sml, sml + 16384};
#if defined(PROBE_B) && PROBE_B != 3
              for (int u = bidp; u < 512; u += Gp) lru_unit<true>(lds, proj, xb, 1024, agg, LP, u >> 8, u & 255, tid);
#endif
              for (int u = bidp; u < 512; u += Gp) lru_unit<true>(lds, proj, proj + 256, PJ, agg, LP, u >> 8, (u >> 8) ? 255 - (u & 255) : (u & 255), tid); }
        }
        GRID_BAR();
#ifndef NO_C1
        { PH_BEGIN; pg8::StaticOrder S; S.init(MT, DM, Gp, bidp); pg8::Gemm g{proj + 256, (const bf16_t*)WL(W_PA), MT, DM, 256, PJ}; pg8::EpiMerge<0> E{gates, merged}; pg8::gemm_phase<pg8::EpiMerge<0>, pg8::StaticOrder, true, true>(lds, g, S, E, tid); }
        { PH_BEGIN; pg8::StaticOrder S; S.init(MT, DM, Gp, bidp); pg8::Gemm g{proj + 512, (const bf16_t*)WL(W_PB), MT, DM, 256, PJ}; pg8::EpiMerge<1> E{gates, merged}; pg8::gemm_phase<pg8::EpiMerge<1>, pg8::StaticOrder, true, true>(lds, g, S, E, tid); }
        { PH_BEGIN; pg8::StaticOrder S; S.init(MT, DM, Gp, bidp); pg8::Gemm g{proj + 1024, (const bf16_t*)WL(W_PC), MT, DM, 512, PJ}; pg8::EpiMerge<2> E{gates, merged}; pg8::gemm_phase<pg8::EpiMerge<2>, pg8::StaticOrder, true, true>(lds, g, S, E, tid); }
#ifdef PROBE_C1
        { PH_BEGIN; pg8::StaticOrder S; S.init(MT, DM, Gp, bidp); pg8::Gemm g{proj + 256, (const bf16_t*)WL(W_PA), MT, DM, 256, PJ}; pg8::EpiMerge<0> E{gates, merged}; pg8::gemm_phase<pg8::EpiMerge<0>, pg8::StaticOrder, true, true>(lds, g, S, E, tid); }
        { PH_BEGIN; pg8::StaticOrder S; S.init(MT, DM, Gp, bidp); pg8::Gemm g{proj + 512, (const bf16_t*)WL(W_PB), MT, DM, 256, PJ}; pg8::EpiMerge<1> E{gates, merged}; pg8::gemm_phase<pg8::EpiMerge<1>, pg8::StaticOrder, true, true>(lds, g, S, E, tid); }
        { PH_BEGIN; pg8::StaticOrder S; S.init(MT, DM, Gp, bidp); pg8::Gemm g{proj + 1024, (const bf16_t*)WL(W_PC), MT, DM, 512, PJ}; pg8::EpiMerge<2> E{gates, merged}; pg8::gemm_phase<pg8::EpiMerge<2>, pg8::StaticOrder, true, true>(lds, g, S, E, tid); }
#endif
#endif
        GRID_BAR();
#ifndef NO_C2
        {
            PH_BEGIN;
            pg8::Gemm g{merged, (const bf16_t*)WL(W_O), MT, DM, DM, DM}; pg8::StaticOrder S; S.init(MT, DM, Gp, bidp);
            pg8::EpiResid E{(const float*)nullptr, xb, (float*)nullptr, xb2, (bf16_t*)nullptr, ssqB};
            pg8::gemm_phase<pg8::EpiResid, pg8::StaticOrder, true, true>(lds, g, S, E, tid);
        }
#endif
        GRID_BAR();
#ifndef NO_C3
        {
            PH_BEGIN;
            pg8::Gemm g{xb2, (const bf16_t*)WL(W_FF), MT, 2 * FF, DM, DM}; pg8::StaticOrder S; S.init(MT, 2 * FF, Gp, bidp);
            pg8::EpiFfn1 E{hid, ssqB};
            pg8::gemm_phase<pg8::EpiFfn1, pg8::StaticOrder, true, true>(lds, g, S, E, tid);
#ifdef PROBE_C3
            pg8::gemm_phase<pg8::EpiFfn1, pg8::StaticOrder, true, true>(lds, g, S, E, tid);
#endif
        }
#endif
        GRID_BAR();
#ifndef NO_C4
        {
            PH_BEGIN;
            pg8::Gemm g{hid, (const bf16_t*)WL(W_DN), MT, DM, FF, FF}; pg8::StaticOrder S; S.init(MT, DM, Gp, bidp);
            const bool lastl = (l + 1 == NL);
            pg8::EpiResid E{(const float*)nullptr, xb2, lastl ? out : (float*)nullptr, lastl ? (bf16_t*)nullptr : xb, (bf16_t*)nullptr, ssqA};
            pg8::gemm_phase<pg8::EpiResid, pg8::StaticOrder, true, true>(lds, g, S, E, tid);
        }
#endif
        if (l + 1 < NL) GRID_BAR();
    }
}
#undef WL
#undef GRID_BAR
#undef IS_T0
#undef PH_BEGIN
#undef ws
#undef out
#undef hid
#undef gates
#undef vt
#undef xb2
#undef proj
#undef merged
#undef xb
#undef sm
#undef agg
#undef ssqB
#undef ssqA
extern "C" void kernel_launch(void* const* d_in, const int* in_sizes, int n_in, void* d_out, int out_size, void* d_ws, size_t ws_size, hipStream_t stream) {
    static int grid = 0;
    if (grid == 0) {
        if (n_in != 31 || out_size != MT * DM || ws_size < WS_END) { fprintf(stderr, "kernel_launch: unexpected shapes (n_in %d out %d ws %zu)\n", n_in, out_size, ws_size); grid = -1; return; }
        int dev = 0, cus = 0, per_cu = 0;
        hipGetDevice(&dev); hipDeviceGetAttribute(&cus, hipDeviceAttributeMultiprocessorCount, dev);
        if (hipFuncSetAttribute((const void*)mega_fwd, hipFuncAttributeMaxDynamicSharedMemorySize, LDS_BYTES) != hipSuccess) { fprintf(stderr, "kernel_launch: hipFuncSetAttribute failed\n"); grid = -1; return; }
        if (hipOccupancyMaxActiveBlocksPerMultiprocessor(&per_cu, (const void*)mega_fwd, 512, LDS_BYTES) != hipSuccess || per_cu < 1) { fprintf(stderr, "kernel_launch: occupancy query says %d\n", per_cu); per_cu = 1; }
        (void)hipGetLastError();
        grid = cus;
    }
    if (grid < 0) return;
    if (hipMemsetAsync(d_ws, 0, CTL_ZERO_BYTES, stream) != hipSuccess) { fprintf(stderr, "kernel_launch: memset failed\n"); return; }
    Args a{};
    for (int i = 0; i < 31; ++i) a.in[i] = (const float*)d_in[i];
    a.out = (float*)d_out; a.ws = (unsigned char*)d_ws;
    void* args[] = {&a};
    hipError_t e = hipLaunchCooperativeKernel((const void*)mega_fwd, dim3(grid), dim3(512), args, LDS_BYTES, stream);
    if (e != hipSuccess) fprintf(stderr, "cooperative launch failed: %s (grid %d)\n", hipGetErrorString(e), grid);
}
```

```cpp
#include <hip/hip_runtime.h>
#include <hip/hip_cooperative_groups.h>
#include <hip/hip_bf16.h>
#include <cstdio>
#include <cstdint>
#include <cmath>
namespace cg = cooperative_groups;
namespace pg8 {
#define PG8_LAS __attribute__((address_space(3)))
typedef unsigned short bf16_t;
typedef short bf16x8 __attribute__((ext_vector_type(8)));
typedef float f32x4 __attribute__((ext_vector_type(4)));
typedef unsigned u32x4 __attribute__((ext_vector_type(4)));
constexpr int BM = 256, BK = 64, HALF = 128, HTB = HALF * BK * 2  , STAGE_BYTES = 8 * HTB, NXCD = 8, WGM = 4;

__host__ __device__ __forceinline__ int lds_byte(int r, int c) { const int st = (r >> 4) * 2 + (c >> 5), rr = r & 15, cc = c & 31, ob = rr * 64 + cc * 2; return st * 1024 + (ob ^ (((ob >> 9) & 1) << 5)); }
__host__ __device__ __forceinline__ void stage_rc(int b, int& R, int& C) { const int st = b / 1024, sb = b % 1024, swz = sb ^ (((sb >> 9) & 1) << 5); R = (st >> 1) * 16 + swz / 64; C = (st & 1) * 32 + (swz % 64) / 2; }
__host__ __device__ __forceinline__ int perm32(int rho) { const int n = rho >> 4, i = rho & 15; return 8 * (i >> 2) + 4 * n + (i & 3); }

struct Unit { int pm, pn; };
struct Gemm { const bf16_t* A; const bf16_t* Bt; int M, N, K, lda; };

struct StaticOrder {
    int nM, nN, nwg, G, c;
    __host__ __device__ void init(int M, int N, int G_, int c_) { nM = M / BM; nN = N / BM; nwg = nM * nN; G = G_; c = c_; }
    __host__ __device__ bool next(int i, Unit& u) const {
        const long L = (long)i * G + c; if (L >= nwg) return false;
        int wgid = (int)L; { const int q = nwg / NXCD, r = nwg % NXCD, xcd = wgid % NXCD, off = wgid / NXCD; wgid = (xcd < r ? xcd * (q + 1) : r * (q + 1) + (xcd - r) * q) + off; }
        const int nig = WGM * nN, gid = wgid / nig, fm = gid * WGM, gsz = (nM - fm) < WGM ? (nM - fm) : WGM;
        u.pm = fm + ((wgid % nig) % gsz); u.pn = (wgid % nig) / gsz; return true;
    }
    __device__ __forceinline__ void a_ready(const Unit&) const {}
    __device__ __forceinline__ void done(const Unit&) const {}
};

template <class Epi, class Sched, bool ALIGN_EPI = false, bool SP2 = false>
__device__ __forceinline__ void gemm_phase(PG8_LAS unsigned char* lds, const Gemm g, const Sched& S, const Epi& E, const int tid) {
    const int wid = __builtin_amdgcn_readfirstlane(tid >> 6), lane = tid & 63, wr = wid >> 2, wc = wid & 3, fr = lane & 15, fq = lane >> 4;
    const int K = g.K, nt = K / BK;
    unsigned voffA[2], voffB[2];
#pragma unroll
    for (int i = 0; i < 2; ++i) { int R, C; stage_rc(tid * 16 + i * 8192, R, C); const int Rb = Epi::PERM ? ((R & ~31) + perm32(R & 31)) : R;
        voffA[i] = (unsigned)(R * g.lda + C) * 2u; voffB[i] = (unsigned)(Rb * K + C) * 2u; }
    const size_t kstep = (size_t)(BK * 2);
    const size_t hstepA = (size_t)HALF * g.lda * 2, hstepB = (size_t)HALF * K * 2;
    const size_t tstepA = 2 * hstepA, tstepB = 2 * hstepB;
    const unsigned ldsw = (unsigned)wid * 1024u;
    const int aoff = lds_byte(wr * 64 + fr, fq * 8), boff = lds_byte(wc * 32 + fr, fq * 8);
#define PG8_SA(b, h) (((b) * 2 + (h)) * HTB)
#define PG8_SB(b, h) ((4 + (b) * 2 + (h)) * HTB)
#define PG8_STAGE(bufoff, gbase, voff) do { _Pragma("unroll") for (int _i = 0; _i < 2; ++_i) \
        __builtin_amdgcn_global_load_lds((const unsigned*)((const char*)(gbase) + (voff)[_i]), (PG8_LAS unsigned*)(lds + (bufoff) + ldsw + _i * 8192), 16, 0, 0); } while (0)
#define PG8_LDA(dst, b, h) do { _Pragma("unroll") for (int m = 0; m < 4; ++m) _Pragma("unroll") for (int k = 0; k < 2; ++k) dst[m][k] = *(const PG8_LAS bf16x8*)(lds + PG8_SA(b, h) + aoff + m * 2048 + k * 1024); } while (0)
#define PG8_LDB(dst, b, h) do { _Pragma("unroll") for (int n = 0; n < 2; ++n) _Pragma("unroll") for (int k = 0; k < 2; ++k) dst[n][k] = *(const PG8_LAS bf16x8*)(lds + PG8_SB(b, h) + boff + n * 2048 + k * 1024); } while (0)
#define PG8_MMA(ai, bj, At, Bt) do { __builtin_amdgcn_s_setprio(1); _Pragma("unroll") for (int m = 0; m < 4; ++m) _Pragma("unroll") for (int n = 0; n < 2; ++n) _Pragma("unroll") for (int k = 0; k < 2; ++k) \
        acc[ai][bj][m][n] = __builtin_amdgcn_mfma_f32_16x16x32_bf16(Bt[n][k], At[m][k], acc[ai][bj][m][n], 0, 0, 0); __builtin_amdgcn_s_setprio(0); } while (0)
#define PG8_WAIT_V(n) asm volatile("s_waitcnt vmcnt(" #n ")" ::: "memory")
#define PG8_WAIT_L(n) asm volatile("s_waitcnt lgkmcnt(" #n ")" ::: "memory")
#define PG8_BAR __builtin_amdgcn_s_barrier()
#define PG8_SCHED __builtin_amdgcn_sched_barrier(0)
    Unit cur, nxt; int ui = 0;
    if (!S.next(0, cur)) return;
    f32x4 acc[2][2][4][2];
#pragma unroll
    for (int a = 0; a < 2; ++a)
#pragma unroll
        for (int b = 0; b < 2; ++b)
#pragma unroll
            for (int m = 0; m < 4; ++m)
#pragma unroll
                for (int n = 0; n < 2; ++n) acc[a][b][m][n] = (f32x4){0.f, 0.f, 0.f, 0.f};
    bf16x8 At[4][2], B0[2][2], B1[2][2];
    const char* cA = (const char*)g.A + (size_t)cur.pm * tstepA; const char* cB = (const char*)g.Bt + (size_t)cur.pn * tstepB;
    S.a_ready(cur);
    if constexpr (SP2) {
        PG8_STAGE(PG8_SB(0, 0), cB, voffB); PG8_STAGE(PG8_SB(0, 1), cB + hstepB, voffB); PG8_STAGE(PG8_SA(0, 0), cA, voffA); PG8_STAGE(PG8_SA(0, 1), cA + hstepA, voffA);
        if (wr == 1) PG8_BAR;
        PG8_WAIT_V(2); PG8_BAR;
        PG8_STAGE(PG8_SB(1, 0), cB + kstep, voffB); PG8_STAGE(PG8_SA(1, 0), cA + kstep, voffA); PG8_STAGE(PG8_SB(1, 1), cB + hstepB + kstep, voffB);
        PG8_WAIT_V(6); PG8_BAR;
    } else {
        PG8_STAGE(PG8_SB(0, 0), cB, voffB); PG8_STAGE(PG8_SA(0, 0), cA, voffA); PG8_STAGE(PG8_SB(0, 1), cB + hstepB, voffB); PG8_STAGE(PG8_SA(0, 1), cA + hstepA, voffA);
        if (wr == 1) PG8_BAR;
        PG8_WAIT_V(4); PG8_BAR;
        PG8_STAGE(PG8_SB(1, 0), cB + kstep, voffB); PG8_STAGE(PG8_SA(1, 0), cA + kstep, voffA); PG8_STAGE(PG8_SB(1, 1), cB + hstepB + kstep, voffB);
        PG8_WAIT_V(6); PG8_BAR;
    }
    asm volatile(".p2align 8" ::: "memory");
    for (;;) {
        const bool has_next = S.next(ui + 1, nxt);
        const char* nA = has_next ? (const char*)g.A + (size_t)nxt.pm * tstepA : cA; const char* nB = has_next ? (const char*)g.Bt + (size_t)nxt.pn * tstepB : cB;
        for (int t = 0; t < nt; t += 2) {
            const bool last = (t == nt - 2);
            const char* a1 = cA + (size_t)(t + 1) * kstep;
            const char* a2 = last ? nA : cA + (size_t)(t + 2) * kstep; const char* b2 = last ? nB : cB + (size_t)(t + 2) * kstep;
            const char* a3 = a2 + kstep; const char* b3 = b2 + kstep;
            if (last && has_next) S.a_ready(nxt);
            if constexpr (SP2) {
            PG8_LDB(B0, 0, 0); PG8_LDB(B1, 0, 1); PG8_SCHED; PG8_LDA(At, 0, 0); PG8_STAGE(PG8_SA(1, 1), a1 + hstepA, voffA);
            PG8_WAIT_V(8); PG8_WAIT_L(0); PG8_BAR; PG8_MMA(0, 0, At, B0); PG8_MMA(0, 1, At, B1); PG8_BAR; PG8_SCHED;
            PG8_LDA(At, 0, 1); PG8_STAGE(PG8_SB(0, 0), b2, voffB); PG8_STAGE(PG8_SB(0, 1), b2 + hstepB, voffB); PG8_STAGE(PG8_SA(0, 0), a2, voffA);
            PG8_WAIT_V(8); PG8_WAIT_L(0); PG8_BAR; PG8_MMA(1, 0, At, B0); PG8_MMA(1, 1, At, B1); PG8_BAR; PG8_SCHED;
            PG8_LDB(B0, 1, 0); PG8_LDB(B1, 1, 1); PG8_SCHED; PG8_LDA(At, 1, 0); PG8_STAGE(PG8_SA(0, 1), a2 + hstepA, voffA);
            PG8_WAIT_V(8); PG8_WAIT_L(0); PG8_BAR; PG8_MMA(0, 0, At, B0); PG8_MMA(0, 1, At, B1); PG8_BAR; PG8_SCHED;
            PG8_LDA(At, 1, 1); PG8_STAGE(PG8_SB(1, 0), b3, voffB); PG8_STAGE(PG8_SB(1, 1), b3 + hstepB, voffB); PG8_STAGE(PG8_SA(1, 0), a3, voffA);
            PG8_WAIT_V(8); PG8_WAIT_L(0); PG8_BAR; PG8_MMA(1, 0, At, B0); PG8_MMA(1, 1, At, B1); PG8_BAR; PG8_SCHED;
            } else {
            PG8_LDB(B0, 0, 0); PG8_SCHED; PG8_LDA(At, 0, 0); PG8_STAGE(PG8_SA(1, 1), a1 + hstepA, voffA);
            PG8_WAIT_L(8); PG8_BAR; PG8_WAIT_L(0); PG8_MMA(0, 0, At, B0); PG8_BAR; PG8_SCHED;
            PG8_LDB(B1, 0, 1); PG8_STAGE(PG8_SB(0, 0), b2, voffB);
            PG8_BAR; PG8_WAIT_L(0); PG8_MMA(0, 1, At, B1); PG8_BAR;
            PG8_LDA(At, 0, 1); PG8_STAGE(PG8_SA(0, 0), a2, voffA);
            PG8_BAR; PG8_WAIT_L(0); PG8_MMA(1, 0, At, B0); PG8_BAR; PG8_SCHED;
            PG8_STAGE(PG8_SB(0, 1), b2 + hstepB, voffB);
            PG8_WAIT_V(6); PG8_BAR; PG8_MMA(1, 1, At, B1); PG8_BAR;
            PG8_LDB(B0, 1, 0); PG8_SCHED; PG8_LDA(At, 1, 0); PG8_STAGE(PG8_SA(0, 1), a2 + hstepA, voffA);
            PG8_WAIT_L(8); PG8_BAR; PG8_WAIT_L(0); PG8_MMA(0, 0, At, B0); PG8_BAR; PG8_SCHED;
            PG8_LDB(B1, 1, 1); PG8_STAGE(PG8_SB(1, 0), b3, voffB);
            PG8_BAR; PG8_WAIT_L(0); PG8_MMA(0, 1, At, B1); PG8_BAR;
            PG8_LDA(At, 1, 1); PG8_STAGE(PG8_SA(1, 0), a3, voffA);
            PG8_BAR; PG8_WAIT_L(0); PG8_MMA(1, 0, At, B0); PG8_BAR; PG8_SCHED;
            PG8_STAGE(PG8_SB(1, 1), b3 + hstepB, voffB);
            PG8_WAIT_V(6); PG8_BAR; PG8_MMA(1, 1, At, B1); PG8_BAR;
            }
        }
        if constexpr (ALIGN_EPI) { if (wr == 0) PG8_BAR; }
        if constexpr (!Epi::AFTER_DRAIN) { int l2_; asm volatile("v_mbcnt_lo_u32_b32 %0, -1, 0\n\tv_mbcnt_hi_u32_b32 %0, -1, %0" : "=v"(l2_)); E(acc, cur, wr, wc, l2_ & 15, l2_ >> 4); S.done(cur); }
        if (!has_next) break;
#pragma unroll
        for (int a = 0; a < 2; ++a)
#pragma unroll
            for (int b = 0; b < 2; ++b)
#pragma unroll
                for (int m = 0; m < 4; ++m)
#pragma unroll
                    for (int n = 0; n < 2; ++n) acc[a][b][m][n] = (f32x4){0.f, 0.f, 0.f, 0.f};
        cur = nxt; cA = nA; cB = nB; ++ui;
        if constexpr (ALIGN_EPI) { if (wr == 1) PG8_BAR; }
    }
    PG8_WAIT_V(0);
    if constexpr (!ALIGN_EPI) { if (wr == 0) PG8_BAR; }
    PG8_BAR;
    if constexpr (Epi::AFTER_DRAIN) { E.fused(acc, cur, wr, wc, fr, fq, lds, wid, lane); S.done(cur); }
#undef PG8_SA
#undef PG8_SB
#undef PG8_STAGE
#undef PG8_LDA
#undef PG8_LDB
#undef PG8_MMA
#undef PG8_WAIT_V
#undef PG8_WAIT_L
#undef PG8_BAR
#undef PG8_SCHED
}
}

#define LAS __attribute__((address_space(3)))
typedef unsigned short bf16_t;
typedef short bf16x8 __attribute__((ext_vector_type(8)));
typedef float f32x4 __attribute__((ext_vector_type(4)));
typedef float f32x2 __attribute__((ext_vector_type(2)));
typedef float f32x16 __attribute__((ext_vector_type(16)));
typedef unsigned u32x4 __attribute__((ext_vector_type(4)));
typedef unsigned u32x2 __attribute__((ext_vector_type(2)));
typedef __bf16 bf16x2_t __attribute__((ext_vector_type(2)));

constexpr int NB = 2, SEQ = 16384, DM = 1024, NL = 4, MT = NB * SEQ;
constexpr int INC = 5632, PJ = 2048, GP = 3072, FF = 2816;
constexpr float EPS = 1e-6f, LOG2E = 1.4426950408889634f;
constexpr size_t MiB = 1u << 20;
constexpr size_t WS_SSQA = 1 * MiB, WS_SSQB = 3 * MiB, WS_AGG = 5 * MiB, WS_SMALL = 6 * MiB;
constexpr size_t WS_W0 = 8 * MiB, WS_WSZ = 32 * MiB;
constexpr size_t WS_XB = 72 * MiB, WS_PROJ = 136 * MiB, WS_VT = 264 * MiB, WS_GATES = 296 * MiB, WS_END = 488 * MiB;
constexpr size_t W_IN = 0, W_PA = 11 * MiB, W_PB = W_PA + MiB / 2, W_PC = 12 * MiB, W_O = 13 * MiB, W_FF = 15 * MiB, W_DN = 26 * MiB;
constexpr int SMALL_PER_LAYER = 16384 + 16384 + 65536;
constexpr int LDS_BYTES = 147456, MISC_OFF = 131072 + 320;
constexpr int CW_BAR = 4096; constexpr size_t CTL_ZERO_BYTES = 65536;

__device__ __forceinline__ unsigned pk2(float lo, float hi) { f32x2 v = {lo, hi}; bf16x2_t b = __builtin_convertvector(v, bf16x2_t); return __builtin_bit_cast(unsigned, b); }
__device__ __forceinline__ bf16_t f2bf(float f) { unsigned u = __builtin_bit_cast(unsigned, f); return (bf16_t)((u + 0x7fffu + ((u >> 16) & 1u)) >> 16); }
__device__ __forceinline__ float bf2f(bf16_t b) { return __builtin_bit_cast(float, (unsigned)b << 16); }
__device__ __forceinline__ float bflo(unsigned w) { return __builtin_bit_cast(float, w << 16); }
__device__ __forceinline__ float bfhi(unsigned w) { return __builtin_bit_cast(float, w & 0xffff0000u); }
__device__ __forceinline__ float fsigmoid(float x) { return __builtin_amdgcn_rcpf(1.f + __builtin_amdgcn_exp2f(-x * LOG2E)); }
__device__ __forceinline__ float shx(float v, int mask, int lane) { return __builtin_bit_cast(float, __builtin_amdgcn_ds_bpermute((lane ^ mask) << 2, __builtin_bit_cast(int, v))); }
__device__ __forceinline__ float wave_sum(float v, int lane) {
#pragma unroll
    for (int o = 1; o < 64; o <<= 1) v += shx(v, o, lane);
    return v;
}
__device__ __forceinline__ int crow(int r, int hi) { return (r & 3) + 8 * (r >> 2) + 4 * hi; }
#define MFMA32(a, b, c) __builtin_amdgcn_mfma_f32_32x32x16_bf16((a), (b), (c), 0, 0, 0)
__device__ __forceinline__ bf16x8 pack8(float a0, float a1, float a2, float a3, float a4, float a5, float a6, float a7) {
    u32x4 p; p.x = pk2(a0, a1); p.y = pk2(a2, a3); p.z = pk2(a4, a5); p.w = pk2(a6, a7); return __builtin_bit_cast(bf16x8, p);
}

namespace pg8 {
__device__ __forceinline__ float row_rstd(const float* ssq, int r) {
    const f32x4* p = (const f32x4*)(ssq + (size_t)r * 16);
    const f32x4 a = p[0], b = p[1], c = p[2], d = p[3];
    const float s = ((a[0] + a[1]) + (a[2] + a[3])) + ((b[0] + b[1]) + (b[2] + b[3])) + ((c[0] + c[1]) + (c[2] + c[3])) + ((d[0] + d[1]) + (d[2] + d[3]));
    return __builtin_amdgcn_rsqf(s * (1.f / 1024.f) + EPS);
}
__device__ __forceinline__ u32x4 pack_f8(const f32x4 v0, const f32x4 v1) { u32x4 w; w.x = pk2(v0[0], v0[1]); w.y = pk2(v0[2], v0[3]); w.z = pk2(v1[0], v1[1]); w.w = pk2(v1[2], v1[3]); return w; }

struct EpiInProj {
    static constexpr bool PERM = true, AFTER_DRAIN = false;
    bf16_t* proj; bf16_t* vt; bf16_t* gates; const float* ssq; const float* bgate; const float* qg; const float* kg;
    __device__ __forceinline__ void operator()(const f32x4 (&acc)[2][2][4][2], const Unit& u, int wr, int wc, int fr, int fq) const {
        const int row0 = u.pm * BM + wr * 64 + fr, cin = wc * 32 + 8 * fq;
        if (u.pn >= 4 && u.pn < 8) {
            const int G = 4 * (u.pn - 4) + wc, ln_ = fr | (fq << 4); const bool isq = u.pn < 6;
            const float* gp = (isq ? qg : kg) + 8 * fq; const float gs = isq ? (0.125f * LOG2E) : 1.f;
            const f32x4 g00 = *(const f32x4*)gp * gs, g01 = *(const f32x4*)(gp + 4) * gs, g10 = *(const f32x4*)(gp + 32) * gs, g11 = *(const f32x4*)(gp + 36) * gs;
#pragma unroll
            for (int ai = 0; ai < 2; ++ai)
#pragma unroll
                for (int m = 0; m < 4; ++m) { const int r = row0 + ai * HALF + m * 16; const float rs = row_rstd(ssq, r); bf16_t* rowp = proj + (size_t)r * PJ + 1024 + 64 * G + 8 * fq;
                    f32x4 a0 = acc[ai][0][m][0] * rs, a1 = acc[ai][0][m][1] * rs, b0 = acc[ai][1][m][0] * rs, b1 = acc[ai][1][m][1] * rs;
                    float ss = (a0[0] * a0[0] + a0[1] * a0[1]) + (a0[2] * a0[2] + a0[3] * a0[3]) + (a1[0] * a1[0] + a1[1] * a1[1]) + (a1[2] * a1[2] + a1[3] * a1[3])
                             + (b0[0] * b0[0] + b0[1] * b0[1]) + (b0[2] * b0[2] + b0[3] * b0[3]) + (b1[0] * b1[0] + b1[1] * b1[1]) + (b1[2] * b1[2] + b1[3] * b1[3]);
                    ss += shx(ss, 16, ln_); ss += shx(ss, 32, ln_);
                    const float rq = __builtin_amdgcn_rsqf(ss * (1.f / 64.f) + EPS);
                    *(u32x4*)rowp = pack_f8(a0 * (g00 * rq), a1 * (g01 * rq)); *(u32x4*)(rowp + 32) = pack_f8(b0 * (g10 * rq), b1 * (g11 * rq)); }
        } else if (u.pn < 8) {
#pragma unroll
            for (int ai = 0; ai < 2; ++ai)
#pragma unroll
                for (int m = 0; m < 4; ++m) { const int r = row0 + ai * HALF + m * 16; const float rs = row_rstd(ssq, r); bf16_t* rowp = proj + (size_t)r * PJ + u.pn * BM + cin;
#pragma unroll
                    for (int bj = 0; bj < 2; ++bj) *(u32x4*)(rowp + bj * HALF) = pack_f8(acc[ai][bj][m][0] * rs, acc[ai][bj][m][1] * rs); }
        } else if (u.pn < 10) {
#pragma unroll
            for (int ai = 0; ai < 2; ++ai)
#pragma unroll
                for (int m = 0; m < 4; ++m) { const int r = row0 + ai * HALF + m * 16; const float rs = row_rstd(ssq, r);
                    const int b = r >> 14, s = r & (SEQ - 1), ko = s & 15, gq = ko >> 2, sg = (gq == 1) ? 2 : ((gq == 2) ? 1 : gq), slot = (s & ~15) | (sg * 4 + (ko & 3));
#pragma unroll
                    for (int bj = 0; bj < 2; ++bj) { const int head = (u.pn - 8) * 2 + bj; bf16_t* base = vt + ((size_t)((b * 4 + head) * 128 + cin)) * SEQ + slot;
                        const f32x4 v0 = acc[ai][bj][m][0] * rs, v1 = acc[ai][bj][m][1] * rs;
                        base[0] = f2bf(v0[0]); base[(size_t)SEQ] = f2bf(v0[1]); base[(size_t)2 * SEQ] = f2bf(v0[2]); base[(size_t)3 * SEQ] = f2bf(v0[3]);
                        base[(size_t)4 * SEQ] = f2bf(v1[0]); base[(size_t)5 * SEQ] = f2bf(v1[1]); base[(size_t)6 * SEQ] = f2bf(v1[2]); base[(size_t)7 * SEQ] = f2bf(v1[3]); } }
        } else {
            const int colg = (u.pn - 10) * BM + cin;
            f32x4 bv[2][2];
#pragma unroll
            for (int bj = 0; bj < 2; ++bj) { bv[bj][0] = *(const f32x4*)(bgate + colg + bj * HALF); bv[bj][1] = *(const f32x4*)(bgate + colg + bj * HALF + 4); }
#pragma unroll
            for (int ai = 0; ai < 2; ++ai)
#pragma unroll
                for (int m = 0; m < 4; ++m) { const int r = row0 + ai * HALF + m * 16; const float rs = row_rstd(ssq, r); unsigned char* rowp = (unsigned char*)gates + (size_t)r * GP + colg;
#pragma unroll
                    for (int bj = 0; bj < 2; ++bj) { const f32x4 v0 = acc[ai][bj][m][0] * rs + bv[bj][0], v1 = acc[ai][bj][m][1] * rs + bv[bj][1];
                        unsigned w0 = 0u, w1 = 0u;
#pragma unroll
                        for (int e = 0; e < 4; ++e) { w0 |= (unsigned)(fsigmoid(v0[e]) * 255.f + 0.5f) << (8 * e); w1 |= (unsigned)(fsigmoid(v1[e]) * 255.f + 0.5f) << (8 * e); }
                        u32x2 w; w.x = w0; w.y = w1; *(u32x2*)(rowp + bj * HALF) = w; } }
        }
    }
};
template <int BR> struct EpiMerge {
    static constexpr bool PERM = true, AFTER_DRAIN = false;
    const bf16_t* gates; bf16_t* merged;
    __device__ __forceinline__ void operator()(const f32x4 (&acc)[2][2][4][2], const Unit& u, int wr, int wc, int fr, int fq) const {
        const int row0 = u.pm * BM + wr * 64 + fr, cin = wc * 32 + 8 * fq;
#pragma unroll
        for (int ai = 0; ai < 2; ++ai) {
            u32x2 gv[4][2]; u32x4 pv[4][2];
#pragma unroll
            for (int m = 0; m < 4; ++m)
#pragma unroll
                for (int bj = 0; bj < 2; ++bj) { const int r = row0 + ai * HALF + m * 16, col = u.pn * BM + bj * HALF + cin;
                    gv[m][bj] = *(const u32x2*)((const unsigned char*)gates + (size_t)r * GP + BR * 1024 + col);
                    if (BR > 0) pv[m][bj] = *(const u32x4*)(merged + (size_t)r * DM + col); }
#pragma unroll
            for (int m = 0; m < 4; ++m)
#pragma unroll
                for (int bj = 0; bj < 2; ++bj) { const int r = row0 + ai * HALF + m * 16, col = u.pn * BM + bj * HALF + cin;
                    const u32x2 g = gv[m][bj];
                    f32x4 o0 = {0.f, 0.f, 0.f, 0.f}, o1 = {0.f, 0.f, 0.f, 0.f};
                    if (BR > 0) { const u32x4 p = pv[m][bj]; o0 = (f32x4){bflo(p.x), bfhi(p.x), bflo(p.y), bfhi(p.y)}; o1 = (f32x4){bflo(p.z), bfhi(p.z), bflo(p.w), bfhi(p.w)}; }
                    const float k255 = 1.f / 255.f;
                    const f32x4 g0 = {(float)(g.x & 255u) * k255, (float)((g.x >> 8) & 255u) * k255, (float)((g.x >> 16) & 255u) * k255, (float)(g.x >> 24) * k255};
                    const f32x4 g1 = {(float)(g.y & 255u) * k255, (float)((g.y >> 8) & 255u) * k255, (float)((g.y >> 16) & 255u) * k255, (float)(g.y >> 24) * k255};
                    o0 += g0 * acc[ai][bj][m][0]; o1 += g1 * acc[ai][bj][m][1];
                    *(u32x4*)(merged + (size_t)r * DM + col) = pack_f8(o0, o1); }
            asm volatile("" ::: "memory"); }
    }
};
struct EpiResid {
    static constexpr bool PERM = true, AFTER_DRAIN = false;
    const float* x32; const bf16_t* x16; float* o32; bf16_t* oa; bf16_t* ob; float* ssq;
    __device__ __forceinline__ void operator()(const f32x4 (&acc)[2][2][4][2], const Unit& u, int wr, int wc, int fr, int fq) const {
        const int row0 = u.pm * BM + wr * 64 + fr, cin = wc * 32 + 8 * fq;
#pragma unroll
        for (int ai = 0; ai < 2; ++ai)
#pragma unroll
            for (int m = 0; m < 4; ++m) { const int r = row0 + ai * HALF + m * 16; float ss = 0.f;
#pragma unroll
                for (int bj = 0; bj < 2; ++bj) { const size_t off = (size_t)r * DM + u.pn * BM + bj * HALF + cin;
                    f32x4 x0, x1;
                    if (x32) { x0 = *(const f32x4*)(x32 + off); x1 = *(const f32x4*)(x32 + off + 4); }
                    else { const u32x4 p = *(const u32x4*)(x16 + off); x0 = (f32x4){bflo(p.x), bfhi(p.x), bflo(p.y), bfhi(p.y)}; x1 = (f32x4){bflo(p.z), bfhi(p.z), bflo(p.w), bfhi(p.w)}; }
                    x0 += acc[ai][bj][m][0]; x1 += acc[ai][bj][m][1];
                    if (o32) { *(f32x4*)(o32 + off) = x0; *(f32x4*)(o32 + off + 4) = x1; }
                    const u32x4 pk = pack_f8(x0, x1);
                    if (oa) *(u32x4*)(oa + off) = pk;
                    if (ob) *(u32x4*)(ob + off) = pk;
                    ss += (x0[0] * x0[0] + x0[1] * x0[1]) + (x0[2] * x0[2] + x0[3] * x0[3]) + (x1[0] * x1[0] + x1[1] * x1[1]) + (x1[2] * x1[2] + x1[3] * x1[3]); }
                { const int ln_ = fr | (fq << 4); ss += shx(ss, 16, ln_); ss += shx(ss, 32, ln_); }
                if (fq == 0) ssq[(size_t)r * 16 + u.pn * 4 + wc] = ss;
                asm volatile("" ::: "memory"); }
    }
};
struct EpiFfn1 {
    static constexpr bool PERM = true, AFTER_DRAIN = false;
    bf16_t* hid; const float* ssq;
    __device__ __forceinline__ void operator()(const f32x4 (&acc)[2][2][4][2], const Unit& u, int wr, int wc, int fr, int fq) const {
        const int row0 = u.pm * BM + wr * 64 + fr, cin = wc * 32 + 8 * fq;
#pragma unroll
        for (int ai = 0; ai < 2; ++ai)
#pragma unroll
            for (int m = 0; m < 4; ++m) { const int r = row0 + ai * HALF + m * 16; const float rs = row_rstd(ssq, r);
                f32x4 o[2];
#pragma unroll
                for (int n = 0; n < 2; ++n) { const f32x4 g = acc[ai][0][m][n] * rs, up = acc[ai][1][m][n] * rs;
#pragma unroll
                    for (int e = 0; e < 4; ++e) o[n][e] = g[e] * fsigmoid(g[e]) * up[e]; }
                *(u32x4*)(hid + (size_t)r * FF + u.pn * HALF + cin) = pack_f8(o[0], o[1]);
                asm volatile("" ::: "memory"); }
    }
};
}

#define XB_TMO      128
#define XB_XCNT(j)  (256  + 64 * (j))
#define XB_XSUB(j)  (1280 + 64 * (j))
#define XB_XGEN(j)  (2304 + 64 * (j))
#define XB_TOP      3328
#define XB_TOPGEN   3392
#define XCD_BAR_WORDS 3456
#define XB_SPIN_CAP (1u << 18)

__device__ __forceinline__ unsigned xb_ld(unsigned* p)              { return __hip_atomic_load(p, __ATOMIC_RELAXED, __HIP_MEMORY_SCOPE_AGENT); }
__device__ __forceinline__ unsigned xb_add(unsigned* p, unsigned v) { return __hip_atomic_fetch_add(p, v, __ATOMIC_RELAXED, __HIP_MEMORY_SCOPE_AGENT); }
__device__ __forceinline__ unsigned xb_xcc_id() { return (unsigned)__builtin_amdgcn_s_getreg((3 << 11) | 20) & 0xFu; }
#define XB_SPIN(cond, bar) do { unsigned _sp = 0; while (cond) { __builtin_amdgcn_s_sleep(1); \
    if ((++_sp & 255u) == 0u) { if (xb_ld(&(bar)[XB_TMO])) break; if (_sp > XB_SPIN_CAP) { atomicAdd(&(bar)[XB_TMO], 1u); break; } } } } while (0)

struct XcdBarrier {
    unsigned* bar; unsigned x;
    volatile LAS unsigned* st;
};

__device__ __forceinline__ XcdBarrier xcd_barrier_post(unsigned* bar, volatile LAS unsigned* st, bool is0) {
    XcdBarrier b; b.bar = bar; b.x = xb_xcc_id(); b.st = st;
    if (is0) (void)xb_add(&bar[XB_XCNT(b.x)], 1u);
    return b;
}
__device__ __forceinline__ void xcd_barrier_complete(unsigned* bar, unsigned x, unsigned& nloc, unsigned& nx) {
    const unsigned G = gridDim.x * gridDim.y * gridDim.z;
    unsigned sum, cnt, mine, sp = 0u;
    for (;;) {
        sum = 0u; cnt = 0u; mine = 0u;
#pragma unroll
        for (unsigned j = 0; j < 16; ++j) { const unsigned c = xb_ld(&bar[XB_XCNT(j)]); sum += c; cnt += (c > 0u) ? 1u : 0u; mine = (j == x) ? c : mine; }
        if (sum == G) break;
        __builtin_amdgcn_s_sleep(1);
        if ((++sp & 255u) == 0u) { if (xb_ld(&bar[XB_TMO])) break; if (sp > XB_SPIN_CAP) { atomicAdd(&bar[XB_TMO], 1u); break; } }
    }
    nloc = mine > 0u ? mine : 1u; nx = cnt > 0u ? cnt : 1u;
}

__device__ __forceinline__ void xcd_barrier(const XcdBarrier& b, bool is0) {
    asm volatile("s_waitcnt vmcnt(0)" ::: "memory");
    __syncthreads();
    if (is0) {
        unsigned* bar = b.bar;
        __builtin_amdgcn_s_waitcnt(0);
        unsigned nloc = b.st[0], nx = b.st[1];
        if (nloc == 0u) { xcd_barrier_complete(bar, b.x, nloc, nx); b.st[0] = nloc; b.st[1] = nx; }
        const unsigned old = xb_add(&bar[XB_XSUB(b.x)], 1u);
        const unsigned gen = old / nloc;
        if (old + 1u == (gen + 1u) * nloc) {
            __builtin_amdgcn_fence(__ATOMIC_RELEASE, "agent");
            asm volatile("s_waitcnt vmcnt(0)" ::: "memory");
            const unsigned og = xb_add(&bar[XB_TOP], 1u);
            const unsigned tg = og / nx;
            if (og + 1u == (tg + 1u) * nx) xb_add(&bar[XB_TOPGEN], 1u);
            else XB_SPIN(xb_ld(&bar[XB_TOPGEN]) == tg, bar);
            __builtin_amdgcn_fence(__ATOMIC_ACQUIRE, "agent");
            xb_add(&bar[XB_XGEN(b.x)], 1u);
            asm volatile("s_waitcnt vmcnt(0)" ::: "memory");
        } else {
            XB_SPIN(xb_ld(&bar[XB_XGEN(b.x)]) == gen, bar);
            __builtin_amdgcn_fence(__ATOMIC_ACQUIRE, "agent");
            asm volatile("s_waitcnt vmcnt(0)" ::: "memory");
        }
    }
    __syncthreads();
}


struct Args { const float* in[31]; float* out; unsigned char* ws; };
typedef const float* cfptr_t;
__device__ __forceinline__ cfptr_t kin(int i) { const volatile __attribute__((address_space(4))) cfptr_t* p = (const volatile __attribute__((address_space(4))) cfptr_t*)__builtin_amdgcn_kernarg_segment_ptr(); return p[i]; }

struct ConvD { const float* W; const float* gain; bf16_t* dst; int N, k0, n0, ldk, split; };
__device__ __forceinline__ void conv_load(const ConvD& d, LAS float* scr, int tid) {
    const int n4 = tid & 15, kk = tid >> 4;
#pragma unroll
    for (int i = 0; i < 2; ++i) { const int k = kk + 32 * i; f32x4 v = *(const f32x4*)(d.W + (size_t)(d.k0 + k) * d.N + d.n0 + 4 * n4); if (d.gain) v *= d.gain[d.k0 + k];
        LAS float* s = scr + k * 65 + 4 * n4; s[0] = v[0]; s[1] = v[1]; s[2] = v[2]; s[3] = v[3]; }
}
__device__ __forceinline__ void conv_store(const ConvD& d, const LAS float* scr, int tid) {
    const int nn = tid >> 3, c = tid & 7;
    const LAS float* s = scr + (8 * c) * 65 + nn;
    u32x4 o; o.x = pk2(s[0], s[65]); o.y = pk2(s[130], s[195]); o.z = pk2(s[260], s[325]); o.w = pk2(s[390], s[455]);
    *(u32x4*)(d.dst + (size_t)((d.split && nn >= 32) ? nn + 96 : nn) * d.ldk + d.k0 + 8 * c) = o;
}
__device__ __forceinline__ ConvD conv_desc(int it, int l, unsigned char* Wb) {
    ConvD d; d.gain = nullptr; d.split = 0; int r = it;
    if (r < 1408) { const int kb = r / 88, nb = r % 88; const bool qk = (nb >= 16 && nb < 32); const int brow = qk ? (256 * (4 + ((nb - 16) >> 2)) + 32 * ((nb - 16) & 3)) : nb * 64;
        d.W = kin(2) + (size_t)l * DM * INC; d.N = INC; d.k0 = kb * 64; d.n0 = nb * 64; d.dst = (bf16_t*)(Wb + W_IN) + (size_t)brow * DM; d.ldk = DM; d.gain = kin(1) + l * DM; d.split = qk; return d; } r -= 1408;
    if (r < 64) { const int kb = r / 16, nb = r % 16; d.W = kin(23) + (size_t)l * 256 * DM; d.N = DM; d.k0 = kb * 64; d.n0 = nb * 64; d.dst = (bf16_t*)(Wb + W_PA) + (size_t)nb * 64 * 256; d.ldk = 256; return d; } r -= 64;
    if (r < 64) { const int kb = r / 16, nb = r % 16; d.W = kin(24) + (size_t)l * 256 * DM; d.N = DM; d.k0 = kb * 64; d.n0 = nb * 64; d.dst = (bf16_t*)(Wb + W_PB) + (size_t)nb * 64 * 256; d.ldk = 256; return d; } r -= 64;
    if (r < 128) { const int kb = r / 16, nb = r % 16; d.W = kin(25) + (size_t)l * 512 * DM; d.N = DM; d.k0 = kb * 64; d.n0 = nb * 64; d.dst = (bf16_t*)(Wb + W_PC) + (size_t)nb * 64 * 512; d.ldk = 512; return d; } r -= 128;
    if (r < 256) { const int kb = r / 16, nb = r % 16; d.W = kin(26) + (size_t)l * DM * DM; d.N = DM; d.k0 = kb * 64; d.n0 = nb * 64; d.dst = (bf16_t*)(Wb + W_O) + (size_t)nb * 64 * DM; d.ldk = DM; return d; } r -= 256;
    if (r < 704) { const int kb = r / 44, nb = r % 44; d.W = kin(28) + (size_t)l * DM * FF; d.N = FF; d.k0 = kb * 64; d.n0 = nb * 64; d.dst = (bf16_t*)(Wb + W_FF) + (size_t)(256 * (nb >> 1) + 64 * (nb & 1)) * DM; d.ldk = DM; d.gain = kin(27) + l * DM; return d; } r -= 704;
    if (r < 704) { const int kb = r / 44, nb = r % 44; d.W = kin(29) + (size_t)l * DM * FF; d.N = FF; d.k0 = kb * 64; d.n0 = nb * 64; d.dst = (bf16_t*)(Wb + W_FF) + (size_t)(256 * (nb >> 1) + 128 + 64 * (nb & 1)) * DM; d.ldk = DM; d.gain = kin(27) + l * DM; return d; } r -= 704;
    { const int kb = r / 16, nb = r % 16; d.W = kin(30) + (size_t)l * FF * DM; d.N = DM; d.k0 = kb * 64; d.n0 = nb * 64; d.dst = (bf16_t*)(Wb + W_DN) + (size_t)nb * 64 * FF; d.ldk = FF; return d; }
}
__device__ __forceinline__ void convert_layer(int l, unsigned char* Wb, LAS float* scr, int tid, int bid, int G) {
    for (int it = bid; it < 4032; it += 6 * G) {
        const ConvD d0 = conv_desc(it, l, Wb);
        const bool v1 = it + G < 4032, v2 = it + 2 * G < 4032, v3 = it + 3 * G < 4032, v4 = it + 4 * G < 4032, v5 = it + 5 * G < 4032;
        const ConvD d1 = conv_desc(v1 ? it + G : it, l, Wb), d2 = conv_desc(v2 ? it + 2 * G : it, l, Wb), d3 = conv_desc(v3 ? it + 3 * G : it, l, Wb), d4 = conv_desc(v4 ? it + 4 * G : it, l, Wb), d5 = conv_desc(v5 ? it + 5 * G : it, l, Wb);
        conv_load(d0, scr, tid); if (v1) conv_load(d1, scr + 4160, tid); if (v2) conv_load(d2, scr + 2 * 4160, tid); if (v3) conv_load(d3, scr + 3 * 4160, tid); if (v4) conv_load(d4, scr + 4 * 4160, tid); if (v5) conv_load(d5, scr + 5 * 4160, tid);
        __syncthreads();
        conv_store(d0, scr, tid); if (v1) conv_store(d1, scr + 4160, tid); if (v2) conv_store(d2, scr + 2 * 4160, tid); if (v3) conv_store(d3, scr + 3 * 4160, tid); if (v4) conv_store(d4, scr + 4 * 4160, tid); if (v5) conv_store(d5, scr + 5 * 4160, tid);
        __syncthreads();
    }
}
__device__ __forceinline__ void convert_small(bf16_t* sm, int tid, int bid, int G) {
    for (int idx = bid * 512 + tid; idx < NL * SMALL_PER_LAYER; idx += G * 512) {
        const int l = idx / SMALL_PER_LAYER, e = idx % SMALL_PER_LAYER; float v;
        if (e < 32768) { const int e2 = e & 16383, hd = e2 >> 12, o = (e2 >> 6) & 63, i = e2 & 63; const float* src = (e < 16384) ? kin(6) : kin(8); v = src[(size_t)((l * 4 + hd) * 64 + i) * 64 + o]; }
        else { const int e2 = e - 32768, t = (e2 >> 7) & 127, s = e2 & 127; v = (s <= t) ? kin(13)[(size_t)l * 65536 + e2] : 0.f; }
        sm[idx] = f2bf(v);
    }
}
__device__ __forceinline__ void x_pass(const float* x, bf16_t* xb, float* ssq, int lane, int gw, int NGW) {
    for (int m0 = gw; m0 < MT; m0 += 4 * NGW) {
        f32x4 v[4][4];
#pragma unroll
        for (int q = 0; q < 4; ++q) { const int m = m0 + q * NGW; const f32x4* xr = (const f32x4*)(x + (size_t)(m < MT ? m : m0) * DM) + lane;
#pragma unroll
            for (int j = 0; j < 4; ++j) v[q][j] = xr[64 * j]; }
#pragma unroll
        for (int q = 0; q < 4; ++q) { const int m = m0 + q * NGW; if (m >= MT) break;
            u32x2* o = (u32x2*)(xb + (size_t)m * DM) + lane; float ss = 0.f;
#pragma unroll
            for (int j = 0; j < 4; ++j) { const f32x4 t = v[q][j]; ss += (t[0] * t[0] + t[1] * t[1]) + (t[2] * t[2] + t[3] * t[3]); u32x2 w; w.x = pk2(t[0], t[1]); w.y = pk2(t[2], t[3]); o[64 * j] = w; }
            ss = wave_sum(ss, lane);
            if (lane < 16) ssq[(size_t)m * 16 + lane] = (lane == 0) ? ss : 0.f; }
    }
}
__device__ __forceinline__ void qk_norm(bf16_t* proj, bf16_t* outp, int opitch, const float* qg, const float* kg, int lane, int gw, int NGW) {
    const int d0 = (lane * 8) & 63; float gq[8], gk[8];
#pragma unroll
    for (int e = 0; e < 8; ++e) { gq[e] = qg[d0 + e] * (0.125f * LOG2E); gk[e] = kg[d0 + e]; }
    for (int m = gw; m < MT; m += NGW) {
        bf16_t* base = proj + (size_t)m * PJ + 1024;
#pragma unroll
        for (int i = 0; i < 2; ++i) { const u32x4* p = (const u32x4*)(base + (lane + 64 * i) * 8); const u32x4 v = *p; u32x4* po = (u32x4*)(outp + (size_t)m * opitch + (lane + 64 * i) * 8);
            float f[8] = {bflo(v.x), bfhi(v.x), bflo(v.y), bfhi(v.y), bflo(v.z), bfhi(v.z), bflo(v.w), bfhi(v.w)};
            float ss = 0.f;
#pragma unroll
            for (int e = 0; e < 8; ++e) ss += f[e] * f[e];
            ss += shx(ss, 1, lane); ss += shx(ss, 2, lane); ss += shx(ss, 4, lane);
            const float rs = __builtin_amdgcn_rsqf(ss * (1.f / 64.f) + EPS);
#pragma unroll
            for (int e = 0; e < 8; ++e) f[e] *= rs * (i == 0 ? gq[e] : gk[e]);
            u32x4 w; w.x = pk2(f[0], f[1]); w.y = pk2(f[2], f[3]); w.z = pk2(f[4], f[5]); w.w = pk2(f[6], f[7]); *po = w; }
    }
}

constexpr int LRU_XA = 0, LRU_XP = 528, LRU_CW = 35392;
struct LruP { const float *cw, *cb, *ba, *bi, *lam; const bf16_t *waT, *wiT; };
template <bool FINAL> __device__ __forceinline__ void lru_unit(LAS unsigned char* lds, bf16_t* proj, bf16_t* outp, int opitch, float* agg, const LruP& P, int b, int chunk, int tid) {
    const int lane = tid & 63, r = lane & 31, h = lane >> 5, w = __builtin_amdgcn_readfirstlane(tid >> 6), hd = w >> 1, cbk = w & 1;
    const size_t Rb = (size_t)b * SEQ; const int t0 = chunk * 64;
    { u32x4 xv[5];
#pragma unroll
      for (int i = 0; i < 5; ++i) { const int c = tid + 512 * i, j = c >> 5, cc = c & 31, tok = t0 - 3 + j; xv[i] = (u32x4){0u, 0u, 0u, 0u};
          if (c < 67 * 32 && tok >= 0) xv[i] = *(const u32x4*)(proj + (Rb + tok) * PJ + cc * 8); }
#pragma unroll
      for (int i = 0; i < 5; ++i) { const int c = tid + 512 * i, j = c >> 5, cc = c & 31; if (c < 67 * 32) *(LAS u32x4*)(lds + LRU_XA + j * LRU_XP + cc * 16) = xv[i]; } }
    LAS float* CWl = (LAS float*)(lds + LRU_CW);
    for (int i = tid; i < 1280; i += 512) CWl[i] = (i < 1024) ? P.cw[i] : P.cb[i - 1024];
    __syncthreads();
    const int oc = hd * 64 + cbk * 32 + r;
    float Hc = 0.f;
    if (FINAL) {
        const int mid = chunk >> 1, lo = h ? mid : 0, hi2 = h ? chunk : mid; float PA = 1.f, PH = 0.f;
        const f32x2* ap = (const f32x2*)agg + ((size_t)b * 256) * 256 + oc;
        int j = lo;
        for (; j + 48 <= hi2; j += 48) { f32x2 qv[48];
#pragma unroll
            for (int i = 0; i < 48; ++i) qv[i] = ap[(size_t)(j + i) * 256];
#pragma unroll
            for (int i = 0; i < 48; ++i) { PH = qv[i].x * PH + qv[i].y; PA *= qv[i].x; } }
        for (; j + 8 <= hi2; j += 8) { f32x2 qv[8];
#pragma unroll
            for (int i = 0; i < 8; ++i) qv[i] = ap[(size_t)(j + i) * 256];
#pragma unroll
            for (int i = 0; i < 8; ++i) { PH = qv[i].x * PH + qv[i].y; PA *= qv[i].x; } }
        for (; j < hi2; ++j) { const f32x2 q = ap[(size_t)j * 256]; PH = q.x * PH + q.y; PA *= q.x; }
        const float oPA = shx(PA, 32, lane), oPH = shx(PH, 32, lane);
        Hc = h ? (PA * oPH + PH) : (oPA * PH + oPH);
        asm volatile("" : "+v"(Hc));
    }
    const float cw0 = CWl[oc], cw1 = CWl[256 + oc], cw2 = CWl[512 + oc], cw3 = CWl[768 + oc], cbv = CWl[1024 + oc];
    const float bav = P.ba[oc], biv = P.bi[oc], elam = __builtin_amdgcn_exp2f(-P.lam[oc] * LOG2E), cl = -8.f * ((elam < 0.03f) ? elam * (1.f - elam * (0.5f - elam * (0.33333334f - elam * 0.25f))) : __builtin_amdgcn_logf(1.f + elam) * 0.6931471805599453f);
    float av[2][16], bv[2][16];
#pragma unroll
    for (int rb = 0; rb < 2; ++rb) { f32x16 acca = (f32x16){}, acci = (f32x16){};
#pragma unroll
        for (int ks = 0; ks < 4; ++ks) { const int ci0 = hd * 64 + 16 * ks + 8 * h;
            const bf16x8 waf = *(const bf16x8*)(P.waT + (size_t)oc * 64 + 16 * ks + 8 * h), wif = *(const bf16x8*)(P.wiT + (size_t)oc * 64 + 16 * ks + 8 * h);
            const f32x4 c0 = *(const LAS f32x4*)(CWl + 1024 + ci0), c1 = *(const LAS f32x4*)(CWl + 1024 + ci0 + 4);
            float xc[8] = {c0[0], c0[1], c0[2], c0[3], c1[0], c1[1], c1[2], c1[3]};
#pragma unroll
            for (int tap = 0; tap < 4; ++tap) { const u32x4 xv = *(const LAS u32x4*)(lds + LRU_XA + (32 * rb + r + tap) * LRU_XP + ci0 * 2);
                const f32x4 w0 = *(const LAS f32x4*)(CWl + tap * 256 + ci0), w1 = *(const LAS f32x4*)(CWl + tap * 256 + ci0 + 4);
                xc[0] += w0[0] * bflo(xv.x); xc[1] += w0[1] * bfhi(xv.x); xc[2] += w0[2] * bflo(xv.y); xc[3] += w0[3] * bfhi(xv.y);
                xc[4] += w1[0] * bflo(xv.z); xc[5] += w1[1] * bfhi(xv.z); xc[6] += w1[2] * bflo(xv.w); xc[7] += w1[3] * bfhi(xv.w); }
            const bf16x8 af = pack8(xc[0], xc[1], xc[2], xc[3], xc[4], xc[5], xc[6], xc[7]);
            acca = MFMA32(af, waf, acca); acci = MFMA32(af, wif, acci); }
#pragma unroll
        for (int i = 0; i < 16; ++i) { const int tok = 32 * rb + crow(i, h);
            const LAS bf16_t* xp = (const LAS bf16_t*)(lds + LRU_XA + tok * LRU_XP + oc * 2);
            const float xc = cbv + cw0 * bf2f(xp[0]) + cw1 * bf2f(xp[LRU_XP / 2]) + cw2 * bf2f(xp[LRU_XP]) + cw3 * bf2f(xp[3 * LRU_XP / 2]);
            const float rg = fsigmoid(acca[i] + bav), ig = fsigmoid(acci[i] + biv), la = cl * rg;
            const float x2 = 2.f * la;
            const float em1 = (x2 > -0.03f) ? x2 * (1.f + x2 * (0.5f + x2 * (0.16666667f + x2 * 0.041666668f))) : (__builtin_amdgcn_exp2f(x2 * LOG2E) - 1.f);
            av[rb][i] = __builtin_amdgcn_exp2f(la * LOG2E); bv[rb][i] = __builtin_amdgcn_sqrtf(-em1) * ig * xc; }
#pragma unroll
        for (int i = 0; i < 16; ++i) asm volatile("" : "+v"(av[rb][i]), "+v"(bv[rb][i]));
    }
    float Ag[8], Bg[8];
#pragma unroll
    for (int k = 0; k < 8; ++k) { const int rb = k >> 2, i0 = 4 * (k & 3);
        Ag[k] = (av[rb][i0] * av[rb][i0 + 1]) * (av[rb][i0 + 2] * av[rb][i0 + 3]);
        Bg[k] = ((bv[rb][i0] * av[rb][i0 + 1] + bv[rb][i0 + 1]) * av[rb][i0 + 2] + bv[rb][i0 + 2]) * av[rb][i0 + 3] + bv[rb][i0 + 3]; }
    float myin[8]; float Pp = 1.f;
#pragma unroll
    for (int k = 0; k < 8; ++k) { const float pA = shx(Ag[k], 32, lane), pB = shx(Bg[k], 32, lane);
        const float A0 = h ? pA : Ag[k], B0 = h ? pB : Bg[k], A1 = h ? Ag[k] : pA, B1 = h ? Bg[k] : pB;
        const float in0 = Hc; Hc = A0 * Hc + B0; const float in1 = Hc; Hc = A1 * Hc + B1; myin[k] = h ? in1 : in0; Pp *= A0 * A1; }
    if (!FINAL) { if (h == 0) { f32x2 q; q.x = Pp; q.y = Hc; ((f32x2*)agg)[((size_t)b * 256 + chunk) * 256 + oc] = q; } }
    else {
        bf16_t gav[8][4];
#pragma unroll
        for (int k = 0; k < 8; ++k)
#pragma unroll
            for (int j = 0; j < 4; ++j) { const int tok = 32 * (k >> 2) + 8 * (k & 3) + 4 * h + j; gav[k][j] = *(const bf16_t*)(proj + (Rb + t0 + tok) * PJ + 256 + oc); }
#pragma unroll
        for (int k = 0; k < 8; ++k) { const int rb = k >> 2, i0 = 4 * (k & 3); float hh = myin[k];
#pragma unroll
            for (int j = 0; j < 4; ++j) { hh = av[rb][i0 + j] * hh + bv[rb][i0 + j]; const int tok = 32 * rb + 8 * (k & 3) + 4 * h + j;
                const float ga = bf2f(gav[k][j]); bf16_t* go = outp + (Rb + t0 + tok) * opitch + oc;
                const float z = 1.5957691216057308f * (ga + 0.044715f * ga * ga * ga);
                *go = f2bf(hh * ga * fsigmoid(z)); } }
    }
    __syncthreads();
}

constexpr int SG_VP = 272;
struct SgP { const float *lng, *lnb, *sgb; const bf16_t* sgw; };
__device__ __forceinline__ void sg_unit(LAS unsigned char* lds, bf16_t* proj, bf16_t* outp, int opitch, const SgP& P, int n, int tid) {
    const int lane = tid & 63, r = lane & 31, h = lane >> 5, w = __builtin_amdgcn_readfirstlane(tid >> 6);
    const size_t R0 = (size_t)n * 128;
    { const f32x4 g4 = *(const f32x4*)(P.lng + lane * 4), b4 = *(const f32x4*)(P.lnb + lane * 4);
      u32x2 raws[16];
#pragma unroll
      for (int rr = 0; rr < 16; ++rr) raws[rr] = *(const u32x2*)(proj + (R0 + w * 16 + rr) * PJ + 768 + lane * 4);
#pragma unroll
      for (int rr = 0; rr < 16; ++rr) { const int t = w * 16 + rr; const u32x2 raw = raws[rr];
        float v[4] = {bflo(raw.x), bfhi(raw.x), bflo(raw.y), bfhi(raw.y)};
        const float mean = wave_sum((v[0] + v[1]) + (v[2] + v[3]), lane) * (1.f / 256.f);
#pragma unroll
        for (int e = 0; e < 4; ++e) v[e] -= mean;
        const float var = wave_sum((v[0] * v[0] + v[1] * v[1]) + (v[2] * v[2] + v[3] * v[3]), lane) * (1.f / 256.f);
        const float rs = __builtin_amdgcn_rsqf(var + EPS);
#pragma unroll
        for (int e = 0; e < 4; ++e) *(LAS bf16_t*)(lds + (lane * 4 + e) * SG_VP + t * 2) = f2bf(v[e] * rs * g4[e] + b4[e]); } }
    __syncthreads();
    const int g = w >> 1, cbk = w & 1, c = g * 64 + cbk * 32 + r;
#pragma unroll
    for (int tb = 0; tb < 4; ++tb) { f32x16 acc = (f32x16){};
        const bf16_t* wp = P.sgw + (size_t)(g * 128 + 32 * tb + r) * 128 + 8 * h;
#pragma unroll
        for (int ks = 0; ks < 2 * tb + 2; ++ks) { const bf16x8 af = *(const bf16x8*)(wp + 16 * ks); const bf16x8 bfr = *(const LAS bf16x8*)(lds + c * SG_VP + (16 * ks + 8 * h) * 2); acc = MFMA32(af, bfr, acc); }
        bf16_t uv[16]; float sbv[16];
#pragma unroll
        for (int i = 0; i < 16; ++i) { const int t = 32 * tb + crow(i, h); uv[i] = *(const bf16_t*)(proj + (R0 + t) * PJ + 512 + c); sbv[i] = P.sgb[g * 128 + t]; }
#pragma unroll
        for (int i = 0; i < 16; ++i) { const int t = 32 * tb + crow(i, h); outp[(R0 + t) * opitch + c] = f2bf(bf2f(uv[i]) * (acc[i] + sbv[i])); } }
    __syncthreads();
}

constexpr int AT_SLOT = 16384, AT_K = 0, AT_V = 4 * AT_SLOT, AT_TAB = 131072 + 1024;
__device__ __forceinline__ void glds16(const void* gsrc, unsigned lds_dst) {
    unsigned keep;
    asm volatile("s_mov_b32 %0, m0\n\ts_mov_b32 m0, %2\n\ts_nop 0\n\tglobal_load_lds_dwordx4 %1, off\n\ts_mov_b32 m0, %0" : "=&s"(keep) : "v"(gsrc), "s"(lds_dst) : "memory");
}
__device__ __forceinline__ void at_qk(f32x16& p0, f32x16& p1, const LAS unsigned char* lk, const int (&koff)[4], const bf16x8 (&qf)[4]) {
    const f32x16 z = (f32x16){};
#pragma unroll
    for (int ks = 0; ks < 4; ++ks) { const bf16x8 a0 = *(const LAS bf16x8*)(lk + koff[ks]), a1 = *(const LAS bf16x8*)(lk + koff[ks] + 8192);
        p0 = MFMA32(a0, qf[ks], ks == 0 ? z : p0); p1 = MFMA32(a1, qf[ks], ks == 0 ? z : p1); }
}
__device__ __forceinline__ void at_bias(f32x16& p0, f32x16& p1, const LAS float* tb) {
#pragma unroll
    for (int i = 0; i < 16; ++i) { const int kk = (i & 3) + 8 * (i >> 2); p0[i] += tb[kk]; p1[i] += tb[32 + kk]; }
}
template <bool DOQK, bool DOEXP, bool DOPV, int VAR> __device__ __forceinline__ void at_fused(f32x16& pn0, f32x16& pn1, f32x16& pc0, f32x16& pc1, bf16x8 (&pfc)[4], const bf16x8 (&pfp)[4], f32x16 (&o)[4], float& lsum,
                                         const LAS unsigned char* lk, const LAS unsigned char* lv, const int (&koff)[4], const int (&voff)[4], const bf16x8 (&qf)[4]) {
    constexpr int PD = 6, NF = PD + 1;
    bf16x8 fr[NF];
#define AT_NEED(g) (((g) < 8) ? DOQK : DOPV)
#define AT_FRAG(g) (((g) < 8) ? *(const LAS bf16x8*)(lk + koff[(g) >> 1] + ((g) & 1) * 8192) : *(const LAS bf16x8*)(lv + voff[((g) - 8) >> 2] + (((g) - 8) & 3) * 4096))
#define AT_EX2(x) ((VAR == 1) ? (x) : __builtin_amdgcn_exp2f(x))
#define AT_EXP(e) do { if ((e) < 16) { pc0[(e)] = AT_EX2(pc0[(e)]); s0 += pc0[(e)]; } else { pc1[(e) - 16] = AT_EX2(pc1[(e) - 16]); s1 += pc1[(e) - 16]; } } while (0)
#pragma unroll
    for (int g = 0; g < PD; ++g) { if (AT_NEED(g)) fr[g % NF] = AT_FRAG(g); else fr[g % NF] = (bf16x8){}; }
    float s0 = 0.f, s1 = 0.f;
    const f32x16 z = (f32x16){};
#pragma unroll
    for (int g = 0; g < 24; ++g) {
        if (g + PD < 24 && AT_NEED(g + PD)) fr[(g + PD) % NF] = AT_FRAG(g + PD);
        if (g < 8) { const int ks = g >> 1;
            if (!DOQK || VAR == 2) {} else if (g & 1) pn1 = MFMA32(fr[g % NF], qf[ks], ks == 0 ? z : pn1); else pn0 = MFMA32(fr[g % NF], qf[ks], ks == 0 ? z : pn0);
        } else if (DOPV && VAR != 2) { const int sp = (g - 8) >> 2, db = (g - 8) & 3; o[db] = MFMA32(fr[g % NF], pfp[sp], o[db]); }
        if (DOEXP) {
            const int e0 = g + (g + 2) / 3, e1 = (g + 1) + (g + 3) / 3;
#pragma unroll
            for (int e = e0; e < e1; ++e) AT_EXP(e);
            asm volatile("" : "+v"(s0), "+v"(s1));
            if (g == 6) pfc[0] = pack8(pc0[0], pc0[1], pc0[2], pc0[3], pc0[4], pc0[5], pc0[6], pc0[7]);
            if (g == 12) pfc[1] = pack8(pc0[8], pc0[9], pc0[10], pc0[11], pc0[12], pc0[13], pc0[14], pc0[15]);
            if (g == 18) pfc[2] = pack8(pc1[0], pc1[1], pc1[2], pc1[3], pc1[4], pc1[5], pc1[6], pc1[7]);
        }
        __builtin_amdgcn_sched_barrier(0);
    }
    if (DOEXP) { pfc[3] = pack8(pc1[8], pc1[9], pc1[10], pc1[11], pc1[12], pc1[13], pc1[14], pc1[15]); lsum += s0 + s1; }
#undef AT_FRAG
#undef AT_NEED
#undef AT_EXP
#undef AT_EX2
}
template <int VAR> __device__ __forceinline__ void attn_unit(LAS unsigned char* lds, const bf16_t* proj, const bf16_t* vt, bf16_t* outp, int opitch, int b, int hd, int qb, float lam, float osc, const float* relb, const float* subg, int tid_in) {
    int tid = tid_in; asm volatile("" : "+v"(tid));
    const int lane = tid & 63, r = lane & 31, h = lane >> 5, w = __builtin_amdgcn_readfirstlane(tid >> 6), mp = w >> 2, rs = w & 3;
    LAS float* tab = (LAS float*)(lds + AT_TAB);
    const size_t Rb = (size_t)b * SEQ, R0 = Rb + (size_t)qb * 128;
    const int NT = 2 * qb + 2;
    const bool deep = NT >= 8;
    const int rk0 = 8 * w + (lane >> 4), rk1 = rk0 + 4, rv0 = 16 * w + (lane >> 3), rv1 = rv0 + 8;
    const bf16_t* ks0 = proj + (Rb + rk0) * PJ + 1536 + hd * 128 + (((lane & 15) ^ (rk0 & 15)) * 8);
    const bf16_t* ks1 = proj + (Rb + rk1) * PJ + 1536 + hd * 128 + (((lane & 15) ^ (rk1 & 15)) * 8);
    const bf16_t* vs0 = vt + ((size_t)((b * 4 + hd) * 128 + rv0)) * SEQ + (((lane & 7) ^ ((rv0 >> 1) & 7)) * 8);
    const bf16_t* vs1 = vt + ((size_t)((b * 4 + hd) * 128 + rv1)) * SEQ + (((lane & 7) ^ ((rv1 >> 1) & 7)) * 8);
    const unsigned ldsb = (unsigned)(uintptr_t)lds, kd = ldsb + AT_K + w * 2048, vd = ldsb + AT_V + w * 2048;
#define AT_ISSUE_K(j) do { const unsigned d_ = (unsigned)__builtin_amdgcn_readfirstlane(kd + ((j) & 3) * AT_SLOT); if (VAR != 3) { glds16(ks0 + (size_t)(j) * 64 * PJ, d_); glds16(ks1 + (size_t)(j) * 64 * PJ, d_ + 1024u); } } while (0)
#define AT_ISSUE_V(j) do { const unsigned d_ = (unsigned)__builtin_amdgcn_readfirstlane(vd + ((j) & 3) * AT_SLOT); if (VAR != 3) { glds16(vs0 + (j) * 64, d_); glds16(vs1 + (j) * 64, d_ + 1024u); } } while (0)
#define AT_WAITBAR(N) asm volatile("s_waitcnt vmcnt(" #N ") lgkmcnt(0)\n\ts_barrier" ::: "memory")
    AT_ISSUE_K(0); AT_ISSUE_K(1);
    if (2 < NT) AT_ISSUE_K(2);
    AT_ISSUE_V(0);
    if (3 < NT) AT_ISSUE_K(3);
    AT_ISSUE_V(1);
    { const float cfar = relb[15 * 4 + hd];
      if (tid < 64) tab[1216 + tid] = -INFINITY;
      for (int idx = tid; idx < 1216; idx += 512) { const int rel = idx - 1151, n = rel < 0 ? -rel : rel; int bk = (n < 8) ? n : (5 + (31 - __builtin_clz(n))); bk = bk > 15 ? 15 : bk; if (rel > 0) bk += 16; tab[idx] = (relb[bk * 4 + hd] - cfar) * LOG2E; } }
    bf16x8 qf[4];
    { const bf16_t* qp = proj + (R0 + 32 * rs + r) * PJ + 1024 + hd * 128 + mp * 64 + 8 * h;
#pragma unroll
      for (int ks = 0; ks < 4; ++ks) qf[ks] = *(const bf16x8*)(qp + 16 * ks); }
    int koff[4], voff[4];
    { const int kx = (mp * 8 + h) ^ (r & 15), vx = h ^ ((r >> 1) & 7);
#pragma unroll
      for (int i = 0; i < 4; ++i) { koff[i] = r * 256 + ((kx ^ (2 * i)) << 4); voff[i] = r * 128 + ((vx ^ (2 * i)) << 4); } }
    if (deep) AT_WAITBAR(8); else AT_WAITBAR(0);
    f32x16 o[4]; o[0] = (f32x16){}; o[1] = (f32x16){}; o[2] = (f32x16){}; o[3] = (f32x16){};
    float lsum = 0.f;
    const int qpos = qb * 128 + 32 * rs + r;
    const LAS float* tb0 = tab + (1151 + 4 * h - qpos);
    f32x16 pa0, pa1, pb0, pb1; bf16x8 pfA[4], pfB[4];
    pb0 = (f32x16){}; pb1 = (f32x16){};
#pragma unroll
    for (int i = 0; i < 4; ++i) { pfA[i] = (bf16x8){}; pfB[i] = (bf16x8){}; }
    at_qk(pa0, pa1, lds + AT_K, koff, qf);
    if (1088 > qb * 128) at_bias(pa0, pa1, tb0);
    asm volatile("s_waitcnt lgkmcnt(0)\n\ts_barrier" ::: "memory");
#define AT_STEP(t, C0, C1, N0, N1, PC, PP, DOPV) do { \
        if ((t) + 4 < NT) AT_ISSUE_K((t) + 4); \
        if ((t) + 2 < NT) AT_ISSUE_V((t) + 2); \
        at_fused<true, true, DOPV, VAR>(N0, N1, C0, C1, PC, PP, o, lsum, lds + AT_K + (((t) + 1) & 3) * AT_SLOT, lds + AT_V + (((t) + 3) & 3) * AT_SLOT, koff, voff, qf); \
        if (((t) + 1) * 64 + 1088 > qb * 128) at_bias(N0, N1, (rs < 2 && (t) + 2 == NT) ? (const LAS float*)(tab + 1216) : tb0 + ((t) + 1) * 64); \
        if ((t) + 4 < NT) AT_WAITBAR(8); else AT_WAITBAR(0); } while (0)
    AT_STEP(0, pa0, pa1, pb0, pb1, pfA, pfB, false);
    asm volatile(".p2align 8" ::: "memory");
    for (int t = 1; t + 1 < NT; t += 2) {
        AT_STEP(t, pb0, pb1, pa0, pa1, pfB, pfA, true);
        AT_STEP(t + 1, pa0, pa1, pb0, pb1, pfA, pfB, true);
    }
    at_fused<false, true, true, VAR>(pa0, pa1, pb0, pb1, pfB, pfA, o, lsum, lds + AT_K, lds + AT_V + ((NT - 2) & 3) * AT_SLOT, koff, voff, qf);
    at_fused<false, false, true, VAR>(pa0, pa1, pb0, pb1, pfA, pfB, o, lsum, lds + AT_K, lds + AT_V + ((NT - 1) & 3) * AT_SLOT, koff, voff, qf);
    __syncthreads();
#undef AT_STEP
#undef AT_ISSUE_K
#undef AT_ISSUE_V
#undef AT_WAITBAR
    int lane_e = tid & 63; asm volatile("" : "+v"(lane_e));
    lsum += shx(lsum, 32, lane_e);
    const float inv = __builtin_amdgcn_rcpf(lsum);
    LAS float* ex = (LAS float*)lds;
    if (mp == 1) {
#pragma unroll
        for (int db = 0; db < 4; ++db)
#pragma unroll
            for (int i = 0; i < 16; ++i) ex[((rs * 4 + db) * 16 + i) * 64 + lane_e] = o[db][i] * inv;
    }
    __syncthreads();
    if (mp == 0) {
        float ss = 0.f;
#pragma unroll
        for (int db = 0; db < 4; ++db)
#pragma unroll
            for (int i = 0; i < 16; ++i) { const float v = o[db][i] * inv - lam * ex[((rs * 4 + db) * 16 + i) * 64 + lane_e]; o[db][i] = v; ss += v * v; }
        ss += shx(ss, 32, lane_e);
        const float rsn = __builtin_amdgcn_rsqf(ss * (1.f / 128.f) + EPS) * osc;
        const int r_e = lane_e & 31, h_e = lane_e >> 5; bf16_t* op = outp + (R0 + 32 * rs + r_e) * opitch + hd * 128;
#pragma unroll
        for (int db = 0; db < 4; ++db)
#pragma unroll
            for (int i4 = 0; i4 < 4; ++i4) { const int d = 32 * db + 8 * i4 + 4 * h_e; const f32x4 g4 = *(const f32x4*)(subg + d);
                u32x2 wv; wv.x = pk2(o[db][4 * i4] * rsn * g4[0], o[db][4 * i4 + 1] * rsn * g4[1]); wv.y = pk2(o[db][4 * i4 + 2] * rsn * g4[2], o[db][4 * i4 + 3] * rsn * g4[3]);
                *(u32x2*)(op + d) = wv; }
    }
    __syncthreads();
}

__global__ void __launch_bounds__(512, 2) mega_fwd(Args a) {
    extern __shared__ __attribute__((aligned(16))) unsigned char lds_raw[];
    cg::grid_group grid = cg::this_grid();
    LAS unsigned char* lds = (LAS unsigned char*)lds_raw;
    const int G = gridDim.x, bid = blockIdx.x;
    const int wave = __builtin_amdgcn_readfirstlane(threadIdx.x >> 6);
#define IS_T0(v) bool v; { int l_; asm volatile("v_mbcnt_lo_u32_b32 %0, -1, 0\n\tv_mbcnt_hi_u32_b32 %0, -1, %0" : "=v"(l_)); v = (wave == 0) && (l_ == 0); }
    { IS_T0(t0_); if (t0_) { ((LAS unsigned*)(lds + MISC_OFF))[8] = 0u; ((LAS unsigned*)(lds + MISC_OFF))[9] = 0u; } __syncthreads();
      (void)xcd_barrier_post((unsigned*)kin(32) + CW_BAR, (volatile LAS unsigned*)(lds + MISC_OFF) + 8, t0_); }
#define GRID_BAR() do { XcdBarrier b_; b_.bar = (unsigned*)kin(32) + CW_BAR; b_.x = xb_xcc_id(); b_.st = (volatile LAS unsigned*)(lds + MISC_OFF) + 8; IS_T0(t0_); xcd_barrier(b_, t0_); } while (0)
#define PH_BEGIN int tid, bidp = bid, Gp = G; { int l_; asm volatile("v_mbcnt_lo_u32_b32 %0, -1, 0\n\tv_mbcnt_hi_u32_b32 %0, -1, %0" : "=v"(l_)); asm volatile("" : "+s"(bidp), "+s"(Gp)); tid = wave * 64 + l_; }
#define WSB(off) ((unsigned char*)kin(32) + (off))
#define ssqA ((float*)WSB(WS_SSQA))
#define ssqB ((float*)WSB(WS_SSQB))
#define agg ((float*)WSB(WS_AGG))
#define sm ((bf16_t*)WSB(WS_SMALL))
#define xb ((bf16_t*)WSB(WS_XB))
#define merged ((bf16_t*)kin(31))
#define proj ((bf16_t*)WSB(WS_PROJ))
#define xb2 ((bf16_t*)WSB(WS_PROJ))
#define vt ((bf16_t*)WSB(WS_VT))
#define gates ((bf16_t*)WSB(WS_GATES))
#define hid ((bf16_t*)WSB(WS_GATES))
#define out ((float*)kin(31))
#define ws WSB(0)

    { PH_BEGIN; convert_layer(0, ws + WS_W0, (LAS float*)lds, tid, bidp, Gp);
      convert_small(sm, tid, bidp, Gp);
      x_pass(kin(0), xb, ssqA, tid & 63, bidp * 8 + wave, Gp * 8); }
    grid.sync();

    for (int l = 0; l < NL; ++l) {
#define WL(off) (ws + WS_W0 + (size_t)(l & 1) * WS_WSZ + (off))
#ifndef NO_A
        {
            PH_BEGIN;
            pg8::Gemm g{xb, (const bf16_t*)WL(W_IN), MT, INC, DM, DM}; pg8::StaticOrder S; S.init(MT, INC, Gp, bidp);
            pg8::EpiInProj E{proj, vt, gates, ssqA, kin(3) + l * 3072, kin(15) + l * 64, kin(16) + l * 64};
            pg8::gemm_phase<pg8::EpiInProj, pg8::StaticOrder, true, true>(lds, g, S, E, tid);
#ifdef PROBE_A
            pg8::gemm_phase<pg8::EpiInProj, pg8::StaticOrder, true, true>(lds, g, S, E, tid);
#endif
        }
#endif
        GRID_BAR();
        {
            PH_BEGIN; const int lane = tid & 63, gw = bidp * 8 + wave, NGW = Gp * 8;
            const bf16_t* sml = sm + (size_t)l * SMALL_PER_LAYER;
#if defined(PROBE_B) && PROBE_B == 3
            { LruP LP{kin(4) + l * 1024, kin(5) + l * 256, kin(7) + l * 256, kin(9) + l * 256, kin(10) + l * 256, sml, sml + 16384};
              for (int u = bidp; u < 512; u += Gp) lru_unit<false>(lds, proj, proj, PJ, agg, LP, u >> 8, u & 255, tid); }
            if (l + 1 < NL) convert_layer(l + 1, ws + WS_W0 + (size_t)((l + 1) & 1) * WS_WSZ, (LAS float*)lds, tid, bidp, Gp);
#elif defined(PROBE_B)
#if PROBE_B == 1
            qk_norm(proj, xb, 1024, kin(15) + l * 64, kin(16) + l * 64, lane, gw, NGW);
#endif
            { LruP LP{kin(4) + l * 1024, kin(5) + l * 256, kin(7) + l * 256, kin(9) + l * 256, kin(10) + l * 256, sml, sml + 16384};
              for (int u = bidp; u < 512; u += Gp) lru_unit<false>(lds, proj, proj, PJ, agg, LP, u >> 8, u & 255, tid); }
            { SgP SP{kin(11) + l * 256, kin(12) + l * 256, kin(14) + l * 512, sml + 32768};
              for (int u = bidp; u < 256; u += Gp) sg_unit(lds, proj, xb, 1024, SP, u, tid); }
#if PROBE_B == 1
            if (l + 1 < NL) convert_layer(l + 1, ws + WS_W0 + (size_t)((l + 1) & 1) * WS_WSZ, (LAS float*)lds, tid, bidp, Gp);
#endif
#endif
            { LruP LP{kin(4) + l * 1024, kin(5) + l * 256, kin(7) + l * 256, kin(9) + l * 256, kin(10) + l * 256, sml, sml + 16384};
              for (int u = bidp; u < 512; u += Gp) lru_unit<false>(lds, proj, proj, PJ, agg, LP, u >> 8, u & 255, tid); }
            { SgP SP{kin(11) + l * 256, kin(12) + l * 256, kin(14) + l * 512, sml + 32768};
              for (int u = bidp; u < 256; u += Gp) sg_unit(lds, proj, proj + 512, PJ, SP, u, tid); }
            if (l + 1 < NL) convert_layer(l + 1, ws + WS_W0 + (size_t)((l + 1) & 1) * WS_WSZ, (LAS float*)lds, tid, bidp, Gp);
        }
        GRID_BAR();
        {
            PH_BEGIN; const int lane = tid & 63;
            float d1 = kin(17)[l * 64 + lane] * kin(18)[l * 64 + lane], d2 = kin(19)[l * 64 + lane] * kin(20)[l * 64 + lane];
            d1 = wave_sum(d1, lane); d2 = wave_sum(d2, lane);
            const float lam_init = 0.8f - 0.6f * __builtin_amdgcn_exp2f(-0.3f * LOG2E * (float)l);
            const float lam = __builtin_amdgcn_exp2f(d1 * LOG2E) - __builtin_amdgcn_exp2f(d2 * LOG2E) + lam_init;
            const float* relb = kin(22); const float* subg = kin(21) + l * 128;
#ifndef NO_ATT
#ifdef PROBE_ATT
            if (Gp == 256) {
                const int vcu = (bidp % 8) * 32 + bidp / 8, bh = vcu >> 5, s = vcu & 31;
#define ATT_OUT xb, 1024
                for (int i = 0; i < 4; ++i) { const int qb = (i == 0) ? 127 - s : (i == 1) ? 95 - s : (i == 2) ? 32 + s : s; attn_unit<PROBE_ATT>(lds, proj, vt, ATT_OUT, bh >> 2, bh & 3, qb, lam, 1.f - lam_init, relb, subg, tid); }
#undef ATT_OUT
            }
#endif
#define ATT_OUT proj + 1024, PJ
            if (Gp == 256) {
                const int vcu = (bidp % 8) * 32 + bidp / 8, bh = vcu >> 5, s = vcu & 31;
                for (int i = 0; i < 4; ++i) { const int qb = (i == 0) ? 127 - s : (i == 1) ? s : (i == 2) ? 95 - s : 32 + s; attn_unit<0>(lds, proj, vt, ATT_OUT, bh >> 2, bh & 3, qb, lam, 1.f - lam_init, relb, subg, tid); }
            } else {
                for (int u = bidp; u < 1024; u += Gp) attn_unit<0>(lds, proj, vt, ATT_OUT, u >> 9, (u >> 7) & 3, u & 127, lam, 1.f - lam_init, relb, subg, tid);
            }
#endif
            { const bf16_t* sml = sm + (size_t)l * SMALL_PER_LAYER;
              LruP LP{kin(4) + l * 1024, kin(5) + l * 256, kin(7) + l * 256, kin(9) + l * 256, kin(10) + l * 256, sml, sml + 16384};
#if defined(PROBE_B) && PROBE_B != 3
              for (int u = bidp; u < 512; u += Gp) lru_unit<true>(lds, proj, xb, 1024, agg, LP, u >> 8, u & 255, tid);
#endif
              for (int u = bidp; u < 512; u += Gp) lru_unit<true>(lds, proj, proj + 256, PJ, agg, LP, u >> 8, (u >> 8) ? 255 - (u & 255) : (u & 255), tid); }
        }
        GRID_BAR();
#ifndef NO_C1
        { PH_BEGIN; pg8::StaticOrder S; S.init(MT, DM, Gp, bidp); pg8::Gemm g{proj + 256, (const bf16_t*)WL(W_PA), MT, DM, 256, PJ}; pg8::EpiMerge<0> E{gates, merged}; pg8::gemm_phase<pg8::EpiMerge<0>, pg8::StaticOrder, true, true>(lds, g, S, E, tid); }
        { PH_BEGIN; pg8::StaticOrder S; S.init(MT, DM, Gp, bidp); pg8::Gemm g{proj + 512, (const bf16_t*)WL(W_PB), MT, DM, 256, PJ}; pg8::EpiMerge<1> E{gates, merged}; pg8::gemm_phase<pg8::EpiMerge<1>, pg8::StaticOrder, true, true>(lds, g, S, E, tid); }
        { PH_BEGIN; pg8::StaticOrder S; S.init(MT, DM, Gp, bidp); pg8::Gemm g{proj + 1024, (const bf16_t*)WL(W_PC), MT, DM, 512, PJ}; pg8::EpiMerge<2> E{gates, merged}; pg8::gemm_phase<pg8::EpiMerge<2>, pg8::StaticOrder, true, true>(lds, g, S, E, tid); }
#ifdef PROBE_C1
        { PH_BEGIN; pg8::StaticOrder S; S.init(MT, DM, Gp, bidp); pg8::Gemm g{proj + 256, (const bf16_t*)WL(W_PA), MT, DM, 256, PJ}; pg8::EpiMerge<0> E{gates, merged}; pg8::gemm_phase<pg8::EpiMerge<0>, pg8::StaticOrder, true, true>(lds, g, S, E, tid); }
        { PH_BEGIN; pg8::StaticOrder S; S.init(MT, DM, Gp, bidp); pg8::Gemm g{proj + 512, (const bf16_t*)WL(W_PB), MT, DM, 256, PJ}; pg8::EpiMerge<1> E{gates, merged}; pg8::gemm_phase<pg8::EpiMerge<1>, pg8::StaticOrder, true, true>(lds, g, S, E, tid); }
        { PH_BEGIN; pg8::StaticOrder S; S.init(MT, DM, Gp, bidp); pg8::Gemm g{proj + 1024, (const bf16_t*)WL(W_PC), MT, DM, 512, PJ}; pg8::EpiMerge<2> E{gates, merged}; pg8::gemm_phase<pg8::EpiMerge<2>, pg8::StaticOrder, true, true>(lds, g, S, E, tid); }
#endif
#endif
        GRID_BAR();
#ifndef NO_C2
        {
            PH_BEGIN;
            pg8::Gemm g{merged, (const bf16_t*)WL(W_O), MT, DM, DM, DM}; pg8::StaticOrder S; S.init(MT, DM, Gp, bidp);
            pg8::EpiResid E{(const float*)nullptr, xb, (float*)nullptr, xb2, (bf16_t*)nullptr, ssqB};
            pg8::gemm_phase<pg8::EpiResid, pg8::StaticOrder, true, true>(lds, g, S, E, tid);
        }
#endif
        GRID_BAR();
#ifndef NO_C3
        {
            PH_BEGIN;
            pg8::Gemm g{xb2, (const bf16_t*)WL(W_FF), MT, 2 * FF, DM, DM}; pg8::StaticOrder S; S.init(MT, 2 * FF, Gp, bidp);
            pg8::EpiFfn1 E{hid, ssqB};
            pg8::gemm_phase<pg8::EpiFfn1, pg8::StaticOrder, true, true>(lds, g, S, E, tid);
#ifdef PROBE_C3
            pg8::gemm_phase<pg8::EpiFfn1, pg8::StaticOrder, true, true>(lds, g, S, E, tid);
#endif
        }
#endif
        GRID_BAR();
#ifndef NO_C4
        {
            PH_BEGIN;
            pg8::Gemm g{hid, (const bf16_t*)WL(W_DN), MT, DM, FF, FF}; pg8::StaticOrder S; S.init(MT, DM, Gp, bidp);
            const bool lastl = (l + 1 == NL);
            pg8::EpiResid E{(const float*)nullptr, xb2, lastl ? out : (float*)nullptr, lastl ? (bf16_t*)nullptr : xb, (bf16_t*)nullptr, ssqA};
            pg8::gemm_phase<pg8::EpiResid, pg8::StaticOrder, true, true>(lds, g, S, E, tid);
        }
#endif
        if (l + 1 < NL) GRID_BAR();
    }
}
#undef WL
#undef GRID_BAR
#undef IS_T0
#undef PH_BEGIN
#undef ws
#undef out
#undef hid
#undef gates
#undef vt
#undef xb2
#undef proj
#undef merged
#undef xb
#undef sm
#undef agg
#undef ssqB
#undef ssqA
extern "C" void kernel_launch(void* const* d_in, const int* in_sizes, int n_in, void* d_out, int out_size, void* d_ws, size_t ws_size, hipStream_t stream) {
    static int grid = 0;
    if (grid == 0) {
        if (n_in != 31 || out_size != MT * DM || ws_size < WS_END) { fprintf(stderr, "kernel_launch: unexpected shapes (n_in %d out %d ws %zu)\n", n_in, out_size, ws_size); grid = -1; return; }
        int dev = 0, cus = 0, per_cu = 0;
        hipGetDevice(&dev); hipDeviceGetAttribute(&cus, hipDeviceAttributeMultiprocessorCount, dev);
        if (hipFuncSetAttribute((const void*)mega_fwd, hipFuncAttributeMaxDynamicSharedMemorySize, LDS_BYTES) != hipSuccess) { fprintf(stderr, "kernel_launch: hipFuncSetAttribute failed\n"); grid = -1; return; }
        if (hipOccupancyMaxActiveBlocksPerMultiprocessor(&per_cu, (const void*)mega_fwd, 512, LDS_BYTES) != hipSuccess || per_cu < 1) { fprintf(stderr, "kernel_launch: occupancy query says %d\n", per_cu); per_cu = 1; }
        (void)hipGetLastError();
        grid = cus;
    }
    if (grid < 0) return;
    if (hipMemsetAsync(d_ws, 0, CTL_ZERO_BYTES, stream) != hipSuccess) { fprintf(stderr, "kernel_launch: memset failed\n"); return; }
    Args a{};
    for (int i = 0; i < 31; ++i) a.in[i] = (const float*)d_in[i];
    a.out = (float*)d_out; a.ws = (unsigned char*)d_ws;
    void* args[] = {&a};
    hipError_t e = hipLaunchCooperativeKernel((const void*)mega_fwd, dim3(grid), dim3(512), args, LDS_BYTES, stream);
    if (e != hipSuccess) fprintf(stderr, "cooperative launch failed: %s (grid %d)\n", hipGetErrorString(e), grid);
}
```
